# Optimizing an MI355X kernel written in HIP

```python
import math
import jax
import jax.numpy as jnp
from jax import lax
import numpy as np

D_MODEL = 1024
BATCH = 4
SEQ = 8192
DEPTH = 2

GRID_W = 64
CTX_LEN = 256
Q_BLOCK = 128
ROPE_THETA = 10000.0
ROPE_DIM = 64
LN_EPS = 1e-6

DIFF_HEADS = 4
DIFF_HD = 64
DIFF_VD = 2 * DIFF_HD
W_DIFF = DIFF_HEADS * DIFF_VD
S5_GROUP = 16
S5_GROUPS = 32
S5_STATE = 64
W_S5 = S5_GROUP * S5_GROUPS
ML_HEADS = 4
ML_HD = 128
W_ML = ML_HEADS * ML_HD
ML_CHUNK = 64
ML_CONV = 3
GQA_HEADS = 8
GQA_KV = 2
GQA_HD = 64
GQA_GROUP = GQA_HEADS // GQA_KV
W_GQA = GQA_HEADS * GQA_HD

N_BRANCH = 4
W_BRANCH = 512

PEER_HEADS = 8
PEER_NKEYS = 128
PEER_EXPERTS = PEER_NKEYS * PEER_NKEYS
PEER_TOPK = 16
PEER_DQ = 256
PEER_BLOCK = 128

ALPHA = (2 * DEPTH) ** 0.25
BETA = (8 * DEPTH) ** -0.25

IN_SPLITS = (W_DIFF, W_DIFF, W_DIFF,
             W_S5,
             W_ML, W_ML, W_ML, W_ML,
             4 * ML_HEADS,
             W_GQA, GQA_KV * GQA_HD, GQA_KV * GQA_HD,
             N_BRANCH * D_MODEL)
N_IN = sum(IN_SPLITS)
IN_OFFSETS = tuple(sum(IN_SPLITS[:i + 1]) for i in range(len(IN_SPLITS) - 1))

kernel_name = 'hybrid_diffusion_backbone'


def layer_norm(x, g=None, b=None):
    xf = x.astype(jnp.float32)
    xc = xf - jnp.mean(xf, axis=-1, keepdims=True)
    y = xc * lax.rsqrt(jnp.mean(xc * xc, axis=-1, keepdims=True) + LN_EPS)
    if g is not None:
        y = y * g.astype(jnp.float32) + b.astype(jnp.float32)
    return y.astype(x.dtype)


def rms_norm(x, g):
    xf = x.astype(jnp.float32)
    y = xf * lax.rsqrt(jnp.mean(xf * xf, axis=-1, keepdims=True) + LN_EPS)
    return (y * g.astype(jnp.float32)).astype(x.dtype)


def modulate(x, shift, scale):
    return layer_norm(x) * (1 + scale) + shift


def rope_angles(length):
    rows = length // GRID_W
    row = jnp.repeat(jnp.arange(rows, dtype=jnp.float32), GRID_W)
    col = jnp.tile(jnp.arange(GRID_W, dtype=jnp.float32), rows)
    nf = ROPE_DIM // 4
    inv = ROPE_THETA ** (-jnp.arange(nf, dtype=jnp.float32) / nf)
    return row[:, None] * inv, col[:, None] * inv


def _rotate(x, ang):
    x1, x2 = jnp.split(x, 2, axis=-1)
    cos, sin = jnp.cos(ang), jnp.sin(ang)
    return jnp.concatenate([x1 * cos - x2 * sin, x2 * cos + x1 * sin], axis=-1)


def rope_2d(x, ang_row, ang_col):
    shape = (x.shape[1],) + (1,) * (x.ndim - 3) + (ang_row.shape[-1],)
    xf = x.astype(jnp.float32)
    half = ROPE_DIM // 2
    out = jnp.concatenate([_rotate(xf[..., :half], ang_row.reshape(shape)),
                           _rotate(xf[..., half:], ang_col.reshape(shape))], axis=-1)
    return out.astype(x.dtype)


def sweep_query_blocks(fn, q):
    B, L = q.shape[:2]
    nb = L // Q_BLOCK
    qb = jnp.moveaxis(q.reshape((B, nb, Q_BLOCK) + q.shape[2:]), 1, 0)
    out = jnp.moveaxis(lax.map(fn, qb), 0, 1)
    return out.reshape((B, L) + out.shape[3:])


def diff_attend(q, k, v, lam):
    scale = DIFF_HD ** -0.5

    def block(qb):
        s = jnp.einsum('bqhcd,bshcd->bhcqs', qb, k, preferred_element_type=jnp.float32) * scale
        p = jax.nn.softmax(s, axis=-1)
        a = (p[:, :, 0] - lam * p[:, :, 1]).astype(v.dtype)
        return jnp.einsum('bhqs,bshe->bqhe', a, v)
    return sweep_query_blocks(block, q)


def gqa_attend(q, k, v):
    scale = GQA_HD ** -0.5

    def block(qb):
        s = jnp.einsum('bqkgd,bskd->bkgqs', qb, k, preferred_element_type=jnp.float32) * scale
        p = jax.nn.softmax(s, axis=-1).astype(v.dtype)
        return jnp.einsum('bkgqs,bskd->bqkgd', p, v)
    return sweep_query_blocks(block, q)


def diff_mixer(q_c, k_c, v_c, q_l, k_l, v_l, lam_vec, norm_g, lam_init, ang_row, ang_col, with_ctx):
    def heads_qk(t):
        return t.reshape(t.shape[:2] + (DIFF_HEADS, 2, DIFF_HD))

    def heads_v(t):
        return t.reshape(t.shape[:2] + (DIFF_HEADS, DIFF_VD))

    lv = lam_vec.astype(jnp.float32)
    lam = jnp.exp(jnp.sum(lv[0] * lv[1])) - jnp.exp(jnp.sum(lv[2] * lv[3])) + lam_init
    kc, vc = heads_qk(k_c), heads_v(v_c)
    ql = rope_2d(heads_qk(q_l), ang_row, ang_col)
    kl = rope_2d(heads_qk(k_l), ang_row, ang_col)
    k_all = jnp.concatenate([kl, kc], axis=1)
    v_all = jnp.concatenate([heads_v(v_l), vc], axis=1)

    def finish(o):
        return (rms_norm(o, norm_g) * (1 - lam_init)).reshape(o.shape[:2] + (W_DIFF,))
    y_l = finish(diff_attend(ql, k_all, v_all, lam))
    y_c = finish(diff_attend(heads_qk(q_c), kc, vc, lam)) if with_ctx else None
    return y_c, y_l


def gqa_mixer(q_c, k_c, v_c, q_l, k_l, v_l, qn_g, kn_g, ang_row, ang_col, with_ctx):
    def hq(t):
        return rms_norm(t.reshape(t.shape[:2] + (GQA_KV, GQA_GROUP, GQA_HD)), qn_g)

    def hk(t):
        return rms_norm(t.reshape(t.shape[:2] + (GQA_KV, GQA_HD)), kn_g)

    def hv(t):
        return t.reshape(t.shape[:2] + (GQA_KV, GQA_HD))

    kc, vc = hk(k_c), hv(v_c)
    ql = rope_2d(hq(q_l), ang_row, ang_col)
    kl = rope_2d(hk(k_l), ang_row, ang_col)
    k_all = jnp.concatenate([kl, kc], axis=1)
    v_all = jnp.concatenate([hv(v_l), vc], axis=1)
    y_l = gqa_attend(ql, k_all, v_all)
    y_l = y_l.reshape(y_l.shape[:2] + (W_GQA,))
    y_c = None
    if with_ctx:
        y_c = gqa_attend(hq(q_c), kc, vc)
        y_c = y_c.reshape(y_c.shape[:2] + (W_GQA,))
    return y_c, y_l


def s5_discretise(a_re, a_im, log_dt, b_re, b_im):
    dt = jnp.exp(log_dt.astype(jnp.float32))[:, None]
    ar, ai = a_re.astype(jnp.float32), a_im.astype(jnp.float32)
    mag = jnp.exp(ar * dt)
    lr, li = mag * jnp.cos(ai * dt), mag * jnp.sin(ai * dt)
    den = ar * ar + ai * ai
    cr = ((lr - 1) * ar + li * ai) / den
    ci = (li * ar - (lr - 1) * ai) / den
    br, bi = b_re.astype(jnp.float32), b_im.astype(jnp.float32)
    return lr, li, cr[..., None] * br - ci[..., None] * bi, cr[..., None] * bi + ci[..., None] * br


def _complex_affine_combine(e1, e2):
    a1r, a1i, b1r, b1i = e1
    a2r, a2i, b2r, b2i = e2
    return (a1r * a2r - a1i * a2i, a1r * a2i + a1i * a2r,
            a2r * b1r - a2i * b1i + b2r, a2r * b1i + a2i * b1r + b2i)


def s5_scan(u, lr, li, br, bi, h0, reverse):
    L = u.shape[1]
    bu_r = jnp.einsum('blgc,gnc->blgn', u, br)
    bu_i = jnp.einsum('blgc,gnc->blgn', u, bi)
    if h0 is not None:
        idx = L - 1 if reverse else 0
        bu_r = bu_r.at[:, idx].add(lr * h0[0] - li * h0[1])
        bu_i = bu_i.at[:, idx].add(lr * h0[1] + li * h0[0])
    ar = jnp.broadcast_to(lr, (1, L) + lr.shape)
    ai = jnp.broadcast_to(li, (1, L) + li.shape)
    _, _, hr, hi = lax.associative_scan(_complex_affine_combine, (ar, ai, bu_r, bu_i), reverse=reverse, axis=1)
    return hr, hi


def s5_readout(hr, hi, c_re, c_im):
    return jnp.einsum('blgn,gcn->blgc', hr, c_re) - jnp.einsum('blgn,gcn->blgc', hi, c_im)


def s5_mixer(u_c, u_l, a_re, a_im, log_dt, b_re, b_im, c_re, c_im, d_skip, w_glu, b_glu, with_ctx):
    def groups(t):
        return t.astype(jnp.float32).reshape(t.shape[:2] + (S5_GROUPS, S5_GROUP))
    uc, ul = groups(u_c), groups(u_l)
    dg = d_skip.astype(jnp.float32).reshape(S5_GROUPS, S5_GROUP)
    y_l = ul * dg
    y_c = uc * dg if with_ctx else None
    for dirn, reverse in ((0, False), (1, True)):
        lr, li, br, bi = s5_discretise(a_re[dirn], a_im[dirn], log_dt[dirn], b_re[dirn], b_im[dirn])
        hcr, hci = s5_scan(uc, lr, li, br, bi, None, reverse)
        end = 0 if reverse else -1
        hlr, hli = s5_scan(ul, lr, li, br, bi, (hcr[:, end], hci[:, end]), reverse)
        y_l = y_l + s5_readout(hlr, hli, c_re[dirn], c_im[dirn])
        if with_ctx:
            y_c = y_c + s5_readout(hcr, hci, c_re[dirn], c_im[dirn])

    def glu(y, ref):
        z = jax.nn.gelu(y.reshape(y.shape[:2] + (W_S5,)), approximate=False).astype(ref.dtype)
        a, g = jnp.split(z @ w_glu + b_glu, 2, axis=-1)
        return a * jax.nn.sigmoid(g)
    return (glu(y_c, u_c) if with_ctx else None), glu(y_l, u_l)


def centred_conv(x, w, b):
    K = w.shape[0]
    pad = K // 2
    L = x.shape[1]
    xp = jnp.pad(x, ((0, 0), (pad, pad), (0, 0)))
    out = b
    for j in range(K):
        out = out + xp[:, j:j + L] * w[j]
    return out


def mlstm_chunked(q, k, v, log_i, log_f, state):
    B, H, L, d = q.shape
    nc = L // ML_CHUNK

    def chunks(t):
        return jnp.moveaxis(t.reshape((B, H, nc, ML_CHUNK) + t.shape[3:]), 2, 0)
    mask = jnp.tril(jnp.ones((ML_CHUNK, ML_CHUNK), dtype=bool))

    def step(carry, xs):
        C, n, m = carry
        qc, kc, vc, ic, fc = xs
        b = jnp.cumsum(fc, axis=-1)
        logw = jnp.where(mask, b[..., :, None] - b[..., None, :] + ic[..., None, :], -jnp.inf)
        m_inter = b + m[..., None]
        m_t = jnp.maximum(m_inter, jnp.max(logw, axis=-1))
        s = jnp.einsum('bhtd,bhsd->bhts', qc, kc) * jnp.exp(logw - m_t[..., None])
        inter = jnp.exp(m_inter - m_t)
        num = jnp.einsum('bhts,bhsd->bhtd', s, vc) + inter[..., None] * jnp.einsum('bhvk,bhtk->bhtv', C, qc)
        den = jnp.sum(s, axis=-1) + inter * jnp.einsum('bhk,bhtk->bht', n, qc)
        h = num / jnp.maximum(jnp.abs(den), jnp.exp(-m_t))[..., None]
        b_end = b[..., -1]
        g = b_end[..., None] - b + ic
        m_new = jnp.maximum(b_end + m, jnp.max(g, axis=-1))
        decay = jnp.exp(b_end + m - m_new)
        wk = jnp.exp(g - m_new[..., None])
        C_new = decay[..., None, None] * C + jnp.einsum('bhtv,bhtk->bhvk', vc * wk[..., None], kc)
        n_new = decay[..., None] * n + jnp.einsum('bht,bhtk->bhk', wk, kc)
        return (C_new, n_new, m_new), h

    final, hs = lax.scan(step, state, (chunks(q), chunks(k), chunks(v), chunks(log_i), chunks(log_f)))
    return jnp.moveaxis(hs, 0, 2).reshape(B, H, L, d), final


def mlstm_mixer(parts_c, parts_l, conv_w, conv_b, gate_b, norm_g, with_ctx):
    def prep(q, k, v, gates):
        B, L = q.shape[:2]
        qk = jax.nn.silu(centred_conv(jnp.concatenate([q, k], axis=-1), conv_w, conv_b))
        q, k = jnp.split(qk, 2, axis=-1)

        def heads(t):
            return t.reshape(B, L, ML_HEADS, ML_HD).transpose(0, 2, 1, 3).astype(jnp.float32)
        g = (gates + gate_b).astype(jnp.float32).reshape(B, L, 4, ML_HEADS).transpose(2, 0, 3, 1)
        return heads(q), heads(k) * ML_HD ** -0.5, heads(v), g

    qc, kc, vc, gc = prep(parts_c[0], parts_c[1], parts_c[2], parts_c[4])
    ql, kl, vl, gl = prep(parts_l[0], parts_l[1], parts_l[2], parts_l[4])
    B = qc.shape[0]
    st0 = (jnp.zeros((B, ML_HEADS, ML_HD, ML_HD), jnp.float32),
           jnp.zeros((B, ML_HEADS, ML_HD), jnp.float32),
           jnp.zeros((B, ML_HEADS), jnp.float32))
    logsig = jax.nn.log_sigmoid

    def flip(t):
        return jnp.flip(t, axis=2)
    hc_f, st_f = mlstm_chunked(qc, kc, vc, gc[0], logsig(gc[1]), st0)
    hl_f, _ = mlstm_chunked(ql, kl, vl, gl[0], logsig(gl[1]), st_f)
    hc_b, st_b = mlstm_chunked(flip(qc), flip(kc), flip(vc), flip(gc[2]), flip(logsig(gc[3])), st0)
    hl_b, _ = mlstm_chunked(flip(ql), flip(kl), flip(vl), flip(gl[2]), flip(logsig(gl[3])), st_b)

    def finish(h, o):
        B_, L = o.shape[:2]
        hn = rms_norm(h.transpose(0, 2, 1, 3), norm_g.reshape(ML_HEADS, ML_HD))
        og = jax.nn.sigmoid(o.astype(jnp.float32)).reshape(B_, L, ML_HEADS, ML_HD)
        return (hn * og).reshape(B_, L, W_ML).astype(o.dtype)
    y_l = finish(hl_f + flip(hl_b), parts_l[3])
    y_c = finish(hc_f + flip(hc_b), parts_c[3]) if with_ctx else None
    return y_c, y_l


def merge_branches(ys, gate_pre, b_gate, w_branch, w_out):
    gates = jnp.split(jax.nn.sigmoid((gate_pre + b_gate).astype(jnp.float32)).astype(gate_pre.dtype), N_BRANCH, axis=-1)
    merged = gates[0] * (ys[0] @ w_branch[0])
    for k in range(1, N_BRANCH):
        merged = merged + gates[k] * (ys[k] @ w_branch[k])
    return merged @ w_out


def peer_ffn(x, wq, subkeys, emb_u, emb_v):
    B, L, D = x.shape
    T = B * L
    t = x.reshape(T, D)
    q = (t @ wq).reshape(T, PEER_HEADS, 2, PEER_DQ // 2)
    s = jnp.einsum('thpd,pkd->thpk', q, subkeys, preferred_element_type=jnp.float32)
    s1, i1 = lax.top_k(s[:, :, 0], PEER_TOPK)
    s2, i2 = lax.top_k(s[:, :, 1], PEER_TOPK)
    cand = (s1[..., :, None] + s2[..., None, :]).reshape(T, PEER_HEADS, PEER_TOPK * PEER_TOPK)
    cidx = (i1[..., :, None] * PEER_NKEYS + i2[..., None, :]).reshape(T, PEER_HEADS, PEER_TOPK * PEER_TOPK)
    top, pos = lax.top_k(cand, PEER_TOPK)
    idx = jnp.take_along_axis(cidx, pos, axis=-1)
    gate = jax.nn.softmax(top, axis=-1)
    nb = T // PEER_BLOCK

    def block(args):
        tb, ib, gb = args
        act = jax.nn.gelu(jnp.einsum('td,thkd->thk', tb, emb_u[ib], preferred_element_type=jnp.float32), approximate=False)
        w = (gb * act).astype(emb_v.dtype)
        return jnp.einsum('thk,thkd->td', w, emb_v[ib])
    out = lax.map(block, (t.reshape(nb, PEER_BLOCK, D),
                          idx.reshape(nb, PEER_BLOCK, PEER_HEADS, PEER_TOPK),
                          gate.reshape(nb, PEER_BLOCK, PEER_HEADS, PEER_TOPK)))
    return out.reshape(B, L, D)


def setup_inputs(seed: int = 0) -> dict:
    key = jax.random.key(seed)
    ks = iter(jax.random.split(key, 48))
    f32 = jnp.float32

    def nrm(shape, scale):
        return jax.random.normal(next(ks), shape, f32) * scale

    D = D_MODEL
    gate_base = jnp.tile(jnp.concatenate([jnp.zeros((ML_HEADS,), f32), jnp.linspace(3.0, 6.0, ML_HEADS, dtype=f32)]), 2)
    return {
        'x': nrm((BATCH, SEQ, D), 1.0),
        'c': nrm((BATCH, D), 1.0),
        'ctx': nrm((BATCH, CTX_LEN, D), 1.0),
        'c_ctx': nrm((D,), 1.0),
        'ada_w': nrm((DEPTH, D, 6 * D), 0.5 * D ** -0.5),
        'ada_b': nrm((DEPTH, 6 * D), 0.02),
        'w_in': nrm((DEPTH, D, N_IN), D ** -0.5),
        'b_gate': nrm((DEPTH, N_BRANCH * D), 0.02),
        'diff_lam': nrm((DEPTH, 4, DIFF_HD), 0.1),
        'diff_norm_g': 1.0 + nrm((DEPTH, DIFF_VD), 0.02),
        'gqa_qnorm_g': 1.0 + nrm((DEPTH, GQA_HD), 0.02),
        'gqa_knorm_g': 1.0 + nrm((DEPTH, GQA_HD), 0.02),
        's5_a_re': -0.5 + nrm((DEPTH, 2, S5_GROUPS, S5_STATE), 0.01),
        's5_a_im': jnp.pi * jnp.arange(S5_STATE, dtype=f32) + nrm((DEPTH, 2, S5_GROUPS, S5_STATE), 0.01),
        's5_log_dt': jax.random.uniform(next(ks), (DEPTH, 2, S5_GROUPS), f32, math.log(1e-3), math.log(1e-1)),
        's5_b_re': nrm((DEPTH, 2, S5_GROUPS, S5_STATE, S5_GROUP), (2 * S5_GROUP) ** -0.5),
        's5_b_im': nrm((DEPTH, 2, S5_GROUPS, S5_STATE, S5_GROUP), (2 * S5_GROUP) ** -0.5),
        's5_c_re': nrm((DEPTH, 2, S5_GROUPS, S5_GROUP, S5_STATE), (2 * S5_STATE) ** -0.5),
        's5_c_im': nrm((DEPTH, 2, S5_GROUPS, S5_GROUP, S5_STATE), (2 * S5_STATE) ** -0.5),
        's5_d': nrm((DEPTH, W_S5), 0.5),
        's5_w_glu': nrm((DEPTH, W_S5, 2 * W_S5), W_S5 ** -0.5),
        's5_b_glu': nrm((DEPTH, 2 * W_S5), 0.02),
        'ml_conv_w': nrm((DEPTH, ML_CONV, 2 * W_ML), ML_CONV ** -0.5),
        'ml_conv_b': nrm((DEPTH, 2 * W_ML), 0.02),
        'ml_gate_b': gate_base[None, :] + nrm((DEPTH, 4 * ML_HEADS), 0.1),
        'ml_norm_g': 1.0 + nrm((DEPTH, W_ML), 0.02),
        'w_branch': nrm((DEPTH, N_BRANCH, W_BRANCH, D), BETA * W_BRANCH ** -0.5),
        'w_out': nrm((DEPTH, D, D), BETA * D ** -0.5),
        'ln_mix_g': 1.0 + nrm((DEPTH, D), 0.02),
        'ln_mix_b': nrm((DEPTH, D), 0.02),
        'ln_ffn_g': 1.0 + nrm((DEPTH, D), 0.02),
        'ln_ffn_b': nrm((DEPTH, D), 0.02),
        'peer_wq': nrm((DEPTH, D, PEER_HEADS * PEER_DQ), D ** -0.5),
        'peer_subkeys': nrm((DEPTH, 2, PEER_NKEYS, PEER_DQ // 2), (PEER_DQ // 2) ** -0.5),
        'peer_u': nrm((DEPTH, PEER_EXPERTS, D), D ** -0.5),
        'peer_v': nrm((DEPTH, PEER_EXPERTS, D), BETA * PEER_HEADS ** -0.5),
    }


def reference(x, c, ctx, c_ctx, ada_w, ada_b, w_in, b_gate, diff_lam, diff_norm_g, gqa_qnorm_g, gqa_knorm_g,
              s5_a_re, s5_a_im, s5_log_dt, s5_b_re, s5_b_im, s5_c_re, s5_c_im, s5_d, s5_w_glu, s5_b_glu,
              ml_conv_w, ml_conv_b, ml_gate_b, ml_norm_g, w_branch, w_out, ln_mix_g, ln_mix_b, ln_ffn_g, ln_ffn_b,
              peer_wq, peer_subkeys, peer_u, peer_v):
    ang_row, ang_col = rope_angles(x.shape[1])
    cond_lat = jax.nn.silu(c)
    cond_ctx = jax.nn.silu(c_ctx)
    h_lat, h_ctx = x, ctx
    for l in range(DEPTH):
        with_ctx = l < DEPTH - 1
        lam_init = 0.8 - 0.6 * math.exp(-0.3 * l)
        mod_lat = (cond_lat @ ada_w[l] + ada_b[l])[:, None, :]
        mod_ctx = (cond_ctx @ ada_w[l] + ada_b[l])[None, None, :]
        sh1_l, sc1_l, g1_l, sh2_l, sc2_l, g2_l = jnp.split(mod_lat, 6, axis=-1)
        sh1_c, sc1_c, g1_c, sh2_c, sc2_c, g2_c = jnp.split(mod_ctx, 6, axis=-1)

        pl = jnp.split(modulate(h_lat, sh1_l, sc1_l) @ w_in[l], IN_OFFSETS, axis=-1)
        pc = jnp.split(modulate(h_ctx, sh1_c, sc1_c) @ w_in[l], IN_OFFSETS, axis=-1)

        yd_c, yd_l = diff_mixer(pc[0], pc[1], pc[2], pl[0], pl[1], pl[2], diff_lam[l], diff_norm_g[l],
                                lam_init, ang_row, ang_col, with_ctx)
        ys_c, ys_l = s5_mixer(pc[3], pl[3], s5_a_re[l], s5_a_im[l], s5_log_dt[l], s5_b_re[l], s5_b_im[l],
                              s5_c_re[l], s5_c_im[l], s5_d[l], s5_w_glu[l], s5_b_glu[l], with_ctx)
        ym_c, ym_l = mlstm_mixer(pc[4:9], pl[4:9], ml_conv_w[l], ml_conv_b[l], ml_gate_b[l], ml_norm_g[l], with_ctx)
        yg_c, yg_l = gqa_mixer(pc[9], pc[10], pc[11], pl[9], pl[10], pl[11], gqa_qnorm_g[l], gqa_knorm_g[l],
                               ang_row, ang_col, with_ctx)

        mix_l = merge_branches((yd_l, ys_l, ym_l, yg_l), pl[12], b_gate[l], w_branch[l], w_out[l])
        h_lat = layer_norm(ALPHA * h_lat + g1_l * mix_l, ln_mix_g[l], ln_mix_b[l])
        f_l = peer_ffn(modulate(h_lat, sh2_l, sc2_l), peer_wq[l], peer_subkeys[l], peer_u[l], peer_v[l])
        h_lat = layer_norm(ALPHA * h_lat + g2_l * f_l, ln_ffn_g[l], ln_ffn_b[l])

        if with_ctx:
            mix_c = merge_branches((yd_c, ys_c, ym_c, yg_c), pc[12], b_gate[l], w_branch[l], w_out[l])
            h_ctx = layer_norm(ALPHA * h_ctx + g1_c * mix_c, ln_mix_g[l], ln_mix_b[l])
            f_c = peer_ffn(modulate(h_ctx, sh2_c, sc2_c), peer_wq[l], peer_subkeys[l], peer_u[l], peer_v[l])
            h_ctx = layer_norm(ALPHA * h_ctx + g2_c * f_c, ln_ffn_g[l], ln_ffn_b[l])
    return h_lat
```

```cpp
#include <hip/hip_runtime.h>
#include <hip/hip_cooperative_groups.h>
#include <cstdio>
namespace cg = cooperative_groups;

#ifndef MULTI_LAUNCH
#define MULTI_LAUNCH 0
#endif

#define DI __device__ __forceinline__
typedef unsigned short u16;
typedef short bf16x8 __attribute__((ext_vector_type(8)));
typedef short s16x4 __attribute__((ext_vector_type(4)));
typedef float f32x16 __attribute__((ext_vector_type(16)));
typedef float f32x2 __attribute__((ext_vector_type(2)));
typedef __bf16 bf16x2_t __attribute__((ext_vector_type(2)));
typedef unsigned u32x4 __attribute__((ext_vector_type(4)));
typedef __bf16 bf16x8_t __attribute__((ext_vector_type(8)));
#define MFMA32(a, b, c) __builtin_amdgcn_mfma_f32_32x32x16_bf16((a), (b), (c), 0, 0, 0)

constexpr int NB = 4, SL = 8192, SC = 256, SB = 8448, NP = NB * SB, DM = 1024, NIN = 8976;
constexpr float LN_EPS = 1e-6f;
constexpr float ALPHA = 1.41421356237f;
constexpr float LOG2E = 1.44269504089f;

constexpr size_t SZ512 = (size_t)NP * 512 * 2;
constexpr size_t OFF_A = 0;
constexpr size_t OFF_QD = OFF_A + 2 * SZ512;
constexpr size_t OFF_KD = OFF_QD + SZ512;
constexpr size_t OFF_VDT = OFF_KD + SZ512;
constexpr size_t OFF_S5U = OFF_VDT + SZ512;
constexpr size_t OFF_MQ = OFF_S5U + SZ512;
constexpr size_t OFF_MK = OFF_MQ + SZ512;
constexpr size_t OFF_MVT = OFF_MK + SZ512;
constexpr size_t OFF_MO = OFF_MVT + SZ512;
constexpr size_t OFF_QG = OFF_MO + SZ512;
constexpr size_t OFF_KG = OFF_QG + SZ512;
constexpr size_t OFF_VGT = OFF_KG + SZ512 / 4;
constexpr size_t OFF_MGATE = OFF_VGT + SZ512 / 4;
constexpr size_t OFF_WIN = OFF_MGATE + (size_t)NP * 16 * 4;
constexpr size_t OFF_WBR = OFF_WIN + (size_t)9088 * 1024 * 2;
constexpr size_t OFF_WO = OFF_WBR + (size_t)4 * 1024 * 512 * 2;
constexpr size_t OFF_WGLU = OFF_WO + (size_t)1024 * 1024 * 2;
constexpr size_t OFF_WQ = OFF_WGLU + (size_t)1024 * 512 * 2;
constexpr size_t OFF_SK = OFF_WQ + (size_t)2048 * 1024 * 2;
constexpr size_t OFF_MODP = OFF_SK + 65536;
constexpr size_t OFF_MOD = OFF_MODP + (size_t)2 * 8 * 5 * 6144 * 4;
constexpr size_t OFF_LAMB = OFF_MOD + (size_t)2 * 5 * 6144 * 4;
constexpr size_t OFF_BBAR = OFF_LAMB + 65536;
constexpr size_t OFF_LAMV = OFF_BBAR + 1048576;
constexpr size_t SZCH = (size_t)32 * SB * 4;
constexpr size_t OFF_GI = OFF_LAMV + 256;
constexpr size_t OFF_GF = OFF_GI + SZCH;
constexpr size_t OFF_AA = OFF_GF + SZCH;
constexpr size_t OFF_MXA = OFF_AA + SZCH;
constexpr size_t OFF_MTA = OFF_MXA + SZCH;
constexpr size_t SZHE = (size_t)NB * 2 * 32 * 132 * 64 * 8;
constexpr size_t OFF_HEND = OFF_MTA + SZCH;
constexpr size_t OFF_CARRY = OFF_HEND + SZHE;
constexpr size_t OFF_HC = OFF_CARRY + SZHE;
constexpr size_t OFF_STASH = OFF_HC + (size_t)1024 * 1024 * 4;
constexpr size_t OFF_PU = OFF_STASH;
constexpr size_t OFF_PV = OFF_STASH + (size_t)16384 * 1024;
constexpr size_t OFF_ROPE = OFF_STASH + (size_t)512 * 64 * 256 * 4;
constexpr size_t OFF_TMAX = OFF_ROPE + 32768;
constexpr size_t OFF_BBT = OFF_TMAX + 32768;
constexpr size_t OFF_CMT = OFF_BBT + 524288;
constexpr size_t OFF_NST = OFF_CMT + 524288;
constexpr size_t OFF_NPST = OFF_NST + (size_t)1056 * 128 * 4;
constexpr size_t OFF_ALOC = OFF_NPST + (size_t)1056 * 128 * 4;
constexpr size_t OFF_BKA = OFF_ALOC + 8192;
constexpr size_t OFF_CTR = OFF_BKA + 8192;
constexpr size_t OFF_BAR = OFF_CTR + 256;
constexpr size_t WS_END = OFF_BAR + 16384;
constexpr size_t OFF_GST = OFF_MQ;
constexpr size_t OFF_PST = OFF_MK;
constexpr size_t OFF_Z = OFF_MQ;

constexpr size_t OFF_Q2 = OFF_S5U;
constexpr size_t OFF_IDX = OFF_MO;
constexpr size_t OFF_GATE = OFF_MO + (size_t)NP * 8 * 16 * 4;

struct P {
  const float* in[36];
  float* out;
  char* ws;
};

typedef const float* const __attribute__((address_space(4)))* kargp_t;
DI kargp_t karg() { kargp_t k = (kargp_t)__builtin_amdgcn_kernarg_segment_ptr(); asm volatile("" : "+s"(k)); return k; }
#define IN(i) (karg()[i])
#define OUTP ((float*)karg()[36])
#define WSP ((char*)karg()[37])
DI int otid() { int t = threadIdx.x; asm volatile("" : "+v"(t)); return t; }
template <int M> DI int shx_i(int v) {
  if constexpr (M < 32) return __builtin_amdgcn_ds_swizzle(v, 0x1f | (M << 10));
  else return __builtin_amdgcn_ds_bpermute(((otid() & 63) ^ M) << 2, v);
}
#define SHX(v, M) __int_as_float(shx_i<M>(__float_as_int(v)))
#define SHXI(v, M) shx_i<M>(v)
DI unsigned cvtpk(float lo, float hi) { f32x2 v = {lo, hi}; bf16x2_t b = __builtin_convertvector(v, bf16x2_t); return __builtin_bit_cast(unsigned, b); }
DI u16 f2bf(float x) { return (u16)(cvtpk(x, 0.f) & 0xffffu); }
DI float bf2f(u16 x) { return __uint_as_float(((unsigned)x) << 16); }
DI float bflo(unsigned u) { return __uint_as_float(u << 16); }
DI float bfhi(unsigned u) { return __uint_as_float(u & 0xffff0000u); }
DI float wave_sum(float v) { v += SHX(v, 32); v += SHX(v, 16); v += SHX(v, 8); v += SHX(v, 4); v += SHX(v, 2); v += SHX(v, 1); return v; }
DI float wave_max(float v) { v = fmaxf(v, SHX(v, 32)); v = fmaxf(v, SHX(v, 16)); v = fmaxf(v, SHX(v, 8)); v = fmaxf(v, SHX(v, 4)); v = fmaxf(v, SHX(v, 2)); v = fmaxf(v, SHX(v, 1)); return v; }
DI float block_sum(float v, float* red) {
  v = wave_sum(v);
  __syncthreads();
  if ((otid() & 63) == 0) red[otid() >> 6] = v;
  __syncthreads();
  return red[0] + red[1] + red[2] + red[3];
}
DI float sigmoidf_(float x) { return 1.f / (1.f + __expf(-x)); }
DI float gelu_erf(float x) { return 0.5f * x * (1.f + erff(x * 0.70710678118f)); }
DI float silu_(float x) { return x / (1.f + __expf(-x)); }
DI float fexp2(float x) { return __builtin_amdgcn_exp2f(x); }

DI const float* h_in_ptr(const P& p, int L, int pos) {
  int b = pos / SB, s = pos - b * SB;
  if (L == 0) return s < SL ? IN(0) + ((size_t)b * SL + s) * DM : IN(2) + ((size_t)b * SC + (s - SL)) * DM;
  return s < SL ? OUTP + ((size_t)b * SL + s) * DM : (const float*)(WSP + OFF_HC) + ((size_t)b * SC + (s - SL)) * DM;
}
DI float* h_out_ptr(const P& p, int pos) {
  int b = pos / SB, s = pos - b * SB;
  return s < SL ? OUTP + ((size_t)b * SL + s) * DM : (float*)(WSP + OFF_HC) + ((size_t)b * SC + (s - SL)) * DM;
}
DI const float* mod_ptr(const P& p, int L, int pos) {
  int b = pos / SB, s = pos - b * SB;
  int v = s < SL ? b : 4;
  return (const float*)(WSP + OFF_MOD) + ((size_t)L * 5 + v) * 6144;
}

DI void gemm_core(const u16* __restrict__ A, int lda, const u16* __restrict__ B, int ldb, int K, f32x16 (&acc)[2][2], u16* lds) {
  const int tid = otid(), lane = tid & 63, wave = tid >> 6;
  const int wm = wave >> 1, wn = wave & 1, r32 = lane & 31, h = lane >> 5;
  u16* As = lds; u16* Bs = lds + 128 * 72;
  const int lr = tid >> 3, lc = (tid & 7) * 8;
  u32x4 ra[4], rb[4];
  const int nk = K >> 6;
#pragma unroll
  for (int i = 0; i < 4; ++i) {
    ra[i] = *(const u32x4*)(A + (size_t)(lr + 32 * i) * lda + lc);
    rb[i] = *(const u32x4*)(B + (size_t)(lr + 32 * i) * ldb + lc);
  }
#pragma unroll 1
  for (int kt = 0; kt < nk; ++kt) {
    __syncthreads();
#pragma unroll
    for (int i = 0; i < 4; ++i) {
      *(u32x4*)(As + (lr + 32 * i) * 72 + lc) = ra[i];
      *(u32x4*)(Bs + (lr + 32 * i) * 72 + lc) = rb[i];
    }
    __syncthreads();
    if (kt + 1 < nk) {
#pragma unroll
      for (int i = 0; i < 4; ++i) {
        ra[i] = *(const u32x4*)(A + (size_t)(lr + 32 * i) * lda + (kt + 1) * 64 + lc);
        rb[i] = *(const u32x4*)(B + (size_t)(lr + 32 * i) * ldb + (kt + 1) * 64 + lc);
      }
    }
#pragma unroll
    for (int s = 0; s < 4; ++s) {
      bf16x8 af[2], bfr[2];
#pragma unroll
      for (int mi = 0; mi < 2; ++mi) af[mi] = *(const bf16x8*)(As + (wm * 64 + mi * 32 + r32) * 72 + s * 16 + h * 8);
#pragma unroll
      for (int ni = 0; ni < 2; ++ni) bfr[ni] = *(const bf16x8*)(Bs + (wn * 64 + ni * 32 + r32) * 72 + s * 16 + h * 8);
#pragma unroll
      for (int mi = 0; mi < 2; ++mi)
#pragma unroll
        for (int ni = 0; ni < 2; ++ni) acc[mi][ni] = MFMA32(af[mi], bfr[ni], acc[mi][ni]);
    }
  }
}
DI void acc_zero(f32x16 (&acc)[2][2]) {
#pragma unroll
  for (int mi = 0; mi < 2; ++mi)
#pragma unroll
    for (int ni = 0; ni < 2; ++ni)
#pragma unroll
      for (int i = 0; i < 16; ++i) acc[mi][ni][i] = 0.f;
}
#define EPI_LOOP(acc, BODY)                                                                   \
  {                                                                                           \
    const int e_lane = otid() & 63, e_wave = otid() >> 6;                           \
    const int e_wm = e_wave >> 1, e_wn = e_wave & 1, e_r = e_lane & 31, e_h = e_lane >> 5;    \
    _Pragma("unroll") for (int mi = 0; mi < 2; ++mi) _Pragma("unroll") for (int ni = 0; ni < 2; ++ni) \
    _Pragma("unroll") for (int i = 0; i < 16; ++i) {                                         \
      const int row = e_wm * 64 + mi * 32 + (i & 3) + 8 * (i >> 2) + 4 * e_h;                 \
      const int col = e_wn * 64 + ni * 32 + e_r;                                              \
      const float val = acc[mi][ni][i];                                                       \
      BODY                                                                                    \
    }                                                                                         \
  }

template <bool GLUPERM = false>
DI void transpose_tile(const float* __restrict__ src, int K, int N, u16* __restrict__ dst, int tile, float* lds) {
  const int ntn = (N + 63) >> 6;
  const int k0 = (tile / ntn) * 64, n0 = (tile % ntn) * 64;
  const int tid = otid();
  __syncthreads();
  {
    const int r = tid >> 4, c4 = (tid & 15) * 4;
#pragma unroll
    for (int i = 0; i < 4; ++i) {
      const int kk = r + 16 * i;
      float4 v = make_float4(0.f, 0.f, 0.f, 0.f);
      if (n0 + c4 < N) v = *(const float4*)(src + (size_t)(k0 + kk) * N + n0 + c4);
      lds[kk * 65 + c4 + 0] = v.x; lds[kk * 65 + c4 + 1] = v.y; lds[kk * 65 + c4 + 2] = v.z; lds[kk * 65 + c4 + 3] = v.w;
    }
  }
  __syncthreads();
  {
    const int n = tid >> 2, kc = (tid & 3) * 16;
    if (n0 + n < N) {
      unsigned w[8];
#pragma unroll
      for (int j = 0; j < 8; ++j) w[j] = cvtpk(lds[(kc + 2 * j) * 65 + n], lds[(kc + 2 * j + 1) * 65 + n]);
      int nd = n0 + n;
      if (GLUPERM) { const int ca = nd & 511; nd = (ca >> 6) * 128 + ((ca >> 5) & 1) * 64 + (nd >= 512 ? 32 : 0) + (ca & 31); }
      uint4* d = (uint4*)(dst + (size_t)nd * K + k0 + kc);
      d[0] = make_uint4(w[0], w[1], w[2], w[3]);
      d[1] = make_uint4(w[4], w[5], w[6], w[7]);
    }
  }
}
DI void convert_chunk(const float* __restrict__ src, u16* __restrict__ dst, size_t chunk) {
  const size_t o = chunk * 2048 + (size_t)otid() * 8;
  const float4 a = *(const float4*)(src + o), b = *(const float4*)(src + o + 4);
  *(uint4*)(dst + o) = make_uint4(cvtpk(a.x, a.y), cvtpk(a.z, a.w), cvtpk(b.x, b.y), cvtpk(b.z, b.w));
}

DI void convert_chunk_fp8(const float* __restrict__ src, unsigned char* __restrict__ dst, size_t chunk, float scale) {
  const size_t o = chunk * 2048 + (size_t)otid() * 8;
  const float4 a = *(const float4*)(src + o), b = *(const float4*)(src + o + 4);
  int w0 = 0, w1 = 0;
  w0 = __builtin_amdgcn_cvt_pk_fp8_f32(a.x * scale, a.y * scale, w0, false); w0 = __builtin_amdgcn_cvt_pk_fp8_f32(a.z * scale, a.w * scale, w0, true);
  w1 = __builtin_amdgcn_cvt_pk_fp8_f32(b.x * scale, b.y * scale, w1, false); w1 = __builtin_amdgcn_cvt_pk_fp8_f32(b.z * scale, b.w * scale, w1, true);
  *(uint2*)(dst + o) = make_uint2((unsigned)w0, (unsigned)w1);
}

DI void ln_mod_row(const float* __restrict__ hrow, const float* __restrict__ shift, const float* __restrict__ scale, u16* __restrict__ dst, float* red) {
  const int tid = otid();
  const float4 x = *(const float4*)(hrow + tid * 4);
  const float mean = block_sum(x.x + x.y + x.z + x.w, red) * (1.f / DM);
  const float a = x.x - mean, b = x.y - mean, c = x.z - mean, d = x.w - mean;
  const float var = block_sum(a * a + b * b + c * c + d * d, red) * (1.f / DM);
  const float rs = rsqrtf(var + LN_EPS);
  const float4 sh = *(const float4*)(shift + tid * 4), sc = *(const float4*)(scale + tid * 4);
  const float y0 = a * rs * (1.f + sc.x) + sh.x, y1 = b * rs * (1.f + sc.y) + sh.y, y2 = c * rs * (1.f + sc.z) + sh.z, y3 = d * rs * (1.f + sc.w) + sh.w;
  *(uint2*)(dst + tid * 4) = make_uint2(cvtpk(y0, y1), cvtpk(y2, y3));
}

DI void ln_mod_wave(const float* __restrict__ hrow, const float* __restrict__ shift, const float* __restrict__ scale, u16* __restrict__ dst, int lane) {
  float4 x[4];
#pragma unroll
  for (int i = 0; i < 4; ++i) x[i] = *(const float4*)(hrow + lane * 4 + 256 * i);
  float sm = 0.f;
#pragma unroll
  for (int i = 0; i < 4; ++i) sm += x[i].x + x[i].y + x[i].z + x[i].w;
  const float mean = wave_sum(sm) * (1.f / DM);
  float vs = 0.f;
#pragma unroll
  for (int i = 0; i < 4; ++i) { x[i].x -= mean; x[i].y -= mean; x[i].z -= mean; x[i].w -= mean; vs += x[i].x * x[i].x + x[i].y * x[i].y + x[i].z * x[i].z + x[i].w * x[i].w; }
  const float rs = rsqrtf(wave_sum(vs) * (1.f / DM) + LN_EPS);
#pragma unroll
  for (int i = 0; i < 4; ++i) {
    const float4 sh = *(const float4*)(shift + lane * 4 + 256 * i), sc = *(const float4*)(scale + lane * 4 + 256 * i);
    *(uint2*)(dst + lane * 4 + 256 * i) = make_uint2(cvtpk(x[i].x * rs * (1.f + sc.x) + sh.x, x[i].y * rs * (1.f + sc.y) + sh.y), cvtpk(x[i].z * rs * (1.f + sc.z) + sh.z, x[i].w * rs * (1.f + sc.w) + sh.w));
  }
}

template <int VD>
DI void attn_pass(const u16* __restrict__ qrow, const u16* __restrict__ Kb, int ldk, const u16* __restrict__ Vt, int nkeys, f32x16 (&O)[VD / 32], float& lsum, u16* lds) {
  constexpr int NV = VD / 32;
  const int tid = otid(), lane = tid & 63, r32 = lane & 31, h = lane >> 5;
  constexpr int BUF = (64 + VD) * 72;
  bf16x8 qf[4];
#pragma unroll
  for (int s = 0; s < 4; ++s) qf[s] = *(const bf16x8*)(qrow + s * 16 + h * 8);
#pragma unroll
  for (int vb = 0; vb < NV; ++vb)
#pragma unroll
    for (int i = 0; i < 16; ++i) O[vb][i] = 0.f;
  float m = -INFINITY, l = 0.f;
  const float c = 0.125f * LOG2E;
  const int lr = tid >> 3, lc = (tid & 7) * 8;
  u32x4 rk[2], rv[NV];
#pragma unroll
  for (int i = 0; i < 2; ++i) rk[i] = *(const u32x4*)(Kb + (size_t)(lr + 32 * i) * ldk + lc);
#pragma unroll
  for (int i = 0; i < NV; ++i) rv[i] = *(const u32x4*)(Vt + (size_t)(lr + 32 * i) * NP + lc);
  __syncthreads();
#pragma unroll
  for (int i = 0; i < 2; ++i) *(u32x4*)(lds + (lr + 32 * i) * 72 + lc) = rk[i];
#pragma unroll
  for (int i = 0; i < NV; ++i) *(u32x4*)(lds + 64 * 72 + (lr + 32 * i) * 72 + lc) = rv[i];
  __syncthreads();
  if (64 < nkeys) {
#pragma unroll
    for (int i = 0; i < 2; ++i) rk[i] = *(const u32x4*)(Kb + (size_t)(64 + lr + 32 * i) * ldk + lc);
#pragma unroll
    for (int i = 0; i < NV; ++i) rv[i] = *(const u32x4*)(Vt + (size_t)(lr + 32 * i) * NP + 64 + lc);
  }
  for (int k0 = 0; k0 < nkeys; k0 += 64) {
    u16* Ks = lds + ((k0 >> 6) & 1) * BUF; u16* Vs = Ks + 64 * 72;
    f32x16 S[2];
#pragma unroll
    for (int kb = 0; kb < 2; ++kb)
#pragma unroll
      for (int i = 0; i < 16; ++i) S[kb][i] = 0.f;
#pragma unroll
    for (int s = 0; s < 4; ++s)
#pragma unroll
      for (int kb = 0; kb < 2; ++kb) {
        const bf16x8 kf = *(const bf16x8*)(Ks + (kb * 32 + r32) * 72 + s * 16 + h * 8);
        S[kb] = MFMA32(kf, qf[s], S[kb]);
      }
    float mx = S[0][0];
#pragma unroll
    for (int kb = 0; kb < 2; ++kb)
#pragma unroll
      for (int i = 0; i < 16; ++i) mx = fmaxf(mx, S[kb][i]);
    mx = fmaxf(mx, SHX(mx, 32));
    if (__ballot(mx > m + 40.f) != 0ull) {
      const float mn = fmaxf(m, mx);
      const float alpha = fexp2((m - mn) * c);
      m = mn;
      l *= alpha;
#pragma unroll
      for (int vb = 0; vb < NV; ++vb)
#pragma unroll
        for (int i = 0; i < 16; ++i) O[vb][i] *= alpha;
    }
    const float mc = m * c;
    float rs = 0.f;
#pragma unroll
    for (int kb = 0; kb < 2; ++kb)
#pragma unroll
      for (int i = 0; i < 16; ++i) { const float pv = fexp2(S[kb][i] * c - mc); S[kb][i] = pv; rs += pv; }
    l += rs;
#pragma unroll
    for (int kb = 0; kb < 2; ++kb)
#pragma unroll
      for (int s2 = 0; s2 < 2; ++s2) {
        uint4 pw;
        pw.x = cvtpk(S[kb][8 * s2 + 0], S[kb][8 * s2 + 1]); pw.y = cvtpk(S[kb][8 * s2 + 2], S[kb][8 * s2 + 3]);
        pw.z = cvtpk(S[kb][8 * s2 + 4], S[kb][8 * s2 + 5]); pw.w = cvtpk(S[kb][8 * s2 + 6], S[kb][8 * s2 + 7]);
        const bf16x8 pf = __builtin_bit_cast(bf16x8, pw);
#pragma unroll
        for (int vb = 0; vb < NV; ++vb) {
          const u16* vp = Vs + (vb * 32 + r32) * 72 + kb * 32 + s2 * 16 + 4 * h;
          const s16x4 lo = *(const s16x4*)vp, hi = *(const s16x4*)(vp + 8);
          const bf16x8 vf = __builtin_shufflevector(lo, hi, 0, 1, 2, 3, 4, 5, 6, 7);
          O[vb] = MFMA32(vf, pf, O[vb]);
        }
      }
    if (k0 + 64 < nkeys) {
      u16* Kn = lds + (((k0 >> 6) + 1) & 1) * BUF;
#pragma unroll
      for (int i = 0; i < 2; ++i) *(u32x4*)(Kn + (lr + 32 * i) * 72 + lc) = rk[i];
#pragma unroll
      for (int i = 0; i < NV; ++i) *(u32x4*)(Kn + 64 * 72 + (lr + 32 * i) * 72 + lc) = rv[i];
    }
    __syncthreads();
    if (k0 + 128 < nkeys) {
#pragma unroll
      for (int i = 0; i < 2; ++i) rk[i] = *(const u32x4*)(Kb + (size_t)(k0 + 128 + lr + 32 * i) * ldk + lc);
#pragma unroll
      for (int i = 0; i < NV; ++i) rv[i] = *(const u32x4*)(Vt + (size_t)(lr + 32 * i) * NP + k0 + 128 + lc);
    }
  }
  lsum = l + SHX(l, 32);
}

DI void attn_pass_gqa2(const u16* __restrict__ qrow0, const u16* __restrict__ qrow1, const u16* __restrict__ Kb, int ldk, const u16* __restrict__ Vt, int nkeys,
                       f32x16 (&O)[2][2], float (&lsum)[2], u16* lds) {
  const int tid = otid(), lane = tid & 63, r32 = lane & 31, h = lane >> 5;
  constexpr int BUF = 128 * 72;
  bf16x8 qf[2][4];
#pragma unroll
  for (int s = 0; s < 4; ++s) { qf[0][s] = *(const bf16x8*)(qrow0 + s * 16 + h * 8); qf[1][s] = *(const bf16x8*)(qrow1 + s * 16 + h * 8); }
#pragma unroll
  for (int hd = 0; hd < 2; ++hd)
#pragma unroll
    for (int vb = 0; vb < 2; ++vb)
#pragma unroll
      for (int i = 0; i < 16; ++i) O[hd][vb][i] = 0.f;
  float m[2] = {-INFINITY, -INFINITY}, l[2] = {0.f, 0.f};
  const float c = 0.125f * LOG2E;
  const int lr = tid >> 3, lc = (tid & 7) * 8;
  u32x4 rk[2], rv[2];
#pragma unroll
  for (int i = 0; i < 2; ++i) rk[i] = *(const u32x4*)(Kb + (size_t)(lr + 32 * i) * ldk + lc);
#pragma unroll
  for (int i = 0; i < 2; ++i) rv[i] = *(const u32x4*)(Vt + (size_t)(lr + 32 * i) * NP + lc);
  __syncthreads();
#pragma unroll
  for (int i = 0; i < 2; ++i) *(u32x4*)(lds + (lr + 32 * i) * 72 + lc) = rk[i];
#pragma unroll
  for (int i = 0; i < 2; ++i) *(u32x4*)(lds + 64 * 72 + (lr + 32 * i) * 72 + lc) = rv[i];
  __syncthreads();
  if (64 < nkeys) {
#pragma unroll
    for (int i = 0; i < 2; ++i) rk[i] = *(const u32x4*)(Kb + (size_t)(64 + lr + 32 * i) * ldk + lc);
#pragma unroll
    for (int i = 0; i < 2; ++i) rv[i] = *(const u32x4*)(Vt + (size_t)(lr + 32 * i) * NP + 64 + lc);
  }
  for (int k0 = 0; k0 < nkeys; k0 += 64) {
    u16* Ks = lds + ((k0 >> 6) & 1) * BUF; u16* Vs = Ks + 64 * 72;
#pragma unroll
    for (int hd = 0; hd < 2; ++hd) {
      f32x16 S[2];
#pragma unroll
      for (int kb = 0; kb < 2; ++kb)
#pragma unroll
        for (int i = 0; i < 16; ++i) S[kb][i] = 0.f;
#pragma unroll
      for (int s = 0; s < 4; ++s)
#pragma unroll
        for (int kb = 0; kb < 2; ++kb) {
          const bf16x8 kf = *(const bf16x8*)(Ks + (kb * 32 + r32) * 72 + s * 16 + h * 8);
          S[kb] = MFMA32(kf, qf[hd][s], S[kb]);
        }
      float mx = S[0][0];
#pragma unroll
      for (int kb = 0; kb < 2; ++kb)
#pragma unroll
        for (int i = 0; i < 16; ++i) mx = fmaxf(mx, S[kb][i]);
      mx = fmaxf(mx, SHX(mx, 32));
      if (__ballot(mx > m[hd] + 40.f) != 0ull) {
        const float mn = fmaxf(m[hd], mx);
        const float alpha = fexp2((m[hd] - mn) * c);
        m[hd] = mn;
        l[hd] *= alpha;
#pragma unroll
        for (int vb = 0; vb < 2; ++vb)
#pragma unroll
          for (int i = 0; i < 16; ++i) O[hd][vb][i] *= alpha;
      }
      const float mc = m[hd] * c;
      float rs = 0.f;
#pragma unroll
      for (int kb = 0; kb < 2; ++kb)
#pragma unroll
        for (int i = 0; i < 16; ++i) { const float pv = fexp2(S[kb][i] * c - mc); S[kb][i] = pv; rs += pv; }
      l[hd] += rs;
#pragma unroll
      for (int kb = 0; kb < 2; ++kb)
#pragma unroll
        for (int s2 = 0; s2 < 2; ++s2) {
          uint4 pw;
          pw.x = cvtpk(S[kb][8 * s2 + 0], S[kb][8 * s2 + 1]); pw.y = cvtpk(S[kb][8 * s2 + 2], S[kb][8 * s2 + 3]);
          pw.z = cvtpk(S[kb][8 * s2 + 4], S[kb][8 * s2 + 5]); pw.w = cvtpk(S[kb][8 * s2 + 6], S[kb][8 * s2 + 7]);
          const bf16x8 pf = __builtin_bit_cast(bf16x8, pw);
#pragma unroll
          for (int vb = 0; vb < 2; ++vb) {
            const u16* vp = Vs + (vb * 32 + r32) * 72 + kb * 32 + s2 * 16 + 4 * h;
            const s16x4 lo = *(const s16x4*)vp, hi = *(const s16x4*)(vp + 8);
            const bf16x8 vf = __builtin_shufflevector(lo, hi, 0, 1, 2, 3, 4, 5, 6, 7);
            O[hd][vb] = MFMA32(vf, pf, O[hd][vb]);
          }
        }
    }
    if (k0 + 64 < nkeys) {
      u16* Kn = lds + (((k0 >> 6) + 1) & 1) * BUF;
#pragma unroll
      for (int i = 0; i < 2; ++i) *(u32x4*)(Kn + (lr + 32 * i) * 72 + lc) = rk[i];
#pragma unroll
      for (int i = 0; i < 2; ++i) *(u32x4*)(Kn + 64 * 72 + (lr + 32 * i) * 72 + lc) = rv[i];
    }
    __syncthreads();
    if (k0 + 128 < nkeys) {
#pragma unroll
      for (int i = 0; i < 2; ++i) rk[i] = *(const u32x4*)(Kb + (size_t)(k0 + 128 + lr + 32 * i) * ldk + lc);
#pragma unroll
      for (int i = 0; i < 2; ++i) rv[i] = *(const u32x4*)(Vt + (size_t)(lr + 32 * i) * NP + k0 + 128 + lc);
    }
  }
  lsum[0] = l[0] + SHX(l[0], 32);
  lsum[1] = l[1] + SHX(l[1], 32);
}

DI int chain_idx(int dir, int s) { return dir == 0 ? (s < SL ? s + SC : s - SL) : (SB - 1 - s); }
DI void mlstm_dir(const bf16x8 (&qf)[8], const u16* __restrict__ Kb, const u16* __restrict__ Vt, const float* __restrict__ Aarr, const float* __restrict__ tmax, int dir,
                  int t0a, int t0b, int t1a, int t1b, int cq, float mxq, f32x16 (&num)[4], float& den_out, char* smem) {
  const int tid = otid(), lane = tid & 63, r32 = lane & 31, h = lane >> 5;
  u16* Ks = (u16*)smem; u16* Vs = (u16*)(smem + 17408); float* As = (float*)(smem + 17408 + 18432);
  float den = 0.f;
  const int n0 = t0b - t0a, nall = n0 + (t1b - t1a);
  const int kr = tid >> 4, kc = (tid & 15) * 8, vr = tid >> 3, vc = (tid & 7) * 8;
  u32x4 rk[4], rv[4]; float ra = 0.f;
  int* tlist = (int*)(smem + 17408 + 18432 + 256);
  float* tred = (float*)(smem + 17408 + 18432 + 256 + 544);
  {
    float mn = fminf(mxq, SHX(mxq, 32));
    mn = fminf(mn, SHX(mn, 16)); mn = fminf(mn, SHX(mn, 8)); mn = fminf(mn, SHX(mn, 4)); mn = fminf(mn, SHX(mn, 2)); mn = fminf(mn, SHX(mn, 1));
    __syncthreads();
    if (lane == 0) tred[tid >> 6] = mn;
    __syncthreads();
    if (tid == 0) {
      const float bmin = fminf(fminf(tred[0], tred[1]), fminf(tred[2], tred[3]));
      int cnt = 0;
      for (int u = 0; u < nall; ++u) {
        const int k0 = u < n0 ? SL + 64 * (t0a + u) : 64 * (t1a + u - n0);
        if (tmax[k0 >> 6] * LOG2E - bmin > -64.f) tlist[1 + cnt++] = k0;
      }
      tlist[0] = cnt;
    }
    __syncthreads();
  }
  const int ntile = tlist[0];
  auto tile_k0 = [&](int u) { return tlist[1 + u]; };
  for (int u = 0; u < ntile; ++u) {
    const int k0 = tile_k0(u);
    __syncthreads();
    {
#pragma unroll
      for (int i = 0; i < 4; ++i) rk[i] = *(const u32x4*)(Kb + (size_t)(k0 + kr + 16 * i) * 512 + kc);
#pragma unroll
      for (int i = 0; i < 4; ++i) rv[i] = *(const u32x4*)(Vt + (size_t)(vr + 32 * i) * NP + k0 + vc);
      if (tid < 64) ra = Aarr[k0 + tid] * LOG2E;
#pragma unroll
      for (int i = 0; i < 4; ++i) *(u32x4*)(Ks + (kr + 16 * i) * 136 + kc) = rk[i];
#pragma unroll
      for (int i = 0; i < 4; ++i) *(u32x4*)(Vs + (vr + 32 * i) * 72 + vc) = rv[i];
      if (tid < 64) As[tid] = ra;
    }
    __syncthreads();
    f32x16 S[2];
#pragma unroll
    for (int kb = 0; kb < 2; ++kb)
#pragma unroll
      for (int i = 0; i < 16; ++i) S[kb][i] = 0.f;
#pragma unroll
    for (int s = 0; s < 8; ++s)
#pragma unroll
      for (int kb = 0; kb < 2; ++kb) {
        const bf16x8 kf = *(const bf16x8*)(Ks + (kb * 32 + r32) * 136 + s * 16 + h * 8);
        S[kb] = MFMA32(kf, qf[s], S[kb]);
      }
#pragma unroll
    for (int kb = 0; kb < 2; ++kb)
#pragma unroll
      for (int g = 0; g < 4; ++g) {
        const float4 a4 = *(const float4*)(As + kb * 32 + 8 * g + 4 * h);
        const float av[4] = {a4.x, a4.y, a4.z, a4.w};
#pragma unroll
        for (int e = 0; e < 4; ++e) {
          const int sk = k0 + kb * 32 + 8 * g + 4 * h + e;
          const int ck = chain_idx(dir, sk);
          const float w = (ck <= cq) ? fexp2(fminf(av[e] - mxq, 0.f)) : 0.f;
          const float pv = S[kb][4 * g + e] * w;
          S[kb][4 * g + e] = pv; den += pv;
        }
      }
#pragma unroll
    for (int kb = 0; kb < 2; ++kb)
#pragma unroll
      for (int s2 = 0; s2 < 2; ++s2) {
        uint4 pw;
        pw.x = cvtpk(S[kb][8 * s2 + 0], S[kb][8 * s2 + 1]); pw.y = cvtpk(S[kb][8 * s2 + 2], S[kb][8 * s2 + 3]);
        pw.z = cvtpk(S[kb][8 * s2 + 4], S[kb][8 * s2 + 5]); pw.w = cvtpk(S[kb][8 * s2 + 6], S[kb][8 * s2 + 7]);
        const bf16x8 pf = __builtin_bit_cast(bf16x8, pw);
#pragma unroll
        for (int vb = 0; vb < 4; ++vb) {
          const u16* vp = Vs + (vb * 32 + r32) * 72 + kb * 32 + s2 * 16 + 4 * h;
          const s16x4 lo = *(const s16x4*)vp, hi = *(const s16x4*)(vp + 8);
          const bf16x8 vf = __builtin_shufflevector(lo, hi, 0, 1, 2, 3, 4, 5, 6, 7);
          num[vb] = MFMA32(vf, pf, num[vb]);
        }
      }
  }
  den_out += den + SHX(den, 32);
}

DI void s5_load_u(const u16* __restrict__ S5U, int b, int lo, int g, float* lu, int lane) {
  const u16* src = S5U + ((size_t)b * SB + lo + lane) * 512 + g * 16;
  const uint4 a = *(const uint4*)src, c = *(const uint4*)(src + 8);
  float* d = lu + lane * 16;
  d[0] = bflo(a.x); d[1] = bfhi(a.x); d[2] = bflo(a.y); d[3] = bfhi(a.y); d[4] = bflo(a.z); d[5] = bfhi(a.z); d[6] = bflo(a.w); d[7] = bfhi(a.w);
  d[8] = bflo(c.x); d[9] = bfhi(c.x); d[10] = bflo(c.y); d[11] = bfhi(c.y); d[12] = bflo(c.z); d[13] = bfhi(c.z); d[14] = bflo(c.w); d[15] = bfhi(c.w);
}

DI void s5_bu_half(const u16* __restrict__ urow, const bf16x8 (&bfr)[4], u16* W, int r32, int h) {
  const bf16x8 af = *(const bf16x8*)urow;
#pragma unroll
  for (int j = 0; j < 4; ++j) {
    f32x16 z;
#pragma unroll
    for (int i = 0; i < 16; ++i) z[i] = 0.f;
    const f32x16 acc = MFMA32(af, bfr[j], z);
#pragma unroll
    for (int i = 0; i < 16; ++i) W[((i & 3) + 8 * (i >> 2) + 4 * h) * 136 + 32 * j + r32] = f2bf(acc[i]);
  }
}
template <bool WB>
DI void s5_scan_half(u16* W, int dir, int recol, float2 lam, float& hr, float& hi) {
#pragma unroll 4
  for (int q = 0; q < 32; ++q) {
    const int t = dir ? 31 - q : q;
    const float br = bf2f(W[t * 136 + recol]), bi = bf2f(W[t * 136 + recol + 32]);
    const float nr = lam.x * hr - lam.y * hi + br, ni = lam.x * hi + lam.y * hr + bi;
    hr = nr; hi = ni;
    if (WB) { W[t * 136 + recol] = f2bf(hr); W[t * 136 + recol + 32] = f2bf(hi); }
  }
}

__device__ const unsigned char PEER_PAIRS[64] = {0, 1, 2, 3, 4, 5, 6, 7, 8, 9, 10, 11, 12, 13, 14, 15, 16, 17, 18, 19, 20, 21, 22, 23, 32, 33, 34, 35, 36, 48, 49, 50, 51, 64, 65, 66, 80, 81, 96, 97, 112, 113, 128, 144, 160, 176, 192, 208, 224, 240, 0, 0, 0, 0, 0, 0, 0, 0, 0, 0, 0, 0, 0, 0};

constexpr int NPH_LAYER = 14;
constexpr int NPHASES = 2 + 2 * NPH_LAYER;

__device__ __forceinline__ void run_phase(const P& p, int ph, char* smem) {
  const int tid = otid(), lane = tid & 63, wave = tid >> 6;
  const int G = gridDim.x, bid = blockIdx.x;
  char* ws = WSP;
  float* fsm = (float*)smem;
  u16* usm = (u16*)smem;

  if (ph == 0) {
    const int n_mod = 2 * 8 * 24, n_s5 = 32, n_all = n_mod + n_s5 + 2;
    for (int it = bid; it < n_all; it += G) {
      if (it < n_mod) {
        const int L = it / 192, ic = (it / 24) % 8, jc = it % 24;
        __syncthreads();
        for (int e = tid; e < 5 * 128; e += 256) {
          const int v = e / 128, i = ic * 128 + (e % 128);
          const float cv = v < 4 ? IN(1)[v * DM + i] : IN(3)[i];
          fsm[e] = silu_(cv);
        }
        __syncthreads();
        const int j = jc * 256 + tid;
        const float* w = IN(4) + ((size_t)L * DM + ic * 128) * 6144 + j;
        float a0 = 0, a1 = 0, a2 = 0, a3 = 0, a4 = 0;
#pragma unroll 8
        for (int i = 0; i < 128; ++i) {
          const float wv = w[(size_t)i * 6144];
          a0 += fsm[i] * wv; a1 += fsm[128 + i] * wv; a2 += fsm[256 + i] * wv; a3 += fsm[384 + i] * wv; a4 += fsm[512 + i] * wv;
        }
        float* o = (float*)(ws + OFF_MODP) + ((size_t)(L * 8 + ic) * 5) * 6144 + j;
        o[0] = a0; o[6144] = a1; o[2 * 6144] = a2; o[3 * 6144] = a3; o[4 * 6144] = a4;
      } else if (it < n_mod + n_s5) {
        const int e = (it - n_mod) * 256 + tid;
        const int n = e & 63, g = (e >> 6) & 31, ld = e >> 11;
        const float dt = expf(IN(14)[ld * 32 + g]);
        const float ar = IN(12)[e], ai = IN(13)[e];
        const float mag = expf(ar * dt);
        float sn, cs; sincosf(ai * dt, &sn, &cs);
        const float lr = mag * cs, li = mag * sn;
        const float dn = ar * ar + ai * ai;
        const float cr = ((lr - 1.f) * ar + li * ai) / dn, ci = (li * ar - (lr - 1.f) * ai) / dn;
        ((float2*)(ws + OFF_LAMB))[e] = make_float2(lr, li);
        float2* bb = (float2*)(ws + OFF_BBAR) + (size_t)e * 16;
        const float* br = IN(15) + (size_t)e * 16; const float* bi = IN(16) + (size_t)e * 16;
        const int colre = n < 32 ? n : n + 32, colim = colre + 32;
        u16* bbt = (u16*)(ws + OFF_BBT) + (size_t)(e >> 6) * 2048;
        u16* cmt = (u16*)(ws + OFF_CMT) + (size_t)(e >> 6) * 2048;
        for (int c = 0; c < 16; ++c) {
          const float2 v = make_float2(cr * br[c] - ci * bi[c], cr * bi[c] + ci * br[c]);
          bb[c] = v;
          bbt[colre * 16 + c] = f2bf(v.x); bbt[colim * 16 + c] = f2bf(v.y);
          cmt[c * 128 + colre] = f2bf(IN(17)[((size_t)(e >> 6) * 16 + c) * 64 + n]);
          cmt[c * 128 + colim] = f2bf(-IN(18)[((size_t)(e >> 6) * 16 + c) * 64 + n]);
        }
      } else if (it == n_mod + n_s5 + 1) {
        for (int e = tid; e < 192 * 16; e += 256) {
          const int r = e >> 4, i = e & 15;
          const float inv = exp2f(-(float)i * (13.287712379549449f / 16.f));
          float sn, cs; sincosf((float)(r < 128 ? r : r - 128) * inv, &sn, &cs);
          ((float2*)(ws + OFF_ROPE))[e] = make_float2(cs, sn);
        }
      } else {
        if (tid >= 64 && tid < 72) ((int*)(ws + OFF_CTR))[tid - 64] = 0;
        if (tid < 2) {
          const float* lv = IN(8) + tid * 256;
          float s01 = 0.f, s23 = 0.f;
          for (int i = 0; i < 64; ++i) { s01 += lv[i] * lv[64 + i]; s23 += lv[128 + i] * lv[192 + i]; }
          const float lam_init = 0.8f - 0.6f * expf(-0.3f * (float)tid);
          ((float*)(ws + OFF_LAMV))[tid] = expf(s01) - expf(s23) + lam_init;
        }
      }
    }
    return;
  }
  if (ph == 1) {
    const int n_all = 2 * 5 * 6144 / 256;
    for (int it = bid; it < n_all; it += G) {
      const int e = it * 256 + tid;
      const int L = e / (5 * 6144), v = (e / 6144) % 5, j = e % 6144;
      float a = IN(5)[L * 6144 + j];
      for (int ic = 0; ic < 8; ++ic) a += ((const float*)(ws + OFF_MODP))[((size_t)(L * 8 + ic) * 5 + v) * 6144 + j];
      ((float*)(ws + OFF_MOD))[e] = a;
    }
    return;
  }
  const int L = (ph - 2) / NPH_LAYER, k = (ph - 2) % NPH_LAYER;
  u16* XM = (u16*)(ws + OFF_A);
  u16* WinT = (u16*)(ws + OFF_WIN);

  int* s_next = (int*)(smem + 57336);
#define FETCH_ITEM() ([&]() { __syncthreads(); if (otid() == 0) *s_next = atomicAdd(ctr, 1); __syncthreads(); return *s_next; }())
  if (k == 0) {
    const int n_win = 16 * 141, n_wbr = 4 * 8 * 16, n_wo = 256, n_wg = 128, n_wq = 512, n_sk = 16;
    const int n_w = n_win + n_wbr + n_wo + n_wg + n_wq + n_sk;
    const int n_all = n_w + NP / 4;
    for (int it = bid; it < n_all; it += G) {
      if (it < n_w) {
        int t = it;
        if (t < n_win) { transpose_tile(IN(6) + (size_t)L * DM * NIN, DM, NIN, WinT, t, fsm); continue; }
        t -= n_win;
        if (t < n_wbr) { const int kb = t / 128; transpose_tile(IN(26) + ((size_t)L * 4 + kb) * 512 * DM, 512, DM, (u16*)(ws + OFF_WBR) + (size_t)kb * DM * 512, t % 128, fsm); continue; }
        t -= n_wbr;
        if (t < n_wo) { transpose_tile(IN(27) + (size_t)L * DM * DM, DM, DM, (u16*)(ws + OFF_WO), t, fsm); continue; }
        t -= n_wo;
        if (t < n_wg) { transpose_tile<true>(IN(20) + (size_t)L * 512 * DM, 512, DM, (u16*)(ws + OFF_WGLU), t, fsm); continue; }
        t -= n_wg;
        if (t < n_wq) { transpose_tile(IN(32) + (size_t)L * DM * 2048, DM, 2048, (u16*)(ws + OFF_WQ), t, fsm); continue; }
        t -= n_wq;
        convert_chunk(IN(33) + (size_t)L * 32768, (u16*)(ws + OFF_SK), t);
      } else {
        const int pos = (it - n_w) * 4 + wave;
        const float* md = mod_ptr(p, L, pos);
        ln_mod_wave(h_in_ptr(p, L, pos), md, md + 1024, XM + (size_t)pos * DM, lane);
      }
    }
    return;
  }
  if (k == 1) {
    const int n_all = 264 * 39;
    for (int it = bid; it < n_all; it += G) {
      const int mt = it / 39, j = it % 39;
      f32x16 acc[2][2]; acc_zero(acc);
      if (j < 30) {
        int src; u16* dst; int ldd = 512, dcol;
        if (j < 4) { src = j * 128; dst = (u16*)(ws + OFF_QD); dcol = j * 128; }
        else if (j < 8) { src = 512 + (j - 4) * 128; dst = (u16*)(ws + OFF_KD); dcol = (j - 4) * 128; }
        else if (j < 12) { src = 1536 + (j - 8) * 128; dst = (u16*)(ws + OFF_S5U); dcol = (j - 8) * 128; }
        else if (j < 16) { src = 2048 + (j - 12) * 128; dst = (u16*)(ws + OFF_MQ); dcol = (j - 12) * 128; }
        else if (j < 20) { src = 2560 + (j - 16) * 128; dst = (u16*)(ws + OFF_MK); dcol = (j - 16) * 128; }
        else if (j < 24) { src = 3584 + (j - 20) * 128; dst = (u16*)(ws + OFF_MO); dcol = (j - 20) * 128; }
        else if (j < 28) { src = 4112 + (j - 24) * 128; dst = (u16*)(ws + OFF_QG); dcol = (j - 24) * 128; }
        else if (j == 28) { src = 4624; dst = (u16*)(ws + OFF_KG); dcol = 0; ldd = 128; }
        else { src = 4096; dst = nullptr; dcol = 0; }
        gemm_core(XM + (size_t)mt * 128 * DM, DM, WinT + (size_t)src * DM, DM, DM, acc, usm);
        if (j < 29) {
          EPI_LOOP(acc, { dst[(size_t)(mt * 128 + row) * ldd + dcol + col] = f2bf(val); })
        } else {
          float* mg = (float*)(ws + OFF_MGATE);
          EPI_LOOP(acc, { if (col < 16) mg[(size_t)(mt * 128 + row) * 16 + col] = val; })
        }
      } else {
        const int jj = j - 30;
        int src; u16* dst; int drow;
        if (jj < 4) { src = 1024 + jj * 128; dst = (u16*)(ws + OFF_VDT); drow = jj * 128; }
        else if (jj < 8) { src = 3072 + (jj - 4) * 128; dst = (u16*)(ws + OFF_MVT); drow = (jj - 4) * 128; }
        else { src = 4752; dst = (u16*)(ws + OFF_VGT); drow = 0; }
        gemm_core(WinT + (size_t)src * DM, DM, XM + (size_t)mt * 128 * DM, DM, DM, acc, usm);
        EPI_LOOP(acc, { dst[(size_t)(drow + row) * NP + mt * 128 + col] = f2bf(val); })
      }
    }
    return;
  }
  if (k == 2) {
    const int n_s5 = NB * 2 * 32 * 132 / 4;
    const int n_pp = NP / 4;
    const int n_all = n_pp + n_s5;
    for (int it = bid; it < n_all; it += G) {
      if (it < n_pp) {
        const int pos = it * 4 + wave, b = pos / SB, s = pos - b * SB;
        const bool lat = s < SL;
        const int rrow = s >> 6, rcol = 128 + (s & 63);
        if (lat) {
          const int vec = lane >> 2, half = (lane >> 1) & 1, i0 = (lane & 1) * 8;
          u16* base = (u16*)(ws + (vec < 8 ? OFF_QD : OFF_KD)) + (size_t)pos * 512 + (vec & 7) * 64 + half * 32 + i0;
          const u32x4 a = *(const u32x4*)base, b = *(const u32x4*)(base + 16);
          const float4* tb = (const float4*)((const float2*)(ws + OFF_ROPE) + (half ? rcol : rrow) * 16 + i0);
          const float4 t0 = tb[0], t1 = tb[1], t2 = tb[2], t3 = tb[3];
          const float x1[8] = {bflo(a.x), bfhi(a.x), bflo(a.y), bfhi(a.y), bflo(a.z), bfhi(a.z), bflo(a.w), bfhi(a.w)};
          const float x2[8] = {bflo(b.x), bfhi(b.x), bflo(b.y), bfhi(b.y), bflo(b.z), bfhi(b.z), bflo(b.w), bfhi(b.w)};
          const float cs[8] = {t0.x, t0.z, t1.x, t1.z, t2.x, t2.z, t3.x, t3.z};
          const float sn[8] = {t0.y, t0.w, t1.y, t1.w, t2.y, t2.w, t3.y, t3.w};
          float o1[8], o2[8];
#pragma unroll
          for (int e = 0; e < 8; ++e) { o1[e] = x1[e] * cs[e] - x2[e] * sn[e]; o2[e] = x2[e] * cs[e] + x1[e] * sn[e]; }
          u32x4 w1, w2;
          w1.x = cvtpk(o1[0], o1[1]); w1.y = cvtpk(o1[2], o1[3]); w1.z = cvtpk(o1[4], o1[5]); w1.w = cvtpk(o1[6], o1[7]);
          w2.x = cvtpk(o2[0], o2[1]); w2.y = cvtpk(o2[2], o2[3]); w2.z = cvtpk(o2[4], o2[5]); w2.w = cvtpk(o2[6], o2[7]);
          *(u32x4*)base = w1; *(u32x4*)(base + 16) = w2;
        }
        {
          const int c = lane & 7, hh = c >> 2, ie = (c & 1) * 8;
          const float4* tb = (const float4*)((const float2*)(ws + OFF_ROPE) + (hh ? rcol : rrow) * 16 + ie);
          const float4 t0 = tb[0], t1 = tb[1], t2 = tb[2], t3 = tb[3];
          const float cs[8] = {t0.x, t0.z, t1.x, t1.z, t2.x, t2.z, t3.x, t3.z};
          const float sn[8] = {t0.y, t0.w, t1.y, t1.w, t2.y, t2.w, t3.y, t3.w};
#pragma unroll
          for (int rnd = 0; rnd < 2; ++rnd) {
            const bool act = rnd == 0 || lane < 16;
            const int vec = lane >> 3;
            u16* ptr = rnd == 0 ? (u16*)(ws + OFF_QG) + (size_t)pos * 512 + vec * 64 + c * 8 : (u16*)(ws + OFF_KG) + (size_t)pos * 128 + (vec & 1) * 64 + c * 8;
            const float* gp = (rnd == 0 ? IN(10) : IN(11)) + L * 64 + c * 8;
            const u32x4 a = *(const u32x4*)ptr;
            const float4 g0 = *(const float4*)gp, g1 = *(const float4*)(gp + 4);
            float x[8] = {bflo(a.x), bfhi(a.x), bflo(a.y), bfhi(a.y), bflo(a.z), bfhi(a.z), bflo(a.w), bfhi(a.w)};
            float ss = 0.f;
#pragma unroll
            for (int e = 0; e < 8; ++e) ss += x[e] * x[e];
            ss += SHX(ss, 1); ss += SHX(ss, 2); ss += SHX(ss, 4);
            const float rs = rsqrtf(ss * (1.f / 64.f) + LN_EPS);
            const float gg[8] = {g0.x, g0.y, g0.z, g0.w, g1.x, g1.y, g1.z, g1.w};
            float y[8];
#pragma unroll
            for (int e = 0; e < 8; ++e) y[e] = x[e] * rs * gg[e];
            if (lat) {
#pragma unroll
              for (int e = 0; e < 8; ++e) {
                const float yp = SHX(y[e], 2);
                x[e] = (c & 2) ? (y[e] * cs[e] + yp * sn[e]) : (y[e] * cs[e] - yp * sn[e]);
              }
#pragma unroll
              for (int e = 0; e < 8; ++e) y[e] = x[e];
            }
            if (act) { u32x4 w; w.x = cvtpk(y[0], y[1]); w.y = cvtpk(y[2], y[3]); w.z = cvtpk(y[4], y[5]); w.w = cvtpk(y[6], y[7]); *(u32x4*)ptr = w; }
          }
        }
        {
          const int seg_lo = lat ? 0 : SL, seg_hi = lat ? SL - 1 : SB - 1;
#pragma unroll
          for (int q = 0; q < 4; ++q) {
            const int ch = (lane + 64 * q) * 4;
            const u16* raw = (const u16*)(ws + (ch < 512 ? OFF_MQ : OFF_MK)) + (ch & 511);
            const uint2 xc = *(const uint2*)(raw + (size_t)pos * 512);
            uint2 xm = make_uint2(0, 0), xp = make_uint2(0, 0);
            if (s > seg_lo) xm = *(const uint2*)(raw + (size_t)(pos - 1) * 512);
            if (s < seg_hi) xp = *(const uint2*)(raw + (size_t)(pos + 1) * 512);
            const float* cw = IN(22) + (size_t)L * 3 * 1024 + ch; const float* cb = IN(23) + (size_t)L * 1024 + ch;
            const float4 w0 = *(const float4*)cw, w1 = *(const float4*)(cw + 1024), w2 = *(const float4*)(cw + 2048), bb = *(const float4*)cb;
            float o0 = bb.x + w0.x * bflo(xm.x) + w1.x * bflo(xc.x) + w2.x * bflo(xp.x);
            float o1 = bb.y + w0.y * bfhi(xm.x) + w1.y * bfhi(xc.x) + w2.y * bfhi(xp.x);
            float o2 = bb.z + w0.z * bflo(xm.y) + w1.z * bflo(xc.y) + w2.z * bflo(xp.y);
            float o3 = bb.w + w0.w * bfhi(xm.y) + w1.w * bfhi(xc.y) + w2.w * bfhi(xp.y);
            const float ksc = ch < 512 ? 1.f : 0.08838834764831845f;
            o0 = silu_(o0) * ksc; o1 = silu_(o1) * ksc; o2 = silu_(o2) * ksc; o3 = silu_(o3) * ksc;
            u16* dstc = (u16*)(ws + OFF_A) + (ch < 512 ? (size_t)0 : (size_t)NP * 512) + (size_t)pos * 512 + (ch & 511);
            *(uint2*)dstc = make_uint2(cvtpk(o0, o1), cvtpk(o2, o3));
          }
        }
        if (lane < 16) {
          const float g = ((const float*)(ws + OFF_MGATE))[(size_t)pos * 16 + lane] + IN(24)[L * 16 + lane];
          const int type = lane >> 2, head = lane & 3, dir = type >> 1;
          const int chain = dir * 16 + b * 4 + head;
          if (type & 1) ((float*)(ws + OFF_GF))[(size_t)chain * SB + s] = fminf(g, 0.f) - log1pf(expf(-fabsf(g)));
          else ((float*)(ws + OFF_GI))[(size_t)chain * SB + s] = g;
        }
      } else {
        const int item = (it - n_pp) * 4 + wave;
        const int kk = item % 132, g = (item / 132) & 31, dir = (item / (132 * 32)) & 1, b = item / (132 * 64);
        const int lo = dir == 0 ? (kk < 4 ? SL + 64 * kk : 64 * (kk - 4)) : (kk < 4 ? SL + 192 - 64 * kk : 8128 - 64 * (kk - 4));
        const int r32 = lane & 31, h = lane >> 5;
        const int ldg = (L * 2 + dir) * 32 + g;
        u16* W = usm + wave * 4352;
        __syncthreads();
        const float2 lam = ((const float2*)(ws + OFF_LAMB))[ldg * 64 + lane];
        bf16x8 bfr[4];
#pragma unroll
        for (int j = 0; j < 4; ++j) bfr[j] = *(const bf16x8*)((const u16*)(ws + OFF_BBT) + ((size_t)ldg * 128 + 32 * j + r32) * 16 + 8 * h);
        const int recol = lane < 32 ? lane : lane + 32;
        float hr = 0.f, hi = 0.f;
#pragma unroll 1
        for (int hq = 0; hq < 2; ++hq) {
          const int hh = dir ? 1 - hq : hq;
          s5_bu_half((const u16*)(ws + OFF_S5U) + ((size_t)b * SB + lo + 32 * hh + r32) * 512 + g * 16 + 8 * h, bfr, W, r32, h);
          s5_scan_half<false>(W, dir, recol, lam, hr, hi);
        }
        ((float2*)(ws + OFF_HEND))[(size_t)item * 64 + lane] = make_float2(hr, hi);
      }
    }
    return;
  }
  if (k == 3) {
    const int n_all = 32 + 64 + 1056;
    for (int it = bid; it < n_all; it += G) {
      if (it >= 96) {
        const int i2 = it - 96, chain = i2 / 33, j = i2 % 33, dir = chain >> 4, b = (chain >> 2) & 3, head = chain & 3;
        const int p0 = j == 0 ? SL : (dir == 0 ? 256 * (j - 1) : SL - 256 * j);
        const int r32 = lane & 31, h = lane >> 5;
        u16* Ks = usm;
        float* wS = fsm + 4352;
        float* red = fsm + 4352 + 256;
        __syncthreads();
        {
          const int so = dir == 0 ? tid : 255 - tid;
          const float lf = ((const float*)(ws + OFF_GF))[(size_t)chain * SB + p0 + so];
          const float ig = ((const float*)(ws + OFF_GI))[(size_t)chain * SB + p0 + so];
          float x = lf;
#pragma unroll
          for (int d = 1; d < 64; d <<= 1) { const float y = __int_as_float(__builtin_amdgcn_ds_bpermute(((lane - d) & 63) << 2, __float_as_int(x))); if (lane >= d) x += y; }
          if (lane == 63) red[wave] = x;
          __syncthreads();
          float off = 0.f;
          for (int w = 0; w < wave; ++w) off += red[w];
          const float aloc = ig - (x + off);
          const float mx = wave_max(aloc);
          if (lane == 0) red[4 + wave] = mx;
          __syncthreads();
          const float am = fmaxf(fmaxf(red[4], red[5]), fmaxf(red[6], red[7]));
          wS[so] = __expf(aloc - am);
          if (tid == 0) ((float*)(ws + OFF_ALOC))[i2] = am;
        }
        f32x16 acc[4];
#pragma unroll
        for (int vb = 0; vb < 4; ++vb)
#pragma unroll
          for (int i = 0; i < 16; ++i) acc[vb][i] = 0.f;
        float nacc = 0.f;
        const u16* Kg = (const u16*)(ws + OFF_A) + (size_t)NP * 512 + ((size_t)b * SB + p0) * 512 + head * 128;
        const u16* Vg = (const u16*)(ws + OFF_MVT) + (size_t)(head * 128) * NP + (size_t)b * SB + p0;
#pragma unroll 1
        for (int sub = 0; sub < 4; ++sub) {
          __syncthreads();
          {
            const int kr = tid >> 4, kc = (tid & 15) * 8;
#pragma unroll
            for (int i = 0; i < 4; ++i) *(u32x4*)(Ks + (kr + 16 * i) * 136 + kc) = *(const u32x4*)(Kg + (size_t)(sub * 64 + kr + 16 * i) * 512 + kc);
          }
          __syncthreads();
#pragma unroll
          for (int s16 = 0; s16 < 4; ++s16) {
            float kv[8];
#pragma unroll
            for (int jj = 0; jj < 8; ++jj) {
              const int sl = 16 * s16 + 8 * h + jj;
              kv[jj] = bf2f(Ks[sl * 136 + 32 * wave + r32]) * wS[sub * 64 + sl];
              nacc += kv[jj];
            }
            u32x4 aw; aw.x = cvtpk(kv[0], kv[1]); aw.y = cvtpk(kv[2], kv[3]); aw.z = cvtpk(kv[4], kv[5]); aw.w = cvtpk(kv[6], kv[7]);
            const bf16x8 af = __builtin_bit_cast(bf16x8, aw);
#pragma unroll
            for (int vb = 0; vb < 4; ++vb) {
              const bf16x8 vf = *(const bf16x8*)(Vg + (size_t)(32 * vb + r32) * NP + sub * 64 + 16 * s16 + 8 * h);
              acc[vb] = MFMA32(af, vf, acc[vb]);
            }
          }
        }
        u16* Gd = (u16*)(ws + OFF_GST) + (size_t)i2 * 16384;
#pragma unroll
        for (int vb = 0; vb < 4; ++vb)
#pragma unroll
          for (int g = 0; g < 4; ++g)
            *(uint2*)(Gd + (size_t)(32 * vb + r32) * 128 + 32 * wave + 8 * g + 4 * h) = make_uint2(cvtpk(acc[vb][4 * g], acc[vb][4 * g + 1]), cvtpk(acc[vb][4 * g + 2], acc[vb][4 * g + 3]));
        nacc += SHX(nacc, 32);
        if (h == 0) ((float*)(ws + OFF_NST))[(size_t)i2 * 128 + 32 * wave + r32] = nacc;
      } else if (it < 32) {
        const int chain = it, dir = chain >> 4;
        const float* gi = (const float*)(ws + OFF_GI) + (size_t)chain * SB;
        const float* gf = (const float*)(ws + OFF_GF) + (size_t)chain * SB;
        auto spos = [&](int c) { return dir == 0 ? (c < SC ? SL + c : c - SC) : (SB - 1 - c); };
        float tot = 0.f;
        for (int j = 0; j < 33; ++j) tot += gf[spos(tid * 33 + j)];
        __syncthreads();
        fsm[tid] = tot;
        __syncthreads();
        float pre = 0.f;
        for (int i = 0; i < tid; ++i) pre += fsm[i];
        float F = pre, lm = -INFINITY;
        for (int j = 0; j < 33; ++j) { const int sp = spos(tid * 33 + j); F += gf[sp]; lm = fmaxf(lm, gi[sp] - F); }
        __syncthreads();
        fsm[256 + tid] = lm;
        __syncthreads();
        float pm = 0.f;
        for (int i = 0; i < tid; ++i) pm = fmaxf(pm, fsm[256 + i]);
        F = pre;
        for (int j = 0; j < 33; ++j) {
          const int sp = spos(tid * 33 + j);
          F += gf[sp];
          const float a = gi[sp] - F;
          pm = fmaxf(pm, a);
          ((float*)(ws + OFF_AA))[(size_t)chain * SB + sp] = a;
          ((float*)(ws + OFF_MXA))[(size_t)chain * SB + sp] = pm;
          ((float*)(ws + OFF_MTA))[(size_t)chain * SB + sp] = F + pm;
        }
        __threadfence_block();
        __syncthreads();
        if (tid < 132) {
          const float* aa = (const float*)(ws + OFF_AA) + (size_t)chain * SB + tid * 64;
          float mxv = aa[0];
          for (int j = 1; j < 64; ++j) mxv = fmaxf(mxv, aa[j]);
          ((float*)(ws + OFF_TMAX))[chain * 132 + tid] = mxv;
        }
      } else {
        const int item = (it - 32) * 4 + wave;
        const int g = item & 31, dir = (item >> 5) & 1;
        float2 lam = ((const float2*)(ws + OFF_LAMB))[((L * 2 + dir) * 32 + g) * 64 + lane];
#pragma unroll
        for (int q = 0; q < 6; ++q) lam = make_float2(lam.x * lam.x - lam.y * lam.y, 2.f * lam.x * lam.y);
        float cr = 0.f, ci = 0.f;
        const float2* he = (const float2*)(ws + OFF_HEND) + (size_t)item * 132 * 64 + lane;
        float2* ca = (float2*)(ws + OFF_CARRY) + (size_t)item * 132 * 64 + lane;
#pragma unroll 1
        for (int kk0 = 0; kk0 < 132; kk0 += 12) {
          float2 e[12];
#pragma unroll
          for (int j = 0; j < 12; ++j) e[j] = he[(kk0 + j) * 64];
#pragma unroll
          for (int j = 0; j < 12; ++j) {
            ca[(kk0 + j) * 64] = make_float2(cr, ci);
            const float nr = lam.x * cr - lam.y * ci + e[j].x, ni = lam.x * ci + lam.y * cr + e[j].y;
            cr = nr; ci = ni;
          }
        }
      }
    }
    return;
  }
  if (k == 13) {
    const int n_all = 32 * 9;
    for (int it = bid; it < n_all; it += G) {
      const int chain = it / 9, e = it % 9, dir = chain >> 4;
      const float* gi = (const float*)(ws + OFF_GI) + (size_t)chain * SB;
      const float* aa = (const float*)(ws + OFF_AA) + (size_t)chain * SB;
      float st[8];
#pragma unroll
      for (int i = 0; i < 8; ++i) st[i] = 0.f;
      float B = -INFINITY;
      const bool isn = e == 8;
      if (isn && tid >= 16) continue;
      const size_t eo = isn ? (size_t)tid * 8 : (size_t)e * 2048 + tid * 8;
#pragma unroll 1
      for (int kk0 = 0; kk0 < 33; kk0 += 11) {
        uint4 gm[11]; float4 gn0[11], gn1[11]; float Av[11];
#pragma unroll
        for (int j = 0; j < 11; ++j) {
          const int kk = kk0 + j, ci = chain * 33 + kk;
          if (isn) { const float* g = (const float*)(ws + OFF_NST) + (size_t)ci * 128 + eo; gn0[j] = *(const float4*)g; gn1[j] = *(const float4*)(g + 4); }
          else gm[j] = *(const uint4*)((const u16*)(ws + OFF_GST) + (size_t)ci * 16384 + eo);
          float fst = 0.f;
          if (kk > 0) { const int c = 256 * kk - 1; const int sp = dir == 0 ? (c < SC ? SL + c : c - SC) : (SB - 1 - c); fst = gi[sp] - aa[sp]; }
          Av[j] = ((const float*)(ws + OFF_ALOC))[ci] - fst;
        }
#pragma unroll
        for (int j = 0; j < 11; ++j) {
          const int ci = chain * 33 + kk0 + j;
          if (isn) {
            *(uint4*)((u16*)(ws + OFF_NPST) + (size_t)ci * 128 + eo) = make_uint4(cvtpk(st[0], st[1]), cvtpk(st[2], st[3]), cvtpk(st[4], st[5]), cvtpk(st[6], st[7]));
            if (tid == 0) ((float*)(ws + OFF_BKA))[ci] = B;
          } else {
            *(uint4*)((u16*)(ws + OFF_PST) + (size_t)ci * 16384 + eo) = make_uint4(cvtpk(st[0], st[1]), cvtpk(st[2], st[3]), cvtpk(st[4], st[5]), cvtpk(st[6], st[7]));
          }
          const float A = Av[j];
          const float Bn = fmaxf(B, A);
          const float f1 = __expf(B - Bn), f2 = __expf(A - Bn);
          B = Bn;
          if (isn) {
            const float4 g0 = gn0[j], g1 = gn1[j];
            st[0] = f1 * st[0] + f2 * g0.x; st[1] = f1 * st[1] + f2 * g0.y; st[2] = f1 * st[2] + f2 * g0.z; st[3] = f1 * st[3] + f2 * g0.w;
            st[4] = f1 * st[4] + f2 * g1.x; st[5] = f1 * st[5] + f2 * g1.y; st[6] = f1 * st[6] + f2 * g1.z; st[7] = f1 * st[7] + f2 * g1.w;
          } else {
            const uint4 g = gm[j];
            st[0] = f1 * st[0] + f2 * bflo(g.x); st[1] = f1 * st[1] + f2 * bfhi(g.x); st[2] = f1 * st[2] + f2 * bflo(g.y); st[3] = f1 * st[3] + f2 * bfhi(g.y);
            st[4] = f1 * st[4] + f2 * bflo(g.z); st[5] = f1 * st[5] + f2 * bfhi(g.z); st[6] = f1 * st[6] + f2 * bflo(g.w); st[7] = f1 * st[7] + f2 * bfhi(g.w);
          }
        }
      }
    }
    return;
  }
  if (k == 4) {
    const int n_diff = NB * 4 * 66, n_ml = NB * 4 * 66, n_gqa = NB * 4 * 66, n_s5 = NB * 32 * 132 / 4;
    const int n_all = n_diff + n_ml + n_gqa + n_s5;
    const int r32 = lane & 31, h = lane >> 5;
    int* ctr = (int*)(ws + OFF_CTR) + L;
    int it = FETCH_ITEM();
    for (; it < n_diff; it = FETCH_ITEM()) {
      {
        const int qt = it % 66, head = (it / 66) & 3, b = it / (66 * 4);
        const int s = qt * 128 + wave * 32 + r32, pos = b * SB + s;
        const int kbeg = qt < 64 ? 0 : SL, nkeys = qt < 64 ? SB : SC;
        u16* qd = (u16*)(ws + OFF_QD) + (size_t)pos * 512 + head * 128;
        const float lam = ((const float*)(ws + OFF_LAMV))[L];
        const float lam_init = 0.8f - 0.6f * expf(-0.3f * (float)L);
        f32x16 R[4], O[4]; float lsum;
        attn_pass<128>(qd, (const u16*)(ws + OFF_KD) + ((size_t)b * SB + kbeg) * 512 + head * 128, 512,
                       (const u16*)(ws + OFF_VDT) + (size_t)(head * 128) * NP + (size_t)b * SB + kbeg, nkeys, R, lsum, usm);
        float* stash = (float*)(ws + OFF_STASH) + ((size_t)bid * 256 + otid()) * 64;
        {
          const float il = 1.f / lsum;
#pragma unroll
          for (int vb = 0; vb < 4; ++vb)
#pragma unroll
            for (int i = 0; i < 16; ++i) stash[vb * 16 + i] = R[vb][i] * il;
        }
        attn_pass<128>(qd + 64, (const u16*)(ws + OFF_KD) + ((size_t)b * SB + kbeg) * 512 + head * 128 + 64, 512,
                       (const u16*)(ws + OFF_VDT) + (size_t)(head * 128) * NP + (size_t)b * SB + kbeg, nkeys, O, lsum, usm);
        float ss = 0.f;
        {
          const float il = lam / lsum;
#pragma unroll
          for (int vb = 0; vb < 4; ++vb)
#pragma unroll
            for (int i = 0; i < 16; ++i) { R[vb][i] = stash[vb * 16 + i] - O[vb][i] * il; ss += R[vb][i] * R[vb][i]; }
        }
        ss += SHX(ss, 32);
        const float rn = rsqrtf(ss * (1.f / 128.f) + LN_EPS) * (1.f - lam_init);
        const float* ng = IN(9) + L * 128;
#pragma unroll
        for (int vb = 0; vb < 4; ++vb)
#pragma unroll
          for (int g = 0; g < 4; ++g) {
            const int v0 = vb * 32 + 8 * g + 4 * h;
            const float4 gg = *(const float4*)(ng + v0);
            *(uint2*)(qd + v0) = make_uint2(cvtpk(R[vb][4 * g] * rn * gg.x, R[vb][4 * g + 1] * rn * gg.y), cvtpk(R[vb][4 * g + 2] * rn * gg.z, R[vb][4 * g + 3] * rn * gg.w));
          }
      }
    }
    for (; it < n_diff + n_ml; it = FETCH_ITEM()) {
      {
        const int i2 = it - n_diff;
        const int qt = i2 % 66, head = (i2 / 66) & 3, b = i2 / (66 * 4);
        const int tidm = otid(), lane = tidm & 63, wave = tidm >> 6, r32 = lane & 31, h = lane >> 5;
        const int s = qt * 128 + wave * 32 + r32, pos = b * SB + s;
        bf16x8 qf[8];
        {
          const u16* qrow = (const u16*)(ws + OFF_A) + (size_t)pos * 512 + head * 128;
#pragma unroll
          for (int q = 0; q < 8; ++q) qf[q] = *(const bf16x8*)(qrow + q * 16 + h * 8);
        }
        const u16* Kb = (const u16*)(ws + OFF_A) + (size_t)NP * 512 + (size_t)b * SB * 512 + head * 128;
        const u16* Vt = (const u16*)(ws + OFF_MVT) + (size_t)(head * 128) * NP + (size_t)b * SB;
        f32x16 num[4];
        float* stash = (float*)(ws + OFF_STASH) + ((size_t)bid * 256 + otid()) * 64;
#pragma unroll 1
        for (int dir = 0; dir < 2; ++dir) {
          const int chain = dir * 16 + b * 4 + head;
          const float* Aarr = (const float*)(ws + OFF_AA) + (size_t)chain * SB;
          const float mxq = ((const float*)(ws + OFF_MXA))[(size_t)chain * SB + s] * LOG2E;
          const float mt = ((const float*)(ws + OFF_MTA))[(size_t)chain * SB + s];
          const int cq = chain_idx(dir, s);
          int t0a, t0b, t1a, t1b, kch = 0;
          if (qt < 64) { const int kq = qt >> 1; t0a = 0; t0b = 0; if (dir == 0) { t1a = 4 * kq; t1b = 2 * qt + 2; kch = 1 + kq; } else { t1a = 2 * qt; t1b = 4 * kq + 4; kch = 32 - kq; } }
          else { const int cqt = qt - 64; t1a = 0; t1b = 0; if (dir == 0) { t0a = 0; t0b = 2 * cqt + 2; } else { t0a = 2 * cqt; t0b = 4; } }
          float den = 0.f;
          if (kch > 0) {
            const int ci = chain * 33 + kch;
            const float et = fexp2(fminf(((const float*)(ws + OFF_BKA))[ci] * LOG2E - mxq, 0.f));
            const u16* Pp = (const u16*)(ws + OFF_PST) + (size_t)ci * 16384;
#pragma unroll
            for (int vb = 0; vb < 4; ++vb) {
#pragma unroll
              for (int i = 0; i < 16; ++i) num[vb][i] = 0.f;
#pragma unroll
              for (int q = 0; q < 8; ++q) {
                const bf16x8 pf = *(const bf16x8*)(Pp + (size_t)(32 * vb + r32) * 128 + 16 * q + 8 * h);
                num[vb] = MFMA32(pf, qf[q], num[vb]);
              }
#pragma unroll
              for (int i = 0; i < 16; ++i) num[vb][i] *= et;
              __builtin_amdgcn_sched_barrier(0);
            }
            const u16* np = (const u16*)(ws + OFF_NPST) + (size_t)ci * 128;
            float dp = 0.f;
#pragma unroll
            for (int q = 0; q < 8; ++q) {
              const bf16x8_t qv = __builtin_bit_cast(bf16x8_t, qf[q]);
              const bf16x8_t nv = *(const bf16x8_t*)(np + 16 * q + 8 * h);
              dp = __builtin_amdgcn_fdot2_f32_bf16(__builtin_shufflevector(qv, qv, 0, 1), __builtin_shufflevector(nv, nv, 0, 1), dp, false);
              dp = __builtin_amdgcn_fdot2_f32_bf16(__builtin_shufflevector(qv, qv, 2, 3), __builtin_shufflevector(nv, nv, 2, 3), dp, false);
              dp = __builtin_amdgcn_fdot2_f32_bf16(__builtin_shufflevector(qv, qv, 4, 5), __builtin_shufflevector(nv, nv, 4, 5), dp, false);
              dp = __builtin_amdgcn_fdot2_f32_bf16(__builtin_shufflevector(qv, qv, 6, 7), __builtin_shufflevector(nv, nv, 6, 7), dp, false);
            }
            dp += SHX(dp, 32);
            den = et * dp;
          } else {
#pragma unroll
            for (int vb = 0; vb < 4; ++vb)
#pragma unroll
              for (int i = 0; i < 16; ++i) num[vb][i] = 0.f;
          }
          mlstm_dir(qf, Kb, Vt, Aarr, (const float*)(ws + OFF_TMAX) + chain * 132, dir, t0a, t0b, t1a, t1b, cq, mxq, num, den, smem);
          const float dd = 1.f / fmaxf(fabsf(den), expf(-mt));
          if (dir == 0) {
#pragma unroll
            for (int vb = 0; vb < 4; ++vb)
#pragma unroll
              for (int i = 0; i < 16; ++i) stash[vb * 16 + i] = num[vb][i] * dd;
          } else {
            float ss = 0.f;
#pragma unroll
            for (int vb = 0; vb < 4; ++vb)
#pragma unroll
              for (int i = 0; i < 16; ++i) { num[vb][i] = stash[vb * 16 + i] + num[vb][i] * dd; ss += num[vb][i] * num[vb][i]; }
            ss += SHX(ss, 32);
            const float rn = rsqrtf(ss * (1.f / 128.f) + LN_EPS);
            const float* ng = IN(25) + L * 512 + head * 128;
            u16* mo = (u16*)(ws + OFF_MO) + (size_t)pos * 512 + head * 128;
#pragma unroll
            for (int vb = 0; vb < 4; ++vb)
#pragma unroll
              for (int g = 0; g < 4; ++g) {
                const int v0 = vb * 32 + 8 * g + 4 * h;
                const float4 gg = *(const float4*)(ng + v0);
                const uint2 ov = *(const uint2*)(mo + v0);
                const float y0 = num[vb][4 * g] * rn * gg.x * sigmoidf_(bflo(ov.x)), y1 = num[vb][4 * g + 1] * rn * gg.y * sigmoidf_(bfhi(ov.x));
                const float y2 = num[vb][4 * g + 2] * rn * gg.z * sigmoidf_(bflo(ov.y)), y3 = num[vb][4 * g + 3] * rn * gg.w * sigmoidf_(bfhi(ov.y));
                *(uint2*)(mo + v0) = make_uint2(cvtpk(y0, y1), cvtpk(y2, y3));
              }
          }
        }
      }
    }
    for (; it < n_diff + n_ml + n_gqa; it = FETCH_ITEM()) {
      {
        const int i2 = it - n_diff - n_ml;
        const int qt = i2 % 66, hp = (i2 / 66) & 3, b = i2 / (66 * 4);
        const int kv = hp >> 1;
        const int s = qt * 128 + wave * 32 + r32, pos = b * SB + s;
        const int kbeg = qt < 64 ? 0 : SL, nkeys = qt < 64 ? SB : SC;
        u16* qg = (u16*)(ws + OFF_QG) + (size_t)pos * 512 + hp * 128;
        f32x16 O[2][2]; float lsum[2];
        attn_pass_gqa2(qg, qg + 64, (const u16*)(ws + OFF_KG) + ((size_t)b * SB + kbeg) * 128 + kv * 64, 128,
                       (const u16*)(ws + OFF_VGT) + (size_t)(kv * 64) * NP + (size_t)b * SB + kbeg, nkeys, O, lsum, usm);
#pragma unroll
        for (int hd = 0; hd < 2; ++hd) {
          const float il = 1.f / lsum[hd];
#pragma unroll
          for (int vb = 0; vb < 2; ++vb)
#pragma unroll
            for (int g = 0; g < 4; ++g) {
              const int v0 = vb * 32 + 8 * g + 4 * h;
              *(uint2*)(qg + hd * 64 + v0) = make_uint2(cvtpk(O[hd][vb][4 * g] * il, O[hd][vb][4 * g + 1] * il), cvtpk(O[hd][vb][4 * g + 2] * il, O[hd][vb][4 * g + 3] * il));
            }
        }
      }
    }
    for (; it < n_all; it = FETCH_ITEM()) {
      {
        const int item = (it - n_diff - n_ml - n_gqa) * 4 + wave;
        const int T = item % 132, g = (item / 132) & 31, b = item / (132 * 32);
        u16* W = usm + wave * 4352;
        const int recol = lane < 32 ? lane : lane + 32;
        const size_t pos0 = (size_t)b * SB + 64 * T;
        __syncthreads();
        f32x16 ycc[2];
#pragma unroll
        for (int hh = 0; hh < 2; ++hh)
#pragma unroll
          for (int i = 0; i < 16; ++i) ycc[hh][i] = 0.f;
#pragma unroll 1
        for (int dir = 0; dir < 2; ++dir) {
          const int kk = dir == 0 ? (T < 128 ? T + 4 : T - 128) : (T < 128 ? 4 + 127 - T : 3 - (T - 128));
          const int ldg = (L * 2 + dir) * 32 + g;
          const float2 lam = ((const float2*)(ws + OFF_LAMB))[ldg * 64 + lane];
          bf16x8 bfr[4];
#pragma unroll
          for (int j = 0; j < 4; ++j) bfr[j] = *(const bf16x8*)((const u16*)(ws + OFF_BBT) + ((size_t)ldg * 128 + 32 * j + r32) * 16 + 8 * h);
          const float2 cy = ((const float2*)(ws + OFF_CARRY))[((size_t)((b * 2 + dir) * 32 + g) * 132 + kk) * 64 + lane];
          float hr = cy.x, hi = cy.y;
          const u16* cm = (const u16*)(ws + OFF_CMT) + ((size_t)ldg * 16 + (r32 & 15)) * 128 + 8 * h;
#pragma unroll 1
          for (int hq = 0; hq < 2; ++hq) {
            const int hh = dir ? 1 - hq : hq;
            s5_bu_half((const u16*)(ws + OFF_S5U) + (pos0 + 32 * hh + r32) * 512 + g * 16 + 8 * h, bfr, W, r32, h);
            s5_scan_half<true>(W, dir, recol, lam, hr, hi);
            f32x16 yy;
#pragma unroll
            for (int i = 0; i < 16; ++i) yy[i] = 0.f;
#pragma unroll
            for (int sk = 0; sk < 8; ++sk) {
              const bf16x8 af = *(const bf16x8*)(W + r32 * 136 + 16 * sk + 8 * h);
              const bf16x8 cf = *(const bf16x8*)(cm + 16 * sk);
              yy = MFMA32(af, cf, yy);
            }
            if (hh == 0) { ycc[0] += yy; } else { ycc[1] += yy; }
          }
        }
        if (r32 < 16) {
          const float dsk = IN(19)[L * 512 + g * 16 + r32];
#pragma unroll
          for (int hh = 0; hh < 2; ++hh)
#pragma unroll
            for (int i = 0; i < 16; ++i) {
              const int t = 32 * hh + (i & 3) + 8 * (i >> 2) + 4 * h;
              u16* up = (u16*)(ws + OFF_S5U) + (pos0 + t) * 512 + g * 16 + r32;
              *up = f2bf(gelu_erf(ycc[hh][i] + bf2f(*up) * dsk));
            }
        }
      }
    }
    return;
  }
  if (k == 5) {
    const int n_g = 264 * 8;
    const int n_all = n_g + NP / 4;
    for (int it = bid; it < n_all; it += G) {
      if (it < n_g) {
        const int mt = it / 8, nt = it % 8;
        f32x16 acc[2][2]; acc_zero(acc);
        gemm_core((const u16*)(ws + OFF_S5U) + (size_t)mt * 128 * 512, 512, (const u16*)(ws + OFF_WGLU) + (size_t)nt * 128 * 512, 512, 512, acc, usm);
        {
          u16* YS = (u16*)(ws + OFF_MVT);
          const int e_r = lane & 31, e_h = lane >> 5, e_wm = wave >> 1, e_wn = wave & 1;
          const int ca = nt * 64 + e_wn * 32 + e_r;
          const float ba = IN(21)[L * 1024 + ca], bgt = IN(21)[L * 1024 + 512 + ca];
#pragma unroll
          for (int mi = 0; mi < 2; ++mi)
#pragma unroll
            for (int i = 0; i < 16; ++i) {
              const int row = e_wm * 64 + mi * 32 + (i & 3) + 8 * (i >> 2) + 4 * e_h;
              YS[(size_t)(mt * 128 + row) * 512 + ca] = f2bf((acc[mi][0][i] + ba) * sigmoidf_(acc[mi][1][i] + bgt));
            }
        }
      } else {
        const int pos = (it - n_g) * 4 + wave;
        const float* md = mod_ptr(p, L, pos);
        ln_mod_wave(h_in_ptr(p, L, pos), md, md + 1024, XM + (size_t)pos * DM, lane);
      }
    }
    return;
  }
  if (k == 6) {
    const int n_all = NP * 512 / 2048;
    for (int it = bid; it < n_all; it += G) {
      const size_t e = (size_t)it * 2048 + tid * 8;
      const size_t pos = e >> 9; const int c = (int)(e & 511);
      const u16* z = (const u16*)(ws + OFF_Z) + pos * 1024 + c;
      const uint4 a = *(const uint4*)z, g = *(const uint4*)(z + 512);
      uint4 o;
      o.x = cvtpk(bflo(a.x) * sigmoidf_(bflo(g.x)), bfhi(a.x) * sigmoidf_(bfhi(g.x)));
      o.y = cvtpk(bflo(a.y) * sigmoidf_(bflo(g.y)), bfhi(a.y) * sigmoidf_(bfhi(g.y)));
      o.z = cvtpk(bflo(a.z) * sigmoidf_(bflo(g.z)), bfhi(a.z) * sigmoidf_(bfhi(g.z)));
      o.w = cvtpk(bflo(a.w) * sigmoidf_(bflo(g.w)), bfhi(a.w) * sigmoidf_(bfhi(g.w)));
      *(uint4*)((u16*)(ws + OFF_S5U) + pos * 512 + c) = o;
    }
    return;
  }
  if (k == 7) {
    const int n_g = 264 * 8, n_all = n_g + 1024;
    int* ctr = (int*)(ws + OFF_CTR) + 2 + L * 2;
    for (int it = FETCH_ITEM(); it < n_all; it = FETCH_ITEM()) {
      if (it >= n_g) {
        for (int c = 0; c < 8; ++c) convert_chunk_fp8(IN(34) + (size_t)L * 16384 * 1024, (unsigned char*)(ws + OFF_PU), (size_t)(it - n_g) * 8 + c, 64.f);
        continue;
      }
      const int mt = it / 8, nt = it % 8;
      f32x16 mg[2][2]; acc_zero(mg);
#pragma unroll 1
      for (int kb = 0; kb < 4; ++kb) {
        f32x16 a1[2][2]; acc_zero(a1);
        gemm_core(XM + (size_t)mt * 128 * DM, DM, WinT + (size_t)(4880 + kb * 1024 + nt * 128) * DM, DM, DM, a1, usm);
        const float* bg = IN(7) + L * 4096 + kb * 1024 + nt * 128;
        unsigned gp[2][2][8];
        {
          const int r32 = lane & 31, wn = wave & 1;
#pragma unroll
          for (int ni = 0; ni < 2; ++ni) {
            const float bv = bg[wn * 64 + ni * 32 + r32];
#pragma unroll
            for (int mi = 0; mi < 2; ++mi)
#pragma unroll
              for (int i = 0; i < 8; ++i) gp[mi][ni][i] = cvtpk(sigmoidf_(a1[mi][ni][2 * i] + bv), sigmoidf_(a1[mi][ni][2 * i + 1] + bv));
          }
        }
        f32x16 a2[2][2]; acc_zero(a2);
        const size_t yo = kb == 0 ? OFF_QD : (kb == 1 ? OFF_MVT : (kb == 2 ? OFF_MO : OFF_QG));
        gemm_core((const u16*)(ws + yo) + (size_t)mt * 128 * 512, 512, (const u16*)(ws + OFF_WBR) + ((size_t)kb * DM + nt * 128) * 512, 512, 512, a2, usm);
#pragma unroll
        for (int mi = 0; mi < 2; ++mi)
#pragma unroll
          for (int ni = 0; ni < 2; ++ni)
#pragma unroll
            for (int i = 0; i < 8; ++i) { mg[mi][ni][2 * i] += bflo(gp[mi][ni][i]) * a2[mi][ni][2 * i]; mg[mi][ni][2 * i + 1] += bfhi(gp[mi][ni][i]) * a2[mi][ni][2 * i + 1]; }
      }
      u16* MG = (u16*)(ws + OFF_Z);
      EPI_LOOP(mg, { MG[(size_t)(mt * 128 + row) * 1024 + nt * 128 + col] = f2bf(val); })
    }
    return;
  }
  if (k == 8) {
    const int n_g = 264 * 8, n_cv = 1024;
    const int n_all = n_g + n_cv;
    int* ctr = (int*)(ws + OFF_CTR) + 3 + L * 2;
    for (int it = FETCH_ITEM(); it < n_all; it = FETCH_ITEM()) {
      if (it < n_g) {
        const int mt = it / 8, nt = it % 8;
        f32x16 acc[2][2]; acc_zero(acc);
        gemm_core((const u16*)(ws + OFF_Z) + (size_t)mt * 128 * DM, DM, (const u16*)(ws + OFF_WO) + (size_t)nt * 128 * DM, DM, DM, acc, usm);
        const float* g1 = mod_ptr(p, L, mt * 128) + 2048 + nt * 128;
        const float* hin0 = h_in_ptr(p, L, mt * 128) + nt * 128;
        float* hout0 = h_out_ptr(p, mt * 128) + nt * 128;
        EPI_LOOP(acc, { hout0[(size_t)row * DM + col] = ALPHA * hin0[(size_t)row * DM + col] + g1[col] * val; })
      } else {
        for (int c = 0; c < 8; ++c) convert_chunk_fp8(IN(35) + (size_t)L * 16384 * 1024, (unsigned char*)(ws + OFF_PV), (size_t)(it - n_g) * 8 + c, 8.f);
      }
    }
    return;
  }
  if (k == 9) {
    for (int it = bid; it < NP / 4; it += G) {
      const int pos = it * 4 + wave;
      float* hrow = h_out_ptr(p, pos);
      float4 x[4];
#pragma unroll
      for (int i = 0; i < 4; ++i) x[i] = *(const float4*)(hrow + lane * 4 + 256 * i);
      float sm = 0.f;
#pragma unroll
      for (int i = 0; i < 4; ++i) sm += x[i].x + x[i].y + x[i].z + x[i].w;
      const float mean = wave_sum(sm) * (1.f / DM);
      float vs = 0.f;
#pragma unroll
      for (int i = 0; i < 4; ++i) { x[i].x -= mean; x[i].y -= mean; x[i].z -= mean; x[i].w -= mean; vs += x[i].x * x[i].x + x[i].y * x[i].y + x[i].z * x[i].z + x[i].w * x[i].w; }
      const float rs = rsqrtf(wave_sum(vs) * (1.f / DM) + LN_EPS);
      float sm2 = 0.f;
#pragma unroll
      for (int i = 0; i < 4; ++i) {
        const float4 g = *(const float4*)(IN(28) + L * DM + lane * 4 + 256 * i), be = *(const float4*)(IN(29) + L * DM + lane * 4 + 256 * i);
        x[i] = make_float4(x[i].x * rs * g.x + be.x, x[i].y * rs * g.y + be.y, x[i].z * rs * g.z + be.z, x[i].w * rs * g.w + be.w);
        *(float4*)(hrow + lane * 4 + 256 * i) = x[i];
        sm2 += x[i].x + x[i].y + x[i].z + x[i].w;
      }
      const float mean2 = wave_sum(sm2) * (1.f / DM);
      float vs2 = 0.f;
#pragma unroll
      for (int i = 0; i < 4; ++i) { x[i].x -= mean2; x[i].y -= mean2; x[i].z -= mean2; x[i].w -= mean2; vs2 += x[i].x * x[i].x + x[i].y * x[i].y + x[i].z * x[i].z + x[i].w * x[i].w; }
      const float rs2 = rsqrtf(wave_sum(vs2) * (1.f / DM) + LN_EPS);
      const float* md = mod_ptr(p, L, pos);
#pragma unroll
      for (int i = 0; i < 4; ++i) {
        const float4 sh = *(const float4*)(md + 3072 + lane * 4 + 256 * i), sc = *(const float4*)(md + 4096 + lane * 4 + 256 * i);
        *(uint2*)(XM + (size_t)pos * DM + lane * 4 + 256 * i) = make_uint2(cvtpk(x[i].x * rs2 * (1.f + sc.x) + sh.x, x[i].y * rs2 * (1.f + sc.y) + sh.y), cvtpk(x[i].z * rs2 * (1.f + sc.z) + sh.z, x[i].w * rs2 * (1.f + sc.w) + sh.w));
      }
    }
    return;
  }
  if (k == 10) {
    const int n_all = 264 * 16;
    for (int it = bid; it < n_all; it += G) {
      const int mt = it / 16, nt = it % 16;
      f32x16 acc[2][2]; acc_zero(acc);
      gemm_core(XM + (size_t)mt * 128 * DM, DM, (const u16*)(ws + OFF_WQ) + (size_t)nt * 128 * DM, DM, DM, acc, usm);
      u16* Q2 = (u16*)(ws + OFF_Q2);
      EPI_LOOP(acc, { Q2[(size_t)(mt * 128 + row) * 2048 + nt * 128 + col] = f2bf(val); })
    }
    return;
  }
  if (k == 11) {
    const int n_all = NP / 8;
    float* sc = fsm;
    float* T1v = fsm + 64 * 132;
    float* T2v = T1v + 1024;
    int* T1i = (int*)(T2v + 1024);
    int* T2i = T1i + 1024;
    float* Sv = (float*)(T2i + 1024) + wave * 64;
    int* Si = (int*)((float*)(T2i + 1024) + 256) + wave * 64;
    const int r32 = lane & 31, h = lane >> 5;
    for (int it = bid; it < n_all; it += G) {
      const size_t row0 = (size_t)it * 64;
#pragma unroll 1
      for (int half = 0; half < 2; ++half) {
        f32x16 a[2];
#pragma unroll
        for (int ni = 0; ni < 2; ++ni)
#pragma unroll
          for (int i = 0; i < 16; ++i) a[ni][i] = 0.f;
        const u16* qa = (const u16*)(ws + OFF_Q2) + (row0 + (wave >> 1) * 32 + r32) * 256 + half * 128;
        const u16* kbp = (const u16*)(ws + OFF_SK) + (size_t)half * 16384 + (size_t)((wave & 1) * 64 + r32) * 128;
#pragma unroll
        for (int s = 0; s < 8; ++s) {
          const bf16x8 af = *(const bf16x8*)(qa + s * 16 + h * 8);
#pragma unroll
          for (int ni = 0; ni < 2; ++ni) {
            const bf16x8 bf = *(const bf16x8*)(kbp + (size_t)ni * 32 * 128 + s * 16 + h * 8);
            a[ni] = MFMA32(af, bf, a[ni]);
          }
        }
        __syncthreads();
#pragma unroll
        for (int ni = 0; ni < 2; ++ni)
#pragma unroll
          for (int i = 0; i < 16; ++i) sc[((wave >> 1) * 32 + (i & 3) + 8 * (i >> 2) + 4 * h) * 132 + (wave & 1) * 64 + ni * 32 + r32] = a[ni][i];
        __syncthreads();
        float* Tv = half ? T2v : T1v; int* Ti = half ? T2i : T1i;
#pragma unroll 1
        for (int g = 0; g < 4; ++g) {
          float v0[4], v1[4]; unsigned k0[4], k1[4], T[4];
#pragma unroll
          for (int r = 0; r < 4; ++r) {
            const int row = wave * 16 + g * 4 + r;
            v0[r] = sc[row * 132 + lane]; v1[r] = sc[row * 132 + 64 + lane];
            unsigned u0 = __float_as_uint(v0[r]), u1 = __float_as_uint(v1[r]);
            u0 = (u0 >> 31) ? ~u0 : (u0 | 0x80000000u); u1 = (u1 >> 31) ? ~u1 : (u1 | 0x80000000u);
            k0[r] = (u0 & 0xFFFFFF80u) | (unsigned)(127 - lane); k1[r] = (u1 & 0xFFFFFF80u) | (unsigned)(63 - lane);
            T[r] = 0u;
          }
          bool dn0 = false, dn1 = false, dn2 = false, dn3 = false;
#pragma unroll 1
          for (int bit = 31; bit >= 0; --bit) {
#pragma unroll
            for (int r = 0; r < 4; ++r) {
              bool& dn = r == 0 ? dn0 : (r == 1 ? dn1 : (r == 2 ? dn2 : dn3));
              const unsigned cand = T[r] | (1u << bit);
              const int cnt = __popcll(__ballot(k0[r] >= cand)) + __popcll(__ballot(k1[r] >= cand));
              T[r] = cnt >= 16 ? cand : T[r];
              dn = dn | (cnt == 16);
            }
            if (dn0 && dn1 && dn2 && dn3) break;
          }
#pragma unroll
          for (int r = 0; r < 4; ++r) {
            const int row = wave * 16 + g * 4 + r;
            const bool s0 = k0[r] >= T[r], s1 = k1[r] >= T[r];
            const unsigned long long m0 = __ballot(s0), m1 = __ballot(s1);
            const int p0 = __builtin_amdgcn_mbcnt_hi((unsigned)(m0 >> 32), __builtin_amdgcn_mbcnt_lo((unsigned)m0, 0u));
            const int p1 = __popcll(m0) + __builtin_amdgcn_mbcnt_hi((unsigned)(m1 >> 32), __builtin_amdgcn_mbcnt_lo((unsigned)m1, 0u));
            if (s0) { Tv[row * 16 + p0] = v0[r]; Ti[row * 16 + p0] = lane; }
            if (s1) { Tv[row * 16 + p1] = v1[r]; Ti[row * 16 + p1] = lane + 64; }
          }
        }
      }
#pragma unroll 1
      for (int g = 0; g < 4; ++g) {
        {
          const int rowl = wave * 16 + g * 4 + (lane >> 4), j = lane & 15;
#pragma unroll
          for (int half = 0; half < 2; ++half) {
            float* Tv = half ? T2v : T1v; int* Ti = half ? T2i : T1i;
            const float v = Tv[rowl * 16 + j]; const int vi = Ti[rowl * 16 + j];
            int rank = 0;
#pragma unroll
            for (int i = 0; i < 16; ++i) { const float o = Tv[rowl * 16 + i]; rank += (o > v || (o == v && i < j)) ? 1 : 0; }
            Tv[rowl * 16 + rank] = v; Ti[rowl * 16 + rank] = vi;
          }
        }
        unsigned kk[4], T[4]; float cv[4];
        const int pr = PEER_PAIRS[lane], ia = pr >> 4, ib = pr & 15;
#pragma unroll
        for (int r = 0; r < 4; ++r) {
          const int row = wave * 16 + g * 4 + r;
          cv[r] = T1v[row * 16 + ia] + T2v[row * 16 + ib];
          unsigned u = __float_as_uint(cv[r]); u = (u >> 31) ? ~u : (u | 0x80000000u);
          kk[r] = lane < 50 ? ((u & 0xFFFFFFC0u) | (unsigned)(63 - lane)) : 0u;
          T[r] = 0u;
        }
        bool dn0 = false, dn1 = false, dn2 = false, dn3 = false;
#pragma unroll 1
        for (int bit = 31; bit >= 0; --bit) {
#pragma unroll
          for (int r = 0; r < 4; ++r) {
            bool& dn = r == 0 ? dn0 : (r == 1 ? dn1 : (r == 2 ? dn2 : dn3));
            const unsigned cand = T[r] | (1u << bit);
            const int cnt = __popcll(__ballot(kk[r] >= cand));
            T[r] = cnt >= 16 ? cand : T[r];
            dn = dn | (cnt == 16);
          }
          if (dn0 && dn1 && dn2 && dn3) break;
        }
#pragma unroll
        for (int r = 0; r < 4; ++r) {
          const int row = wave * 16 + g * 4 + r;
          const bool se = kk[r] >= T[r] && T[r] != 0u;
          const unsigned long long me = __ballot(se);
          const int pe = __builtin_amdgcn_mbcnt_hi((unsigned)(me >> 32), __builtin_amdgcn_mbcnt_lo((unsigned)me, 0u));
          if (se) {
            Sv[r * 16 + pe] = cv[r];
            Si[r * 16 + pe] = T1i[row * 16 + ia] * 128 + T2i[row * 16 + ib];
          }
        }
        {
          const float val = Sv[lane]; const int idx = Si[lane];
          float mx = val;
          mx = fmaxf(mx, SHX(mx, 8)); mx = fmaxf(mx, SHX(mx, 4)); mx = fmaxf(mx, SHX(mx, 2)); mx = fmaxf(mx, SHX(mx, 1));
          const float ev = __expf(val - mx);
          float sm = ev;
          sm += SHX(sm, 8); sm += SHX(sm, 4); sm += SHX(sm, 2); sm += SHX(sm, 1);
          const size_t o = (row0 + wave * 16 + g * 4) * 16 + lane;
          ((int*)(ws + OFF_IDX))[o] = idx;
          ((float*)(ws + OFF_GATE))[o] = ev / sm;
        }
      }
      __syncthreads();
    }
    return;
  }
  if (k == 12) {
    const unsigned char* PU = (const unsigned char*)(ws + OFF_PU); const unsigned char* PV = (const unsigned char*)(ws + OFF_PV);
    float* wl = fsm + 8 + wave * 32;
    float* fs = fsm + 8 + 128;
    for (int it = bid; it < NP; it += G) {
      const int pos = it;
      float tf[16];
      {
        const u16* xr = XM + (size_t)pos * DM + lane * 16;
        const u32x4 a = *(const u32x4*)xr, b = *(const u32x4*)(xr + 8);
        tf[0] = bflo(a.x); tf[1] = bfhi(a.x); tf[2] = bflo(a.y); tf[3] = bfhi(a.y); tf[4] = bflo(a.z); tf[5] = bfhi(a.z); tf[6] = bflo(a.w); tf[7] = bfhi(a.w);
        tf[8] = bflo(b.x); tf[9] = bfhi(b.x); tf[10] = bflo(b.y); tf[11] = bfhi(b.y); tf[12] = bflo(b.z); tf[13] = bfhi(b.z); tf[14] = bflo(b.w); tf[15] = bfhi(b.w);
      }
      const size_t r0 = (size_t)pos * 8 + wave * 2;
      const int myidx = lane < 32 ? ((const int*)(ws + OFF_IDX))[r0 * 16 + lane] : 0;
      const float myg = lane < 32 ? ((const float*)(ws + OFF_GATE))[r0 * 16 + lane] : 0.f;
      u32x4 A[8], B[8], C[8];
      const bool b5 = lane & 32, b4 = lane & 16, b3 = lane & 8;
#define LOADROWS(X, TAB, E0)                                                             \
      _Pragma("unroll") for (int j = 0; j < 8; ++j) {                                    \
        const int idx = __builtin_amdgcn_readlane(myidx, (E0) + j);                      \
        X[j] = *(const u32x4*)((TAB) + (size_t)idx * DM + lane * 16);                    \
      }
#define UNPK(X, j, q) const f32x2 q##0 = __builtin_amdgcn_cvt_pk_f32_fp8((int)X[j].x, false), q##1 = __builtin_amdgcn_cvt_pk_f32_fp8((int)X[j].x, true), \
                                  q##2 = __builtin_amdgcn_cvt_pk_f32_fp8((int)X[j].y, false), q##3 = __builtin_amdgcn_cvt_pk_f32_fp8((int)X[j].y, true), \
                                  q##4 = __builtin_amdgcn_cvt_pk_f32_fp8((int)X[j].z, false), q##5 = __builtin_amdgcn_cvt_pk_f32_fp8((int)X[j].z, true), \
                                  q##6 = __builtin_amdgcn_cvt_pk_f32_fp8((int)X[j].w, false), q##7 = __builtin_amdgcn_cvt_pk_f32_fp8((int)X[j].w, true);
#define DOTS(X, E0)                                                                  \
      {                                                                                  \
        float d[8];                                                                      \
        _Pragma("unroll") for (int j = 0; j < 8; ++j) {                                  \
          UNPK(X, j, q)                                                                  \
          d[j] = tf[0] * q0.x + tf[1] * q0.y + tf[2] * q1.x + tf[3] * q1.y + tf[4] * q2.x + tf[5] * q2.y + tf[6] * q3.x + tf[7] * q3.y \
               + tf[8] * q4.x + tf[9] * q4.y + tf[10] * q5.x + tf[11] * q5.y + tf[12] * q6.x + tf[13] * q6.y + tf[14] * q7.x + tf[15] * q7.y; \
          asm volatile("" : "+v"(d[j]));                                                 \
        }                                                                                \
        float d4[4], d2[2], d1;                                                          \
        _Pragma("unroll") for (int i = 0; i < 4; ++i) { const float keep = b5 ? d[i + 4] : d[i], send = b5 ? d[i] : d[i + 4]; d4[i] = keep + SHX(send, 32); } \
        _Pragma("unroll") for (int i = 0; i < 2; ++i) { const float keep = b4 ? d4[i + 2] : d4[i], send = b4 ? d4[i] : d4[i + 2]; d2[i] = keep + SHX(send, 16); } \
        { const float keep = b3 ? d2[1] : d2[0], send = b3 ? d2[0] : d2[1]; d1 = keep + SHX(send, 8); } \
        d1 += SHX(d1, 4); d1 += SHX(d1, 2); d1 += SHX(d1, 1);                            \
        const float gt = __int_as_float(__builtin_amdgcn_ds_bpermute(((E0) + (lane >> 3)) << 2, __float_as_int(myg))); \
        if ((lane & 7) == 0) wl[(E0) + (lane >> 3)] = gt * gelu_erf(d1 * (1.f / 64.f)) * 0.125f; \
        __builtin_amdgcn_sched_barrier(0);                                               \
      }
#define ACCV(X, E0)                                                                      \
      _Pragma("unroll") for (int j = 0; j < 8; ++j) {                                    \
        const float w = wl[(E0) + j];                                                    \
        UNPK(X, j, q)                                                                    \
        ov[0] += w * q0.x; ov[1] += w * q0.y; ov[2] += w * q1.x; ov[3] += w * q1.y; ov[4] += w * q2.x; ov[5] += w * q2.y; ov[6] += w * q3.x; ov[7] += w * q3.y; \
        ov[8] += w * q4.x; ov[9] += w * q4.y; ov[10] += w * q5.x; ov[11] += w * q5.y; ov[12] += w * q6.x; ov[13] += w * q6.y; ov[14] += w * q7.x; ov[15] += w * q7.y; \
        _Pragma("unroll") for (int i = 0; i < 16; ++i) asm volatile("" : "+v"(ov[i]));   \
      }
      __syncthreads();
      LOADROWS(A, PU, 0)
      LOADROWS(B, PU, 8)
      LOADROWS(C, PU, 16)
      DOTS(A, 0)
      LOADROWS(A, PU, 24)
      DOTS(B, 8)
      LOADROWS(B, PV, 0)
      DOTS(C, 16)
      LOADROWS(C, PV, 8)
      DOTS(A, 24)
      LOADROWS(A, PV, 16)
      float ov[16];
#pragma unroll
      for (int i = 0; i < 16; ++i) ov[i] = 0.f;
      ACCV(B, 0)
      __builtin_amdgcn_sched_barrier(0);
      LOADROWS(B, PV, 24)
      ACCV(C, 8)
      __builtin_amdgcn_sched_barrier(0);
      ACCV(A, 16)
      __builtin_amdgcn_sched_barrier(0);
      ACCV(B, 24)
#undef LOADROWS
#undef UNPK
#undef DOTS
#undef ACCV
#pragma unroll
      for (int i = 0; i < 16; ++i) fs[wave * 1024 + lane * 16 + i] = ov[i];
      __syncthreads();
      const int tid2 = otid();
      float f[4];
#pragma unroll
      for (int i = 0; i < 4; ++i) f[i] = fs[tid2 * 4 + i] + fs[1024 + tid2 * 4 + i] + fs[2048 + tid2 * 4 + i] + fs[3072 + tid2 * 4 + i];
      float* hrow = h_out_ptr(p, pos);
      const float4 hm = *(const float4*)(hrow + tid2 * 4);
      const float4 g2 = *(const float4*)(mod_ptr(p, L, pos) + 5120 + tid2 * 4);
      const float x0 = ALPHA * hm.x + g2.x * f[0], x1 = ALPHA * hm.y + g2.y * f[1], x2 = ALPHA * hm.z + g2.z * f[2], x3 = ALPHA * hm.w + g2.w * f[3];
      const float mean = block_sum(x0 + x1 + x2 + x3, fsm) * (1.f / DM);
      const float a = x0 - mean, b = x1 - mean, c = x2 - mean, d = x3 - mean;
      const float var = block_sum(a * a + b * b + c * c + d * d, fsm) * (1.f / DM);
      const float rs = rsqrtf(var + LN_EPS);
      const float4 g = *(const float4*)(IN(30) + L * DM + tid2 * 4), be = *(const float4*)(IN(31) + L * DM + tid2 * 4);
      *(float4*)(hrow + tid2 * 4) = make_float4(a * rs * g.x + be.x, b * rs * g.y + be.y, c * rs * g.z + be.z, d * rs * g.w + be.w);
    }
    return;
  }
}

#if MULTI_LAUNCH
__global__ void __launch_bounds__(256, 2) k_phase(P p, int ph) {
  __shared__ __attribute__((aligned(16))) char smem[57344];
  run_phase(p, ph, smem);
}
#endif

#if !MULTI_LAUNCH
#define XB_TMO      128
#define XB_XCNT(j)  (256  + 64 * (j))
#define XB_XSUB(j)  (1280 + 64 * (j))
#define XB_XGEN(j)  (2304 + 64 * (j))
#define XB_TOP      3328
#define XB_TOPGEN   3392
#define XCD_BAR_WORDS 3456
#define XB_SPIN_CAP (1u << 18)
#define LAS __attribute__((address_space(3)))

__device__ __forceinline__ unsigned xb_ld(unsigned* p)              { return __hip_atomic_load(p, __ATOMIC_RELAXED, __HIP_MEMORY_SCOPE_AGENT); }
__device__ __forceinline__ unsigned xb_add(unsigned* p, unsigned v) { return __hip_atomic_fetch_add(p, v, __ATOMIC_RELAXED, __HIP_MEMORY_SCOPE_AGENT); }
__device__ __forceinline__ unsigned xb_xcc_id() { return (unsigned)__builtin_amdgcn_s_getreg((3 << 11) | 20) & 0xFu; }
#define XB_SPIN(cond, bar) do { unsigned _sp = 0; while (cond) { __builtin_amdgcn_s_sleep(1); \
    if ((++_sp & 255u) == 0u) { if (xb_ld(&(bar)[XB_TMO])) break; if (_sp > XB_SPIN_CAP) { atomicAdd(&(bar)[XB_TMO], 1u); break; } } } } while (0)

struct XcdBarrier {
    unsigned* bar; unsigned x;
    volatile LAS unsigned* st;
};

__device__ __forceinline__ XcdBarrier xcd_barrier_post(unsigned* bar, volatile LAS unsigned* st) {
    XcdBarrier b; b.bar = bar; b.x = xb_xcc_id(); b.st = st;
    if (threadIdx.x == 0) (void)xb_add(&bar[XB_XCNT(b.x)], 1u);
    return b;
}
__device__ __forceinline__ void xcd_barrier_complete(unsigned* bar, unsigned x, unsigned& nloc, unsigned& nx) {
    const unsigned G = gridDim.x * gridDim.y * gridDim.z;
    unsigned sum, cnt, mine, sp = 0u;
    for (;;) {
        sum = 0u; cnt = 0u; mine = 0u;
#pragma unroll
        for (unsigned j = 0; j < 16; ++j) { const unsigned c = xb_ld(&bar[XB_XCNT(j)]); sum += c; cnt += (c > 0u) ? 1u : 0u; mine = (j == x) ? c : mine; }
        if (sum == G) break;
        __builtin_amdgcn_s_sleep(1);
        if ((++sp & 255u) == 0u) { if (xb_ld(&bar[XB_TMO])) break; if (sp > XB_SPIN_CAP) { atomicAdd(&bar[XB_TMO], 1u); break; } }
    }
    nloc = mine > 0u ? mine : 1u; nx = cnt > 0u ? cnt : 1u;
}

__device__ __forceinline__ void xcd_barrier(const XcdBarrier& b) {
    asm volatile("s_waitcnt vmcnt(0)" ::: "memory");
    __syncthreads();
    if (threadIdx.x == 0) {
        unsigned* bar = b.bar;
        __builtin_amdgcn_s_waitcnt(0);
        unsigned nloc = b.st[0], nx = b.st[1];
        if (nloc == 0u) { xcd_barrier_complete(bar, b.x, nloc, nx); b.st[0] = nloc; b.st[1] = nx; }
        const unsigned old = xb_add(&bar[XB_XSUB(b.x)], 1u);
        const unsigned gen = old / nloc;
        if (old + 1u == (gen + 1u) * nloc) {
            __builtin_amdgcn_fence(__ATOMIC_RELEASE, "agent");
            asm volatile("s_waitcnt vmcnt(0)" ::: "memory");
            const unsigned og = xb_add(&bar[XB_TOP], 1u);
            const unsigned tg = og / nx;
            if (og + 1u == (tg + 1u) * nx) xb_add(&bar[XB_TOPGEN], 1u);
            else XB_SPIN(xb_ld(&bar[XB_TOPGEN]) == tg, bar);
            __builtin_amdgcn_fence(__ATOMIC_ACQUIRE, "agent");
            xb_add(&bar[XB_XGEN(b.x)], 1u);
            asm volatile("s_waitcnt vmcnt(0)" ::: "memory");
        } else {
            XB_SPIN(xb_ld(&bar[XB_XGEN(b.x)]) == gen, bar);
            __builtin_amdgcn_fence(__ATOMIC_ACQUIRE, "agent");
            asm volatile("s_waitcnt vmcnt(0)" ::: "memory");
        }
    }
    __syncthreads();
}


__global__ void __launch_bounds__(256, 2) k_mega(P p) {
  __shared__ __attribute__((aligned(16))) char smem[57344];
  cg::grid_group grid = cg::this_grid();
  __shared__ uint4 xb_words;
  if (threadIdx.x == 0) xb_words = make_uint4(0u, 0u, 0u, 0u);
  __syncthreads();
  (void)xcd_barrier_post((unsigned*)(WSP + OFF_BAR), (volatile LAS unsigned*)&xb_words);
#define XBAR() { XcdBarrier xb_; xb_.bar = (unsigned*)(WSP + OFF_BAR); xb_.x = xb_xcc_id(); xb_.st = (volatile LAS unsigned*)&xb_words; xcd_barrier(xb_); }
  run_phase(p, 0, smem); grid.sync();
  run_phase(p, 1, smem); XBAR()
  run_phase(p, 2, smem); XBAR()
  run_phase(p, 3, smem); XBAR()
  run_phase(p, 4, smem); XBAR()
  run_phase(p, 5, smem); XBAR()
  run_phase(p, 15, smem); XBAR()
  run_phase(p, 6, smem); XBAR()
  run_phase(p, 7, smem); XBAR()
  run_phase(p, 9, smem); XBAR()
  run_phase(p, 10, smem); XBAR()
  run_phase(p, 11, smem); XBAR()
  run_phase(p, 12, smem); XBAR()
  run_phase(p, 13, smem); XBAR()
  run_phase(p, 14, smem); XBAR()
  run_phase(p, 16, smem); XBAR()
  run_phase(p, 17, smem); XBAR()
  run_phase(p, 18, smem); XBAR()
  run_phase(p, 19, smem); XBAR()
  run_phase(p, 29, smem); XBAR()
  run_phase(p, 20, smem); XBAR()
  run_phase(p, 21, smem); XBAR()
  run_phase(p, 23, smem); XBAR()
  run_phase(p, 24, smem); XBAR()
  run_phase(p, 25, smem); XBAR()
  run_phase(p, 26, smem); XBAR()
  run_phase(p, 27, smem); XBAR()
  run_phase(p, 28, smem);
#undef XBAR
}
#endif

extern "C" void kernel_launch(void* const* d_in, const int* in_sizes, int n_in, void* d_out, int out_size, void* d_ws, size_t ws_size, hipStream_t stream) {
  if (n_in != 36 || ws_size < WS_END) { fprintf(stderr, "kernel_launch: need 36 inputs and %zu bytes of workspace (got %d, %zu)\n", (size_t)WS_END, n_in, ws_size); return; }
  P p{};
  for (int i = 0; i < 36; ++i) p.in[i] = (const float*)d_in[i];
  p.out = (float*)d_out; p.ws = (char*)d_ws;
#if MULTI_LAUNCH
  for (int ph = 0; ph < NPHASES; ++ph) hipLaunchKernelGGL(k_phase, dim3(512), dim3(256), 0, stream, p, ph);
#else
  static int grid_blocks = 0;
  if (!grid_blocks) {
    int dev = 0, cus = 0, per_cu = 0;
    hipGetDevice(&dev);
    hipDeviceGetAttribute(&cus, hipDeviceAttributeMultiprocessorCount, dev);
    hipOccupancyMaxActiveBlocksPerMultiprocessor(&per_cu, k_mega, 256, 0);
    if (per_cu < 1) per_cu = 1;
    grid_blocks = cus * per_cu;
    if (grid_blocks > 512) grid_blocks = 512;
  }
  hipMemsetAsync((char*)d_ws + OFF_BAR, 0, 16384, stream);
  void* args[] = {&p};
  hipError_t e = hipLaunchCooperativeKernel((void*)k_mega, dim3(grid_blocks), dim3(256), args, 0, stream);
  if (e != hipSuccess) fprintf(stderr, "cooperative launch failed: %s (grid %d)\n", hipGetErrorString(e), grid_blocks);
#endif
}
```

```cpp
#include <hip/hip_runtime.h>
#include <hip/hip_cooperative_groups.h>
#include <cstdio>
namespace cg = cooperative_groups;

#ifndef MULTI_LAUNCH
#define MULTI_LAUNCH 0
#endif

#define DI __device__ __forceinline__
typedef unsigned short u16;
typedef short bf16x8 __attribute__((ext_vector_type(8)));
typedef short s16x4 __attribute__((ext_vector_type(4)));
typedef float f32x16 __attribute__((ext_vector_type(16)));
typedef float f32x2 __attribute__((ext_vector_type(2)));
typedef __bf16 bf16x2_t __attribute__((ext_vector_type(2)));
typedef unsigned u32x4 __attribute__((ext_vector_type(4)));
typedef __bf16 bf16x8_t __attribute__((ext_vector_type(8)));
#define MFMA32(a, b, c) __builtin_amdgcn_mfma_f32_32x32x16_bf16((a), (b), (c), 0, 0, 0)

constexpr int NB = 4, SL = 8192, SC = 256, SB = 8448, NP = NB * SB, DM = 1024, NIN = 8976;
constexpr float LN_EPS = 1e-6f;
constexpr float ALPHA = 1.41421356237f;
constexpr float LOG2E = 1.44269504089f;

constexpr size_t SZ512 = (size_t)NP * 512 * 2;
constexpr size_t OFF_A = 0;
constexpr size_t OFF_QD = OFF_A + 2 * SZ512;
constexpr size_t OFF_KD = OFF_QD + SZ512;
constexpr size_t OFF_VDT = OFF_KD + SZ512;
constexpr size_t OFF_S5U = OFF_VDT + SZ512;
constexpr size_t OFF_MQ = OFF_S5U + SZ512;
constexpr size_t OFF_MK = OFF_MQ + SZ512;
constexpr size_t OFF_MVT = OFF_MK + SZ512;
constexpr size_t OFF_MO = OFF_MVT + SZ512;
constexpr size_t OFF_QG = OFF_MO + SZ512;
constexpr size_t OFF_KG = OFF_QG + SZ512;
constexpr size_t OFF_VGT = OFF_KG + SZ512 / 4;
constexpr size_t OFF_MGATE = OFF_VGT + SZ512 / 4;
constexpr size_t OFF_WIN = OFF_MGATE + (size_t)NP * 16 * 4;
constexpr size_t OFF_WBR = OFF_WIN + (size_t)9088 * 1024 * 2;
constexpr size_t OFF_WO = OFF_WBR + (size_t)4 * 1024 * 512 * 2;
constexpr size_t OFF_WGLU = OFF_WO + (size_t)1024 * 1024 * 2;
constexpr size_t OFF_WQ = OFF_WGLU + (size_t)1024 * 512 * 2;
constexpr size_t OFF_SK = OFF_WQ + (size_t)2048 * 1024 * 2;
constexpr size_t OFF_MODP = OFF_SK + 65536;
constexpr size_t OFF_MOD = OFF_MODP + (size_t)2 * 8 * 5 * 6144 * 4;
constexpr size_t OFF_LAMB = OFF_MOD + (size_t)2 * 5 * 6144 * 4;
constexpr size_t OFF_BBAR = OFF_LAMB + 65536;
constexpr size_t OFF_LAMV = OFF_BBAR + 1048576;
constexpr size_t SZCH = (size_t)32 * SB * 4;
constexpr size_t OFF_GI = OFF_LAMV + 256;
constexpr size_t OFF_GF = OFF_GI + SZCH;
constexpr size_t OFF_AA = OFF_GF + SZCH;
constexpr size_t OFF_MXA = OFF_AA + SZCH;
constexpr size_t OFF_MTA = OFF_MXA + SZCH;
constexpr size_t SZHE = (size_t)NB * 2 * 32 * 132 * 64 * 8;
constexpr size_t OFF_HEND = OFF_MTA + SZCH;
constexpr size_t OFF_CARRY = OFF_HEND + SZHE;
constexpr size_t OFF_HC = OFF_CARRY + SZHE;
constexpr size_t OFF_STASH = OFF_HC + (size_t)1024 * 1024 * 4;
constexpr size_t OFF_PU = OFF_STASH;
constexpr size_t OFF_PV = OFF_STASH + (size_t)16384 * 1024;
constexpr size_t OFF_ROPE = OFF_STASH + (size_t)512 * 64 * 256 * 4;
constexpr size_t OFF_TMAX = OFF_ROPE + 32768;
constexpr size_t OFF_BBT = OFF_TMAX + 32768;
constexpr size_t OFF_CMT = OFF_BBT + 524288;
constexpr size_t OFF_NST = OFF_CMT + 524288;
constexpr size_t OFF_NPST = OFF_NST + (size_t)1056 * 128 * 4;
constexpr size_t OFF_ALOC = OFF_NPST + (size_t)1056 * 128 * 4;
constexpr size_t OFF_BKA = OFF_ALOC + 8192;
constexpr size_t OFF_CTR = OFF_BKA + 8192;
constexpr size_t OFF_BAR = OFF_CTR + 256;
constexpr size_t WS_END = OFF_BAR + 16384;
constexpr size_t OFF_GST = OFF_MQ;
constexpr size_t OFF_PST = OFF_MK;
constexpr size_t OFF_Z = OFF_MQ;

constexpr size_t OFF_Q2 = OFF_S5U;
constexpr size_t OFF_IDX = OFF_MO;
constexpr size_t OFF_GATE = OFF_MO + (size_t)NP * 8 * 16 * 4;

struct P {
  const float* in[36];
  float* out;
  char* ws;
};

typedef const float* const __attribute__((address_space(4)))* kargp_t;
DI kargp_t karg() { kargp_t k = (kargp_t)__builtin_amdgcn_kernarg_segment_ptr(); asm volatile("" : "+s"(k)); return k; }
#define IN(i) (karg()[i])
#define OUTP ((float*)karg()[36])
#define WSP ((char*)karg()[37])
DI int otid() { int t = threadIdx.x; asm volatile("" : "+v"(t)); return t; }
template <int M> DI int shx_i(int v) {
  if constexpr (M < 32) return __builtin_amdgcn_ds_swizzle(v, 0x1f | (M << 10));
  else return __builtin_amdgcn_ds_bpermute(((otid() & 63) ^ M) << 2, v);
}
#define SHX(v, M) __int_as_float(shx_i<M>(__float_as_int(v)))
#define SHXI(v, M) shx_i<M>(v)
DI unsigned cvtpk(float lo, float hi) { f32x2 v = {lo, hi}; bf16x2_t b = __builtin_convertvector(v, bf16x2_t); return __builtin_bit_cast(unsigned, b); }
DI u16 f2bf(float x) { return (u16)(cvtpk(x, 0.f) & 0xffffu); }
DI float bf2f(u16 x) { return __uint_as_float(((unsigned)x) << 16); }
DI float bflo(unsigned u) { return __uint_as_float(u << 16); }
DI float bfhi(unsigned u) { return __uint_as_float(u & 0xffff0000u); }
DI float wave_sum(float v) { v += SHX(v, 32); v += SHX(v, 16); v += SHX(v, 8); v += SHX(v, 4); v += SHX(v, 2); v += SHX(v, 1); return v; }
DI float wave_max(float v) { v = fmaxf(v, SHX(v, 32)); v = fmaxf(v, SHX(v, 16)); v = fmaxf(v, SHX(v, 8)); v = fmaxf(v, SHX(v, 4)); v = fmaxf(v, SHX(v, 2)); v = fmaxf(v, SHX(v, 1)); return v; }
DI float block_sum(float v, float* red) {
  v = wave_sum(v);
  __syncthreads();
  if ((otid() & 63) == 0) red[otid() >> 6] = v;
  __syncthreads();
  return red[0] + red[1] + red[2] + red[3];
}
DI float sigmoidf_(float x) { return 1.f / (1.f + __expf(-x)); }
DI float gelu_erf(float x) { return 0.5f * x * (1.f + erff(x * 0.70710678118f)); }
DI float silu_(float x) { return x / (1.f + __expf(-x)); }
DI float fexp2(float x) { return __builtin_amdgcn_exp2f(x); }

DI const float* h_in_ptr(const P& p, int L, int pos) {
  int b = pos / SB, s = pos - b * SB;
  if (L == 0) return s < SL ? IN(0) + ((size_t)b * SL + s) * DM : IN(2) + ((size_t)b * SC + (s - SL)) * DM;
  return s < SL ? OUTP + ((size_t)b * SL + s) * DM : (const float*)(WSP + OFF_HC) + ((size_t)b * SC + (s - SL)) * DM;
}
DI float* h_out_ptr(const P& p, int pos) {
  int b = pos / SB, s = pos - b * SB;
  return s < SL ? OUTP + ((size_t)b * SL + s) * DM : (float*)(WSP + OFF_HC) + ((size_t)b * SC + (s - SL)) * DM;
}
DI const float* mod_ptr(const P& p, int L, int pos) {
  int b = pos / SB, s = pos - b * SB;
  int v = s < SL ? b : 4;
  return (const float*)(WSP + OFF_MOD) + ((size_t)L * 5 + v) * 6144;
}

DI void gemm_core(const u16* __restrict__ A, int lda, const u16* __restrict__ B, int ldb, int K, f32x16 (&acc)[2][2], u16* lds) {
  const int tid = otid(), lane = tid & 63, wave = tid >> 6;
  const int wm = wave >> 1, wn = wave & 1, r32 = lane & 31, h = lane >> 5;
  u16* As = lds; u16* Bs = lds + 128 * 72;
  const int lr = tid >> 3, lc = (tid & 7) * 8;
  u32x4 ra[4], rb[4];
  const int nk = K >> 6;
#pragma unroll
  for (int i = 0; i < 4; ++i) {
    ra[i] = *(const u32x4*)(A + (size_t)(lr + 32 * i) * lda + lc);
    rb[i] = *(const u32x4*)(B + (size_t)(lr + 32 * i) * ldb + lc);
  }
#pragma unroll 1
  for (int kt = 0; kt < nk; ++kt) {
    __syncthreads();
#pragma unroll
    for (int i = 0; i < 4; ++i) {
      *(u32x4*)(As + (lr + 32 * i) * 72 + lc) = ra[i];
      *(u32x4*)(Bs + (lr + 32 * i) * 72 + lc) = rb[i];
    }
    __syncthreads();
    if (kt + 1 < nk) {
#pragma unroll
      for (int i = 0; i < 4; ++i) {
        ra[i] = *(const u32x4*)(A + (size_t)(lr + 32 * i) * lda + (kt + 1) * 64 + lc);
        rb[i] = *(const u32x4*)(B + (size_t)(lr + 32 * i) * ldb + (kt + 1) * 64 + lc);
      }
    }
#pragma unroll
    for (int s = 0; s < 4; ++s) {
      bf16x8 af[2], bfr[2];
#pragma unroll
      for (int mi = 0; mi < 2; ++mi) af[mi] = *(const bf16x8*)(As + (wm * 64 + mi * 32 + r32) * 72 + s * 16 + h * 8);
#pragma unroll
      for (int ni = 0; ni < 2; ++ni) bfr[ni] = *(const bf16x8*)(Bs + (wn * 64 + ni * 32 + r32) * 72 + s * 16 + h * 8);
#pragma unroll
      for (int mi = 0; mi < 2; ++mi)
#pragma unroll
        for (int ni = 0; ni < 2; ++ni) acc[mi][ni] = MFMA32(af[mi], bfr[ni], acc[mi][ni]);
    }
  }
}
DI void acc_zero(f32x16 (&acc)[2][2]) {
#pragma unroll
  for (int mi = 0; mi < 2; ++mi)
#pragma unroll
    for (int ni = 0; ni < 2; ++ni)
#pragma unroll
      for (int i = 0; i < 16; ++i) acc[mi][ni][i] = 0.f;
}
#define EPI_LOOP(acc, BODY)                                                                   \
  {                                                                                           \
    const int e_lane = otid() & 63, e_wave = otid() >> 6;                           \
    const int e_wm = e_wave >> 1, e_wn = e_wave & 1, e_r = e_lane & 31, e_h = e_lane >> 5;    \
    _Pragma("unroll") for (int mi = 0; mi < 2; ++mi) _Pragma("unroll") for (int ni = 0; ni < 2; ++ni) \
    _Pragma("unroll") for (int i = 0; i < 16; ++i) {                                         \
      const int row = e_wm * 64 + mi * 32 + (i & 3) + 8 * (i >> 2) + 4 * e_h;                 \
      const int col = e_wn * 64 + ni * 32 + e_r;                                              \
      const float val = acc[mi][ni][i];                                                       \
      BODY                                                                                    \
    }                                                                                         \
  }

template <bool GLUPERM = false>
DI void transpose_tile(const float* __restrict__ src, int K, int N, u16* __restrict__ dst, int tile, float* lds) {
  const int ntn = (N + 63) >> 6;
  const int k0 = (tile / ntn) * 64, n0 = (tile % ntn) * 64;
  const int tid = otid();
  __syncthreads();
  {
    const int r = tid >> 4, c4 = (tid & 15) * 4;
#pragma unroll
    for (int i = 0; i < 4; ++i) {
      const int kk = r + 16 * i;
      float4 v = make_float4(0.f, 0.f, 0.f, 0.f);
      if (n0 + c4 < N) v = *(const float4*)(src + (size_t)(k0 + kk) * N + n0 + c4);
      lds[kk * 65 + c4 + 0] = v.x; lds[kk * 65 + c4 + 1] = v.y; lds[kk * 65 + c4 + 2] = v.z; lds[kk * 65 + c4 + 3] = v.w;
    }
  }
  __syncthreads();
  {
    const int n = tid >> 2, kc = (tid & 3) * 16;
    if (n0 + n < N) {
      unsigned w[8];
#pragma unroll
      for (int j = 0; j < 8; ++j) w[j] = cvtpk(lds[(kc + 2 * j) * 65 + n], lds[(kc + 2 * j + 1) * 65 + n]);
      int nd = n0 + n;
      if (GLUPERM) { const int ca = nd & 511; nd = (ca >> 6) * 128 + ((ca >> 5) & 1) * 64 + (nd >= 512 ? 32 : 0) + (ca & 31); }
      uint4* d = (uint4*)(dst + (size_t)nd * K + k0 + kc);
      d[0] = make_uint4(w[0], w[1], w[2], w[3]);
      d[1] = make_uint4(w[4], w[5], w[6], w[7]);
    }
  }
}
DI void convert_chunk(const float* __restrict__ src, u16* __restrict__ dst, size_t chunk) {
  const size_t o = chunk * 2048 + (size_t)otid() * 8;
  const float4 a = *(const float4*)(src + o), b = *(const float4*)(src + o + 4);
  *(uint4*)(dst + o) = make_uint4(cvtpk(a.x, a.y), cvtpk(a.z, a.w), cvtpk(b.x, b.y), cvtpk(b.z, b.w));
}

DI void convert_chunk_fp8(const float* __restrict__ src, unsigned char* __restrict__ dst, size_t chunk, float scale) {
  const size_t o = chunk * 2048 + (size_t)otid() * 8;
  const float4 a = *(const float4*)(src + o), b = *(const float4*)(src + o + 4);
  int w0 = 0, w1 = 0;
  w0 = __builtin_amdgcn_cvt_pk_fp8_f32(a.x * scale, a.y * scale, w0, false); w0 = __builtin_amdgcn_cvt_pk_fp8_f32(a.z * scale, a.w * scale, w0, true);
  w1 = __builtin_amdgcn_cvt_pk_fp8_f32(b.x * scale, b.y * scale, w1, false); w1 = __builtin_amdgcn_cvt_pk_fp8_f32(b.z * scale, b.w * scale, w1, true);
  *(uint2*)(dst + o) = make_uint2((unsigned)w0, (unsigned)w1);
}

DI void ln_mod_row(const float* __restrict__ hrow, const float* __restrict__ shift, const float* __restrict__ scale, u16* __restrict__ dst, float* red) {
  const int tid = otid();
  const float4 x = *(const float4*)(hrow + tid * 4);
  const float mean = block_sum(x.x + x.y + x.z + x.w, red) * (1.f / DM);
  const float a = x.x - mean, b = x.y - mean, c = x.z - mean, d = x.w - mean;
  const float var = block_sum(a * a + b * b + c * c + d * d, red) * (1.f / DM);
  const float rs = rsqrtf(var + LN_EPS);
  const float4 sh = *(const float4*)(shift + tid * 4), sc = *(const float4*)(scale + tid * 4);
  const float y0 = a * rs * (1.f + sc.x) + sh.x, y1 = b * rs * (1.f + sc.y) + sh.y, y2 = c * rs * (1.f + sc.z) + sh.z, y3 = d * rs * (1.f + sc.w) + sh.w;
  *(uint2*)(dst + tid * 4) = make_uint2(cvtpk(y0, y1), cvtpk(y2, y3));
}

DI void ln_mod_wave(const float* __restrict__ hrow, const float* __restrict__ shift, const float* __restrict__ scale, u16* __restrict__ dst, int lane) {
  float4 x[4];
#pragma unroll
  for (int i = 0; i < 4; ++i) x[i] = *(const float4*)(hrow + lane * 4 + 256 * i);
  float sm = 0.f;
#pragma unroll
  for (int i = 0; i < 4; ++i) sm += x[i].x + x[i].y + x[i].z + x[i].w;
  const float mean = wave_sum(sm) * (1.f / DM);
  float vs = 0.f;
#pragma unroll
  for (int i = 0; i < 4; ++i) { x[i].x -= mean; x[i].y -= mean; x[i].z -= mean; x[i].w -= mean; vs += x[i].x * x[i].x + x[i].y * x[i].y + x[i].z * x[i].z + x[i].w * x[i].w; }
  const float rs = rsqrtf(wave_sum(vs) * (1.f / DM) + LN_EPS);
#pragma unroll
  for (int i = 0; i < 4; ++i) {
    const float4 sh = *(const float4*)(shift + lane * 4 + 256 * i), sc = *(const float4*)(scale + lane * 4 + 256 * i);
    *(uint2*)(dst + lane * 4 + 256 * i) = make_uint2(cvtpk(x[i].x * rs * (1.f + sc.x) + sh.x, x[i].y * rs * (1.f + sc.y) + sh.y), cvtpk(x[i].z * rs * (1.f + sc.z) + sh.z, x[i].w * rs * (1.f + sc.w) + sh.w));
  }
}

template <int VD>
DI void attn_pass(const u16* __restrict__ qrow, const u16* __restrict__ Kb, int ldk, const u16* __restrict__ Vt, int nkeys, f32x16 (&O)[VD / 32], float& lsum, u16* lds) {
  constexpr int NV = VD / 32;
  const int tid = otid(), lane = tid & 63, r32 = lane & 31, h = lane >> 5;
  u16* Ks = lds; u16* Vs = lds + 64 * 72;
  bf16x8 qf[4];
#pragma unroll
  for (int s = 0; s < 4; ++s) qf[s] = *(const bf16x8*)(qrow + s * 16 + h * 8);
#pragma unroll
  for (int vb = 0; vb < NV; ++vb)
#pragma unroll
    for (int i = 0; i < 16; ++i) O[vb][i] = 0.f;
  float m = -INFINITY, l = 0.f;
  const float c = 0.125f * LOG2E;
  const int lr = tid >> 3, lc = (tid & 7) * 8;
  u32x4 rk[2], rv[NV];
#pragma unroll
  for (int i = 0; i < 2; ++i) rk[i] = *(const u32x4*)(Kb + (size_t)(lr + 32 * i) * ldk + lc);
#pragma unroll
  for (int i = 0; i < NV; ++i) rv[i] = *(const u32x4*)(Vt + (size_t)(lr + 32 * i) * NP + lc);
  for (int k0 = 0; k0 < nkeys; k0 += 64) {
    __syncthreads();
#pragma unroll
    for (int i = 0; i < 2; ++i) *(u32x4*)(Ks + (lr + 32 * i) * 72 + lc) = rk[i];
#pragma unroll
    for (int i = 0; i < NV; ++i) *(u32x4*)(Vs + (lr + 32 * i) * 72 + lc) = rv[i];
    __syncthreads();
    if (k0 + 64 < nkeys) {
#pragma unroll
      for (int i = 0; i < 2; ++i) rk[i] = *(const u32x4*)(Kb + (size_t)(k0 + 64 + lr + 32 * i) * ldk + lc);
#pragma unroll
      for (int i = 0; i < NV; ++i) rv[i] = *(const u32x4*)(Vt + (size_t)(lr + 32 * i) * NP + k0 + 64 + lc);
    }
    f32x16 S[2];
#pragma unroll
    for (int kb = 0; kb < 2; ++kb)
#pragma unroll
      for (int i = 0; i < 16; ++i) S[kb][i] = 0.f;
#pragma unroll
    for (int s = 0; s < 4; ++s)
#pragma unroll
      for (int kb = 0; kb < 2; ++kb) {
        const bf16x8 kf = *(const bf16x8*)(Ks + (kb * 32 + r32) * 72 + s * 16 + h * 8);
        S[kb] = MFMA32(kf, qf[s], S[kb]);
      }
    float mx = S[0][0];
#pragma unroll
    for (int kb = 0; kb < 2; ++kb)
#pragma unroll
      for (int i = 0; i < 16; ++i) mx = fmaxf(mx, S[kb][i]);
    mx = fmaxf(mx, SHX(mx, 32));
    if (__ballot(mx > m + 40.f) != 0ull) {
      const float mn = fmaxf(m, mx);
      const float alpha = fexp2((m - mn) * c);
      m = mn;
      l *= alpha;
#pragma unroll
      for (int vb = 0; vb < NV; ++vb)
#pragma unroll
        for (int i = 0; i < 16; ++i) O[vb][i] *= alpha;
    }
    const float mc = m * c;
    float rs = 0.f;
#pragma unroll
    for (int kb = 0; kb < 2; ++kb)
#pragma unroll
      for (int i = 0; i < 16; ++i) { const float pv = fexp2(S[kb][i] * c - mc); S[kb][i] = pv; rs += pv; }
    l += rs;
#pragma unroll
    for (int kb = 0; kb < 2; ++kb)
#pragma unroll
      for (int s2 = 0; s2 < 2; ++s2) {
        uint4 pw;
        pw.x = cvtpk(S[kb][8 * s2 + 0], S[kb][8 * s2 + 1]); pw.y = cvtpk(S[kb][8 * s2 + 2], S[kb][8 * s2 + 3]);
        pw.z = cvtpk(S[kb][8 * s2 + 4], S[kb][8 * s2 + 5]); pw.w = cvtpk(S[kb][8 * s2 + 6], S[kb][8 * s2 + 7]);
        const bf16x8 pf = __builtin_bit_cast(bf16x8, pw);
#pragma unroll
        for (int vb = 0; vb < NV; ++vb) {
          const u16* vp = Vs + (vb * 32 + r32) * 72 + kb * 32 + s2 * 16 + 4 * h;
          const s16x4 lo = *(const s16x4*)vp, hi = *(const s16x4*)(vp + 8);
          const bf16x8 vf = __builtin_shufflevector(lo, hi, 0, 1, 2, 3, 4, 5, 6, 7);
          O[vb] = MFMA32(vf, pf, O[vb]);
        }
      }
  }
  lsum = l + SHX(l, 32);
}

DI void attn_pass_gqa2(const u16* __restrict__ qrow0, const u16* __restrict__ qrow1, const u16* __restrict__ Kb, int ldk, const u16* __restrict__ Vt, int nkeys,
                       f32x16 (&O)[2][2], float (&lsum)[2], u16* lds) {
  const int tid = otid(), lane = tid & 63, r32 = lane & 31, h = lane >> 5;
  u16* Ks = lds; u16* Vs = lds + 64 * 72;
  bf16x8 qf[2][4];
#pragma unroll
  for (int s = 0; s < 4; ++s) { qf[0][s] = *(const bf16x8*)(qrow0 + s * 16 + h * 8); qf[1][s] = *(const bf16x8*)(qrow1 + s * 16 + h * 8); }
#pragma unroll
  for (int hd = 0; hd < 2; ++hd)
#pragma unroll
    for (int vb = 0; vb < 2; ++vb)
#pragma unroll
      for (int i = 0; i < 16; ++i) O[hd][vb][i] = 0.f;
  float m[2] = {-INFINITY, -INFINITY}, l[2] = {0.f, 0.f};
  const float c = 0.125f * LOG2E;
  const int lr = tid >> 3, lc = (tid & 7) * 8;
  u32x4 rk[2], rv[2];
#pragma unroll
  for (int i = 0; i < 2; ++i) rk[i] = *(const u32x4*)(Kb + (size_t)(lr + 32 * i) * ldk + lc);
#pragma unroll
  for (int i = 0; i < 2; ++i) rv[i] = *(const u32x4*)(Vt + (size_t)(lr + 32 * i) * NP + lc);
  for (int k0 = 0; k0 < nkeys; k0 += 64) {
    __syncthreads();
#pragma unroll
    for (int i = 0; i < 2; ++i) *(u32x4*)(Ks + (lr + 32 * i) * 72 + lc) = rk[i];
#pragma unroll
    for (int i = 0; i < 2; ++i) *(u32x4*)(Vs + (lr + 32 * i) * 72 + lc) = rv[i];
    __syncthreads();
    if (k0 + 64 < nkeys) {
#pragma unroll
      for (int i = 0; i < 2; ++i) rk[i] = *(const u32x4*)(Kb + (size_t)(k0 + 64 + lr + 32 * i) * ldk + lc);
#pragma unroll
      for (int i = 0; i < 2; ++i) rv[i] = *(const u32x4*)(Vt + (size_t)(lr + 32 * i) * NP + k0 + 64 + lc);
    }
#pragma unroll
    for (int hd = 0; hd < 2; ++hd) {
      f32x16 S[2];
#pragma unroll
      for (int kb = 0; kb < 2; ++kb)
#pragma unroll
        for (int i = 0; i < 16; ++i) S[kb][i] = 0.f;
#pragma unroll
      for (int s = 0; s < 4; ++s)
#pragma unroll
        for (int kb = 0; kb < 2; ++kb) {
          const bf16x8 kf = *(const bf16x8*)(Ks + (kb * 32 + r32) * 72 + s * 16 + h * 8);
          S[kb] = MFMA32(kf, qf[hd][s], S[kb]);
        }
      float mx = S[0][0];
#pragma unroll
      for (int kb = 0; kb < 2; ++kb)
#pragma unroll
        for (int i = 0; i < 16; ++i) mx = fmaxf(mx, S[kb][i]);
      mx = fmaxf(mx, SHX(mx, 32));
      if (__ballot(mx > m[hd] + 40.f) != 0ull) {
        const float mn = fmaxf(m[hd], mx);
        const float alpha = fexp2((m[hd] - mn) * c);
        m[hd] = mn;
        l[hd] *= alpha;
#pragma unroll
        for (int vb = 0; vb < 2; ++vb)
#pragma unroll
          for (int i = 0; i < 16; ++i) O[hd][vb][i] *= alpha;
      }
      const float mc = m[hd] * c;
      float rs = 0.f;
#pragma unroll
      for (int kb = 0; kb < 2; ++kb)
#pragma unroll
        for (int i = 0; i < 16; ++i) { const float pv = fexp2(S[kb][i] * c - mc); S[kb][i] = pv; rs += pv; }
      l[hd] += rs;
#pragma unroll
      for (int kb = 0; kb < 2; ++kb)
#pragma unroll
        for (int s2 = 0; s2 < 2; ++s2) {
          uint4 pw;
          pw.x = cvtpk(S[kb][8 * s2 + 0], S[kb][8 * s2 + 1]); pw.y = cvtpk(S[kb][8 * s2 + 2], S[kb][8 * s2 + 3]);
          pw.z = cvtpk(S[kb][8 * s2 + 4], S[kb][8 * s2 + 5]); pw.w = cvtpk(S[kb][8 * s2 + 6], S[kb][8 * s2 + 7]);
          const bf16x8 pf = __builtin_bit_cast(bf16x8, pw);
#pragma unroll
          for (int vb = 0; vb < 2; ++vb) {
            const u16* vp = Vs + (vb * 32 + r32) * 72 + kb * 32 + s2 * 16 + 4 * h;
            const s16x4 lo = *(const s16x4*)vp, hi = *(const s16x4*)(vp + 8);
            const bf16x8 vf = __builtin_shufflevector(lo, hi, 0, 1, 2, 3, 4, 5, 6, 7);
            O[hd][vb] = MFMA32(vf, pf, O[hd][vb]);
          }
        }
    }
  }
  lsum[0] = l[0] + SHX(l[0], 32);
  lsum[1] = l[1] + SHX(l[1], 32);
}

DI int chain_idx(int dir, int s) { return dir == 0 ? (s < SL ? s + SC : s - SL) : (SB - 1 - s); }
DI void mlstm_dir(const bf16x8 (&qf)[8], const u16* __restrict__ Kb, const u16* __restrict__ Vt, const float* __restrict__ Aarr, const float* __restrict__ tmax, int dir,
                  int t0a, int t0b, int t1a, int t1b, int cq, float mxq, f32x16 (&num)[4], float& den_out, char* smem) {
  const int tid = otid(), lane = tid & 63, r32 = lane & 31, h = lane >> 5;
  u16* Ks = (u16*)smem; u16* Vs = (u16*)(smem + 17408); float* As = (float*)(smem + 17408 + 18432);
  float den = 0.f;
  const int n0 = t0b - t0a, nall = n0 + (t1b - t1a);
  const int kr = tid >> 4, kc = (tid & 15) * 8, vr = tid >> 3, vc = (tid & 7) * 8;
  u32x4 rk[4], rv[4]; float ra = 0.f;
  int* tlist = (int*)(smem + 17408 + 18432 + 256);
  float* tred = (float*)(smem + 17408 + 18432 + 256 + 544);
  {
    float mn = fminf(mxq, SHX(mxq, 32));
    mn = fminf(mn, SHX(mn, 16)); mn = fminf(mn, SHX(mn, 8)); mn = fminf(mn, SHX(mn, 4)); mn = fminf(mn, SHX(mn, 2)); mn = fminf(mn, SHX(mn, 1));
    __syncthreads();
    if (lane == 0) tred[tid >> 6] = mn;
    __syncthreads();
    if (tid == 0) {
      const float bmin = fminf(fminf(tred[0], tred[1]), fminf(tred[2], tred[3]));
      int cnt = 0;
      for (int u = 0; u < nall; ++u) {
        const int k0 = u < n0 ? SL + 64 * (t0a + u) : 64 * (t1a + u - n0);
        if (tmax[k0 >> 6] * LOG2E - bmin > -64.f) tlist[1 + cnt++] = k0;
      }
      tlist[0] = cnt;
    }
    __syncthreads();
  }
  const int ntile = tlist[0];
  auto tile_k0 = [&](int u) { return tlist[1 + u]; };
  if (ntile > 0) {
    const int k0 = tile_k0(0);
#pragma unroll
    for (int i = 0; i < 4; ++i) rk[i] = *(const u32x4*)(Kb + (size_t)(k0 + kr + 16 * i) * 512 + kc);
#pragma unroll
    for (int i = 0; i < 4; ++i) rv[i] = *(const u32x4*)(Vt + (size_t)(vr + 32 * i) * NP + k0 + vc);
    if (tid < 64) ra = Aarr[k0 + tid] * LOG2E;
  }
  for (int u = 0; u < ntile; ++u) {
    const int k0 = tile_k0(u);
    __syncthreads();
#pragma unroll
    for (int i = 0; i < 4; ++i) *(u32x4*)(Ks + (kr + 16 * i) * 136 + kc) = rk[i];
#pragma unroll
    for (int i = 0; i < 4; ++i) *(u32x4*)(Vs + (vr + 32 * i) * 72 + vc) = rv[i];
    if (tid < 64) As[tid] = ra;
    __syncthreads();
    if (u + 1 < ntile) {
      const int k1 = tile_k0(u + 1);
#pragma unroll
      for (int i = 0; i < 4; ++i) rk[i] = *(const u32x4*)(Kb + (size_t)(k1 + kr + 16 * i) * 512 + kc);
#pragma unroll
      for (int i = 0; i < 4; ++i) rv[i] = *(const u32x4*)(Vt + (size_t)(vr + 32 * i) * NP + k1 + vc);
      if (tid < 64) ra = Aarr[k1 + tid] * LOG2E;
    }
    f32x16 S[2];
#pragma unroll
    for (int kb = 0; kb < 2; ++kb)
#pragma unroll
      for (int i = 0; i < 16; ++i) S[kb][i] = 0.f;
#pragma unroll
    for (int s = 0; s < 8; ++s)
#pragma unroll
      for (int kb = 0; kb < 2; ++kb) {
        const bf16x8 kf = *(const bf16x8*)(Ks + (kb * 32 + r32) * 136 + s * 16 + h * 8);
        S[kb] = MFMA32(kf, qf[s], S[kb]);
      }
#pragma unroll
    for (int kb = 0; kb < 2; ++kb)
#pragma unroll
      for (int g = 0; g < 4; ++g) {
        const float4 a4 = *(const float4*)(As + kb * 32 + 8 * g + 4 * h);
        const float av[4] = {a4.x, a4.y, a4.z, a4.w};
#pragma unroll
        for (int e = 0; e < 4; ++e) {
          const int sk = k0 + kb * 32 + 8 * g + 4 * h + e;
          const int ck = chain_idx(dir, sk);
          const float w = (ck <= cq) ? fexp2(fminf(av[e] - mxq, 0.f)) : 0.f;
          const float pv = S[kb][4 * g + e] * w;
          S[kb][4 * g + e] = pv; den += pv;
        }
      }
#pragma unroll
    for (int kb = 0; kb < 2; ++kb)
#pragma unroll
      for (int s2 = 0; s2 < 2; ++s2) {
        uint4 pw;
        pw.x = cvtpk(S[kb][8 * s2 + 0], S[kb][8 * s2 + 1]); pw.y = cvtpk(S[kb][8 * s2 + 2], S[kb][8 * s2 + 3]);
        pw.z = cvtpk(S[kb][8 * s2 + 4], S[kb][8 * s2 + 5]); pw.w = cvtpk(S[kb][8 * s2 + 6], S[kb][8 * s2 + 7]);
        const bf16x8 pf = __builtin_bit_cast(bf16x8, pw);
#pragma unroll
        for (int vb = 0; vb < 4; ++vb) {
          const u16* vp = Vs + (vb * 32 + r32) * 72 + kb * 32 + s2 * 16 + 4 * h;
          const s16x4 lo = *(const s16x4*)vp, hi = *(const s16x4*)(vp + 8);
          const bf16x8 vf = __builtin_shufflevector(lo, hi, 0, 1, 2, 3, 4, 5, 6, 7);
          num[vb] = MFMA32(vf, pf, num[vb]);
        }
      }
  }
  den_out += den + SHX(den, 32);
}

DI void s5_load_u(const u16* __restrict__ S5U, int b, int lo, int g, float* lu, int lane) {
  const u16* src = S5U + ((size_t)b * SB + lo + lane) * 512 + g * 16;
  const uint4 a = *(const uint4*)src, c = *(const uint4*)(src + 8);
  float* d = lu + lane * 16;
  d[0] = bflo(a.x); d[1] = bfhi(a.x); d[2] = bflo(a.y); d[3] = bfhi(a.y); d[4] = bflo(a.z); d[5] = bfhi(a.z); d[6] = bflo(a.w); d[7] = bfhi(a.w);
  d[8] = bflo(c.x); d[9] = bfhi(c.x); d[10] = bflo(c.y); d[11] = bfhi(c.y); d[12] = bflo(c.z); d[13] = bfhi(c.z); d[14] = bflo(c.w); d[15] = bfhi(c.w);
}

DI void s5_bu_half(const u16* __restrict__ urow, const bf16x8 (&bfr)[4], u16* W, int r32, int h) {
  const bf16x8 af = *(const bf16x8*)urow;
#pragma unroll
  for (int j = 0; j < 4; ++j) {
    f32x16 z;
#pragma unroll
    for (int i = 0; i < 16; ++i) z[i] = 0.f;
    const f32x16 acc = MFMA32(af, bfr[j], z);
#pragma unroll
    for (int i = 0; i < 16; ++i) W[((i & 3) + 8 * (i >> 2) + 4 * h) * 136 + 32 * j + r32] = f2bf(acc[i]);
  }
}
template <bool WB>
DI void s5_scan_half(u16* W, int dir, int recol, float2 lam, float& hr, float& hi) {
#pragma unroll 4
  for (int q = 0; q < 32; ++q) {
    const int t = dir ? 31 - q : q;
    const float br = bf2f(W[t * 136 + recol]), bi = bf2f(W[t * 136 + recol + 32]);
    const float nr = lam.x * hr - lam.y * hi + br, ni = lam.x * hi + lam.y * hr + bi;
    hr = nr; hi = ni;
    if (WB) { W[t * 136 + recol] = f2bf(hr); W[t * 136 + recol + 32] = f2bf(hi); }
  }
}

__device__ const unsigned char PEER_PAIRS[64] = {0, 1, 2, 3, 4, 5, 6, 7, 8, 9, 10, 11, 12, 13, 14, 15, 16, 17, 18, 19, 20, 21, 22, 23, 32, 33, 34, 35, 36, 48, 49, 50, 51, 64, 65, 66, 80, 81, 96, 97, 112, 113, 128, 144, 160, 176, 192, 208, 224, 240, 0, 0, 0, 0, 0, 0, 0, 0, 0, 0, 0, 0, 0, 0};

constexpr int NPH_LAYER = 14;
constexpr int NPHASES = 2 + 2 * NPH_LAYER;

__device__ __forceinline__ void run_phase(const P& p, int ph, char* smem) {
  const int tid = otid(), lane = tid & 63, wave = tid >> 6;
  const int G = gridDim.x, bid = blockIdx.x;
  char* ws = WSP;
  float* fsm = (float*)smem;
  u16* usm = (u16*)smem;

  if (ph == 0) {
    const int n_mod = 2 * 8 * 24, n_s5 = 32, n_all = n_mod + n_s5 + 2;
    for (int it = bid; it < n_all; it += G) {
      if (it < n_mod) {
        const int L = it / 192, ic = (it / 24) % 8, jc = it % 24;
        __syncthreads();
        for (int e = tid; e < 5 * 128; e += 256) {
          const int v = e / 128, i = ic * 128 + (e % 128);
          const float cv = v < 4 ? IN(1)[v * DM + i] : IN(3)[i];
          fsm[e] = silu_(cv);
        }
        __syncthreads();
        const int j = jc * 256 + tid;
        const float* w = IN(4) + ((size_t)L * DM + ic * 128) * 6144 + j;
        float a0 = 0, a1 = 0, a2 = 0, a3 = 0, a4 = 0;
#pragma unroll 8
        for (int i = 0; i < 128; ++i) {
          const float wv = w[(size_t)i * 6144];
          a0 += fsm[i] * wv; a1 += fsm[128 + i] * wv; a2 += fsm[256 + i] * wv; a3 += fsm[384 + i] * wv; a4 += fsm[512 + i] * wv;
        }
        float* o = (float*)(ws + OFF_MODP) + ((size_t)(L * 8 + ic) * 5) * 6144 + j;
        o[0] = a0; o[6144] = a1; o[2 * 6144] = a2; o[3 * 6144] = a3; o[4 * 6144] = a4;
      } else if (it < n_mod + n_s5) {
        const int e = (it - n_mod) * 256 + tid;
        const int n = e & 63, g = (e >> 6) & 31, ld = e >> 11;
        const float dt = expf(IN(14)[ld * 32 + g]);
        const float ar = IN(12)[e], ai = IN(13)[e];
        const float mag = expf(ar * dt);
        float sn, cs; sincosf(ai * dt, &sn, &cs);
        const float lr = mag * cs, li = mag * sn;
        const float dn = ar * ar + ai * ai;
        const float cr = ((lr - 1.f) * ar + li * ai) / dn, ci = (li * ar - (lr - 1.f) * ai) / dn;
        ((float2*)(ws + OFF_LAMB))[e] = make_float2(lr, li);
        float2* bb = (float2*)(ws + OFF_BBAR) + (size_t)e * 16;
        const float* br = IN(15) + (size_t)e * 16; const float* bi = IN(16) + (size_t)e * 16;
        const int colre = n < 32 ? n : n + 32, colim = colre + 32;
        u16* bbt = (u16*)(ws + OFF_BBT) + (size_t)(e >> 6) * 2048;
        u16* cmt = (u16*)(ws + OFF_CMT) + (size_t)(e >> 6) * 2048;
        for (int c = 0; c < 16; ++c) {
          const float2 v = make_float2(cr * br[c] - ci * bi[c], cr * bi[c] + ci * br[c]);
          bb[c] = v;
          bbt[colre * 16 + c] = f2bf(v.x); bbt[colim * 16 + c] = f2bf(v.y);
          cmt[c * 128 + colre] = f2bf(IN(17)[((size_t)(e >> 6) * 16 + c) * 64 + n]);
          cmt[c * 128 + colim] = f2bf(-IN(18)[((size_t)(e >> 6) * 16 + c) * 64 + n]);
        }
      } else if (it == n_mod + n_s5 + 1) {
        for (int e = tid; e < 192 * 16; e += 256) {
          const int r = e >> 4, i = e & 15;
          const float inv = exp2f(-(float)i * (13.287712379549449f / 16.f));
          float sn, cs; sincosf((float)(r < 128 ? r : r - 128) * inv, &sn, &cs);
          ((float2*)(ws + OFF_ROPE))[e] = make_float2(cs, sn);
        }
      } else {
        if (tid >= 64 && tid < 72) ((int*)(ws + OFF_CTR))[tid - 64] = 0;
        if (tid < 2) {
          const float* lv = IN(8) + tid * 256;
          float s01 = 0.f, s23 = 0.f;
          for (int i = 0; i < 64; ++i) { s01 += lv[i] * lv[64 + i]; s23 += lv[128 + i] * lv[192 + i]; }
          const float lam_init = 0.8f - 0.6f * expf(-0.3f * (float)tid);
          ((float*)(ws + OFF_LAMV))[tid] = expf(s01) - expf(s23) + lam_init;
        }
      }
    }
    return;
  }
  if (ph == 1) {
    const int n_all = 2 * 5 * 6144 / 256;
    for (int it = bid; it < n_all; it += G) {
      const int e = it * 256 + tid;
      const int L = e / (5 * 6144), v = (e / 6144) % 5, j = e % 6144;
      float a = IN(5)[L * 6144 + j];
      for (int ic = 0; ic < 8; ++ic) a += ((const float*)(ws + OFF_MODP))[((size_t)(L * 8 + ic) * 5 + v) * 6144 + j];
      ((float*)(ws + OFF_MOD))[e] = a;
    }
    return;
  }
  const int L = (ph - 2) / NPH_LAYER, k = (ph - 2) % NPH_LAYER;
  u16* XM = (u16*)(ws + OFF_A);
  u16* WinT = (u16*)(ws + OFF_WIN);

  int* s_next = (int*)(smem + 57336);
#define FETCH_ITEM() ([&]() { __syncthreads(); if (otid() == 0) *s_next = atomicAdd(ctr, 1); __syncthreads(); return *s_next; }())
  if (k == 0) {
    const int n_win = 16 * 141, n_wbr = 4 * 8 * 16, n_wo = 256, n_wg = 128, n_wq = 512, n_sk = 16;
    const int n_w = n_win + n_wbr + n_wo + n_wg + n_wq + n_sk;
    const int n_all = n_w + NP / 4;
    for (int it = bid; it < n_all; it += G) {
      if (it < n_w) {
        int t = it;
        if (t < n_win) { transpose_tile(IN(6) + (size_t)L * DM * NIN, DM, NIN, WinT, t, fsm); continue; }
        t -= n_win;
        if (t < n_wbr) { const int kb = t / 128; transpose_tile(IN(26) + ((size_t)L * 4 + kb) * 512 * DM, 512, DM, (u16*)(ws + OFF_WBR) + (size_t)kb * DM * 512, t % 128, fsm); continue; }
        t -= n_wbr;
        if (t < n_wo) { transpose_tile(IN(27) + (size_t)L * DM * DM, DM, DM, (u16*)(ws + OFF_WO), t, fsm); continue; }
        t -= n_wo;
        if (t < n_wg) { transpose_tile<true>(IN(20) + (size_t)L * 512 * DM, 512, DM, (u16*)(ws + OFF_WGLU), t, fsm); continue; }
        t -= n_wg;
        if (t < n_wq) { transpose_tile(IN(32) + (size_t)L * DM * 2048, DM, 2048, (u16*)(ws + OFF_WQ), t, fsm); continue; }
        t -= n_wq;
        convert_chunk(IN(33) + (size_t)L * 32768, (u16*)(ws + OFF_SK), t);
      } else {
        const int pos = (it - n_w) * 4 + wave;
        const float* md = mod_ptr(p, L, pos);
        ln_mod_wave(h_in_ptr(p, L, pos), md, md + 1024, XM + (size_t)pos * DM, lane);
      }
    }
    return;
  }
  if (k == 1) {
    const int n_all = 264 * 39;
    for (int it = bid; it < n_all; it += G) {
      const int mt = it / 39, j = it % 39;
      f32x16 acc[2][2]; acc_zero(acc);
      if (j < 30) {
        int src; u16* dst; int ldd = 512, dcol;
        if (j < 4) { src = j * 128; dst = (u16*)(ws + OFF_QD); dcol = j * 128; }
        else if (j < 8) { src = 512 + (j - 4) * 128; dst = (u16*)(ws + OFF_KD); dcol = (j - 4) * 128; }
        else if (j < 12) { src = 1536 + (j - 8) * 128; dst = (u16*)(ws + OFF_S5U); dcol = (j - 8) * 128; }
        else if (j < 16) { src = 2048 + (j - 12) * 128; dst = (u16*)(ws + OFF_MQ); dcol = (j - 12) * 128; }
        else if (j < 20) { src = 2560 + (j - 16) * 128; dst = (u16*)(ws + OFF_MK); dcol = (j - 16) * 128; }
        else if (j < 24) { src = 3584 + (j - 20) * 128; dst = (u16*)(ws + OFF_MO); dcol = (j - 20) * 128; }
        else if (j < 28) { src = 4112 + (j - 24) * 128; dst = (u16*)(ws + OFF_QG); dcol = (j - 24) * 128; }
        else if (j == 28) { src = 4624; dst = (u16*)(ws + OFF_KG); dcol = 0; ldd = 128; }
        else { src = 4096; dst = nullptr; dcol = 0; }
        gemm_core(XM + (size_t)mt * 128 * DM, DM, WinT + (size_t)src * DM, DM, DM, acc, usm);
        if (j < 29) {
          EPI_LOOP(acc, { dst[(size_t)(mt * 128 + row) * ldd + dcol + col] = f2bf(val); })
        } else {
          float* mg = (float*)(ws + OFF_MGATE);
          EPI_LOOP(acc, { if (col < 16) mg[(size_t)(mt * 128 + row) * 16 + col] = val; })
        }
      } else {
        const int jj = j - 30;
        int src; u16* dst; int drow;
        if (jj < 4) { src = 1024 + jj * 128; dst = (u16*)(ws + OFF_VDT); drow = jj * 128; }
        else if (jj < 8) { src = 3072 + (jj - 4) * 128; dst = (u16*)(ws + OFF_MVT); drow = (jj - 4) * 128; }
        else { src = 4752; dst = (u16*)(ws + OFF_VGT); drow = 0; }
        gemm_core(WinT + (size_t)src * DM, DM, XM + (size_t)mt * 128 * DM, DM, DM, acc, usm);
        EPI_LOOP(acc, { dst[(size_t)(drow + row) * NP + mt * 128 + col] = f2bf(val); })
      }
    }
    return;
  }
  if (k == 2) {
    const int n_s5 = NB * 2 * 32 * 132 / 4;
    const int n_pp = NP / 4;
    const int n_all = n_pp + n_s5;
    for (int it = bid; it < n_all; it += G) {
      if (it < n_pp) {
        const int pos = it * 4 + wave, b = pos / SB, s = pos - b * SB;
        const bool lat = s < SL;
        const int rrow = s >> 6, rcol = 128 + (s & 63);
        if (lat) {
          const int vec = lane >> 2, half = (lane >> 1) & 1, i0 = (lane & 1) * 8;
          u16* base = (u16*)(ws + (vec < 8 ? OFF_QD : OFF_KD)) + (size_t)pos * 512 + (vec & 7) * 64 + half * 32 + i0;
          const u32x4 a = *(const u32x4*)base, b = *(const u32x4*)(base + 16);
          const float4* tb = (const float4*)((const float2*)(ws + OFF_ROPE) + (half ? rcol : rrow) * 16 + i0);
          const float4 t0 = tb[0], t1 = tb[1], t2 = tb[2], t3 = tb[3];
          const float x1[8] = {bflo(a.x), bfhi(a.x), bflo(a.y), bfhi(a.y), bflo(a.z), bfhi(a.z), bflo(a.w), bfhi(a.w)};
          const float x2[8] = {bflo(b.x), bfhi(b.x), bflo(b.y), bfhi(b.y), bflo(b.z), bfhi(b.z), bflo(b.w), bfhi(b.w)};
          const float cs[8] = {t0.x, t0.z, t1.x, t1.z, t2.x, t2.z, t3.x, t3.z};
          const float sn[8] = {t0.y, t0.w, t1.y, t1.w, t2.y, t2.w, t3.y, t3.w};
          float o1[8], o2[8];
#pragma unroll
          for (int e = 0; e < 8; ++e) { o1[e] = x1[e] * cs[e] - x2[e] * sn[e]; o2[e] = x2[e] * cs[e] + x1[e] * sn[e]; }
          u32x4 w1, w2;
          w1.x = cvtpk(o1[0], o1[1]); w1.y = cvtpk(o1[2], o1[3]); w1.z = cvtpk(o1[4], o1[5]); w1.w = cvtpk(o1[6], o1[7]);
          w2.x = cvtpk(o2[0], o2[1]); w2.y = cvtpk(o2[2], o2[3]); w2.z = cvtpk(o2[4], o2[5]); w2.w = cvtpk(o2[6], o2[7]);
          *(u32x4*)base = w1; *(u32x4*)(base + 16) = w2;
        }
        {
          const int c = lane & 7, hh = c >> 2, ie = (c & 1) * 8;
          const float4* tb = (const float4*)((const float2*)(ws + OFF_ROPE) + (hh ? rcol : rrow) * 16 + ie);
          const float4 t0 = tb[0], t1 = tb[1], t2 = tb[2], t3 = tb[3];
          const float cs[8] = {t0.x, t0.z, t1.x, t1.z, t2.x, t2.z, t3.x, t3.z};
          const float sn[8] = {t0.y, t0.w, t1.y, t1.w, t2.y, t2.w, t3.y, t3.w};
#pragma unroll
          for (int rnd = 0; rnd < 2; ++rnd) {
            const bool act = rnd == 0 || lane < 16;
            const int vec = lane >> 3;
            u16* ptr = rnd == 0 ? (u16*)(ws + OFF_QG) + (size_t)pos * 512 + vec * 64 + c * 8 : (u16*)(ws + OFF_KG) + (size_t)pos * 128 + (vec & 1) * 64 + c * 8;
            const float* gp = (rnd == 0 ? IN(10) : IN(11)) + L * 64 + c * 8;
            const u32x4 a = *(const u32x4*)ptr;
            const float4 g0 = *(const float4*)gp, g1 = *(const float4*)(gp + 4);
            float x[8] = {bflo(a.x), bfhi(a.x), bflo(a.y), bfhi(a.y), bflo(a.z), bfhi(a.z), bflo(a.w), bfhi(a.w)};
            float ss = 0.f;
#pragma unroll
            for (int e = 0; e < 8; ++e) ss += x[e] * x[e];
            ss += SHX(ss, 1); ss += SHX(ss, 2); ss += SHX(ss, 4);
            const float rs = rsqrtf(ss * (1.f / 64.f) + LN_EPS);
            const float gg[8] = {g0.x, g0.y, g0.z, g0.w, g1.x, g1.y, g1.z, g1.w};
            float y[8];
#pragma unroll
            for (int e = 0; e < 8; ++e) y[e] = x[e] * rs * gg[e];
            if (lat) {
#pragma unroll
              for (int e = 0; e < 8; ++e) {
                const float yp = SHX(y[e], 2);
                x[e] = (c & 2) ? (y[e] * cs[e] + yp * sn[e]) : (y[e] * cs[e] - yp * sn[e]);
              }
#pragma unroll
              for (int e = 0; e < 8; ++e) y[e] = x[e];
            }
            if (act) { u32x4 w; w.x = cvtpk(y[0], y[1]); w.y = cvtpk(y[2], y[3]); w.z = cvtpk(y[4], y[5]); w.w = cvtpk(y[6], y[7]); *(u32x4*)ptr = w; }
          }
        }
        {
          const int seg_lo = lat ? 0 : SL, seg_hi = lat ? SL - 1 : SB - 1;
#pragma unroll
          for (int q = 0; q < 4; ++q) {
            const int ch = (lane + 64 * q) * 4;
            const u16* raw = (const u16*)(ws + (ch < 512 ? OFF_MQ : OFF_MK)) + (ch & 511);
            const uint2 xc = *(const uint2*)(raw + (size_t)pos * 512);
            uint2 xm = make_uint2(0, 0), xp = make_uint2(0, 0);
            if (s > seg_lo) xm = *(const uint2*)(raw + (size_t)(pos - 1) * 512);
            if (s < seg_hi) xp = *(const uint2*)(raw + (size_t)(pos + 1) * 512);
            const float* cw = IN(22) + (size_t)L * 3 * 1024 + ch; const float* cb = IN(23) + (size_t)L * 1024 + ch;
            const float4 w0 = *(const float4*)cw, w1 = *(const float4*)(cw + 1024), w2 = *(const float4*)(cw + 2048), bb = *(const float4*)cb;
            float o0 = bb.x + w0.x * bflo(xm.x) + w1.x * bflo(xc.x) + w2.x * bflo(xp.x);
            float o1 = bb.y + w0.y * bfhi(xm.x) + w1.y * bfhi(xc.x) + w2.y * bfhi(xp.x);
            float o2 = bb.z + w0.z * bflo(xm.y) + w1.z * bflo(xc.y) + w2.z * bflo(xp.y);
            float o3 = bb.w + w0.w * bfhi(xm.y) + w1.w * bfhi(xc.y) + w2.w * bfhi(xp.y);
            const float ksc = ch < 512 ? 1.f : 0.08838834764831845f;
            o0 = silu_(o0) * ksc; o1 = silu_(o1) * ksc; o2 = silu_(o2) * ksc; o3 = silu_(o3) * ksc;
            u16* dstc = (u16*)(ws + OFF_A) + (ch < 512 ? (size_t)0 : (size_t)NP * 512) + (size_t)pos * 512 + (ch & 511);
            *(uint2*)dstc = make_uint2(cvtpk(o0, o1), cvtpk(o2, o3));
          }
        }
        if (lane < 16) {
          const float g = ((const float*)(ws + OFF_MGATE))[(size_t)pos * 16 + lane] + IN(24)[L * 16 + lane];
          const int type = lane >> 2, head = lane & 3, dir = type >> 1;
          const int chain = dir * 16 + b * 4 + head;
          if (type & 1) ((float*)(ws + OFF_GF))[(size_t)chain * SB + s] = fminf(g, 0.f) - log1pf(expf(-fabsf(g)));
          else ((float*)(ws + OFF_GI))[(size_t)chain * SB + s] = g;
        }
      } else {
        const int item = (it - n_pp) * 4 + wave;
        const int kk = item % 132, g = (item / 132) & 31, dir = (item / (132 * 32)) & 1, b = item / (132 * 64);
        const int lo = dir == 0 ? (kk < 4 ? SL + 64 * kk : 64 * (kk - 4)) : (kk < 4 ? SL + 192 - 64 * kk : 8128 - 64 * (kk - 4));
        const int r32 = lane & 31, h = lane >> 5;
        const int ldg = (L * 2 + dir) * 32 + g;
        u16* W = usm + wave * 4352;
        __syncthreads();
        const float2 lam = ((const float2*)(ws + OFF_LAMB))[ldg * 64 + lane];
        bf16x8 bfr[4];
#pragma unroll
        for (int j = 0; j < 4; ++j) bfr[j] = *(const bf16x8*)((const u16*)(ws + OFF_BBT) + ((size_t)ldg * 128 + 32 * j + r32) * 16 + 8 * h);
        const int recol = lane < 32 ? lane : lane + 32;
        float hr = 0.f, hi = 0.f;
#pragma unroll 1
        for (int hq = 0; hq < 2; ++hq) {
          const int hh = dir ? 1 - hq : hq;
          s5_bu_half((const u16*)(ws + OFF_S5U) + ((size_t)b * SB + lo + 32 * hh + r32) * 512 + g * 16 + 8 * h, bfr, W, r32, h);
          s5_scan_half<false>(W, dir, recol, lam, hr, hi);
        }
        ((float2*)(ws + OFF_HEND))[(size_t)item * 64 + lane] = make_float2(hr, hi);
      }
    }
    return;
  }
  if (k == 3) {
    const int n_all = 32 + 64 + 1056;
    for (int it = bid; it < n_all; it += G) {
      if (it >= 96) {
        const int i2 = it - 96, chain = i2 / 33, j = i2 % 33, dir = chain >> 4, b = (chain >> 2) & 3, head = chain & 3;
        const int p0 = j == 0 ? SL : (dir == 0 ? 256 * (j - 1) : SL - 256 * j);
        const int r32 = lane & 31, h = lane >> 5;
        u16* Ks = usm;
        float* wS = fsm + 4352;
        float* red = fsm + 4352 + 256;
        __syncthreads();
        {
          const int so = dir == 0 ? tid : 255 - tid;
          const float lf = ((const float*)(ws + OFF_GF))[(size_t)chain * SB + p0 + so];
          const float ig = ((const float*)(ws + OFF_GI))[(size_t)chain * SB + p0 + so];
          float x = lf;
#pragma unroll
          for (int d = 1; d < 64; d <<= 1) { const float y = __int_as_float(__builtin_amdgcn_ds_bpermute(((lane - d) & 63) << 2, __float_as_int(x))); if (lane >= d) x += y; }
          if (lane == 63) red[wave] = x;
          __syncthreads();
          float off = 0.f;
          for (int w = 0; w < wave; ++w) off += red[w];
          const float aloc = ig - (x + off);
          const float mx = wave_max(aloc);
          if (lane == 0) red[4 + wave] = mx;
          __syncthreads();
          const float am = fmaxf(fmaxf(red[4], red[5]), fmaxf(red[6], red[7]));
          wS[so] = __expf(aloc - am);
          if (tid == 0) ((float*)(ws + OFF_ALOC))[i2] = am;
        }
        f32x16 acc[4];
#pragma unroll
        for (int vb = 0; vb < 4; ++vb)
#pragma unroll
          for (int i = 0; i < 16; ++i) acc[vb][i] = 0.f;
        float nacc = 0.f;
        const u16* Kg = (const u16*)(ws + OFF_A) + (size_t)NP * 512 + ((size_t)b * SB + p0) * 512 + head * 128;
        const u16* Vg = (const u16*)(ws + OFF_MVT) + (size_t)(head * 128) * NP + (size_t)b * SB + p0;
#pragma unroll 1
        for (int sub = 0; sub < 4; ++sub) {
          __syncthreads();
          {
            const int kr = tid >> 4, kc = (tid & 15) * 8;
#pragma unroll
            for (int i = 0; i < 4; ++i) *(u32x4*)(Ks + (kr + 16 * i) * 136 + kc) = *(const u32x4*)(Kg + (size_t)(sub * 64 + kr + 16 * i) * 512 + kc);
          }
          __syncthreads();
#pragma unroll
          for (int s16 = 0; s16 < 4; ++s16) {
            float kv[8];
#pragma unroll
            for (int jj = 0; jj < 8; ++jj) {
              const int sl = 16 * s16 + 8 * h + jj;
              kv[jj] = bf2f(Ks[sl * 136 + 32 * wave + r32]) * wS[sub * 64 + sl];
              nacc += kv[jj];
            }
            u32x4 aw; aw.x = cvtpk(kv[0], kv[1]); aw.y = cvtpk(kv[2], kv[3]); aw.z = cvtpk(kv[4], kv[5]); aw.w = cvtpk(kv[6], kv[7]);
            const bf16x8 af = __builtin_bit_cast(bf16x8, aw);
#pragma unroll
            for (int vb = 0; vb < 4; ++vb) {
              const bf16x8 vf = *(const bf16x8*)(Vg + (size_t)(32 * vb + r32) * NP + sub * 64 + 16 * s16 + 8 * h);
              acc[vb] = MFMA32(af, vf, acc[vb]);
            }
          }
        }
        u16* Gd = (u16*)(ws + OFF_GST) + (size_t)i2 * 16384;
#pragma unroll
        for (int vb = 0; vb < 4; ++vb)
#pragma unroll
          for (int g = 0; g < 4; ++g)
            *(uint2*)(Gd + (size_t)(32 * vb + r32) * 128 + 32 * wave + 8 * g + 4 * h) = make_uint2(cvtpk(acc[vb][4 * g], acc[vb][4 * g + 1]), cvtpk(acc[vb][4 * g + 2], acc[vb][4 * g + 3]));
        nacc += SHX(nacc, 32);
        if (h == 0) ((float*)(ws + OFF_NST))[(size_t)i2 * 128 + 32 * wave + r32] = nacc;
      } else if (it < 32) {
        const int chain = it, dir = chain >> 4;
        const float* gi = (const float*)(ws + OFF_GI) + (size_t)chain * SB;
        const float* gf = (const float*)(ws + OFF_GF) + (size_t)chain * SB;
        auto spos = [&](int c) { return dir == 0 ? (c < SC ? SL + c : c - SC) : (SB - 1 - c); };
        float tot = 0.f;
        for (int j = 0; j < 33; ++j) tot += gf[spos(tid * 33 + j)];
        __syncthreads();
        fsm[tid] = tot;
        __syncthreads();
        float pre = 0.f;
        for (int i = 0; i < tid; ++i) pre += fsm[i];
        float F = pre, lm = -INFINITY;
        for (int j = 0; j < 33; ++j) { const int sp = spos(tid * 33 + j); F += gf[sp]; lm = fmaxf(lm, gi[sp] - F); }
        __syncthreads();
        fsm[256 + tid] = lm;
        __syncthreads();
        float pm = 0.f;
        for (int i = 0; i < tid; ++i) pm = fmaxf(pm, fsm[256 + i]);
        F = pre;
        for (int j = 0; j < 33; ++j) {
          const int sp = spos(tid * 33 + j);
          F += gf[sp];
          const float a = gi[sp] - F;
          pm = fmaxf(pm, a);
          ((float*)(ws + OFF_AA))[(size_t)chain * SB + sp] = a;
          ((float*)(ws + OFF_MXA))[(size_t)chain * SB + sp] = pm;
          ((float*)(ws + OFF_MTA))[(size_t)chain * SB + sp] = F + pm;
        }
        __threadfence_block();
        __syncthreads();
        if (tid < 132) {
          const float* aa = (const float*)(ws + OFF_AA) + (size_t)chain * SB + tid * 64;
          float mxv = aa[0];
          for (int j = 1; j < 64; ++j) mxv = fmaxf(mxv, aa[j]);
          ((float*)(ws + OFF_TMAX))[chain * 132 + tid] = mxv;
        }
      } else {
        const int item = (it - 32) * 4 + wave;
        const int g = item & 31, dir = (item >> 5) & 1;
        float2 lam = ((const float2*)(ws + OFF_LAMB))[((L * 2 + dir) * 32 + g) * 64 + lane];
#pragma unroll
        for (int q = 0; q < 6; ++q) lam = make_float2(lam.x * lam.x - lam.y * lam.y, 2.f * lam.x * lam.y);
        float cr = 0.f, ci = 0.f;
        const float2* he = (const float2*)(ws + OFF_HEND) + (size_t)item * 132 * 64 + lane;
        float2* ca = (float2*)(ws + OFF_CARRY) + (size_t)item * 132 * 64 + lane;
#pragma unroll 1
        for (int kk0 = 0; kk0 < 132; kk0 += 12) {
          float2 e[12];
#pragma unroll
          for (int j = 0; j < 12; ++j) e[j] = he[(kk0 + j) * 64];
#pragma unroll
          for (int j = 0; j < 12; ++j) {
            ca[(kk0 + j) * 64] = make_float2(cr, ci);
            const float nr = lam.x * cr - lam.y * ci + e[j].x, ni = lam.x * ci + lam.y * cr + e[j].y;
            cr = nr; ci = ni;
          }
        }
      }
    }
    return;
  }
  if (k == 13) {
    const int n_all = 32 * 9;
    for (int it = bid; it < n_all; it += G) {
      const int chain = it / 9, e = it % 9, dir = chain >> 4;
      const float* gi = (const float*)(ws + OFF_GI) + (size_t)chain * SB;
      const float* aa = (const float*)(ws + OFF_AA) + (size_t)chain * SB;
      float st[8];
#pragma unroll
      for (int i = 0; i < 8; ++i) st[i] = 0.f;
      float B = -INFINITY;
      const bool isn = e == 8;
      if (isn && tid >= 16) continue;
      const size_t eo = isn ? (size_t)tid * 8 : (size_t)e * 2048 + tid * 8;
#pragma unroll 1
      for (int kk0 = 0; kk0 < 33; kk0 += 11) {
        uint4 gm[11]; float4 gn0[11], gn1[11]; float Av[11];
#pragma unroll
        for (int j = 0; j < 11; ++j) {
          const int kk = kk0 + j, ci = chain * 33 + kk;
          if (isn) { const float* g = (const float*)(ws + OFF_NST) + (size_t)ci * 128 + eo; gn0[j] = *(const float4*)g; gn1[j] = *(const float4*)(g + 4); }
          else gm[j] = *(const uint4*)((const u16*)(ws + OFF_GST) + (size_t)ci * 16384 + eo);
          float fst = 0.f;
          if (kk > 0) { const int c = 256 * kk - 1; const int sp = dir == 0 ? (c < SC ? SL + c : c - SC) : (SB - 1 - c); fst = gi[sp] - aa[sp]; }
          Av[j] = ((const float*)(ws + OFF_ALOC))[ci] - fst;
        }
#pragma unroll
        for (int j = 0; j < 11; ++j) {
          const int ci = chain * 33 + kk0 + j;
          if (isn) {
            *(uint4*)((u16*)(ws + OFF_NPST) + (size_t)ci * 128 + eo) = make_uint4(cvtpk(st[0], st[1]), cvtpk(st[2], st[3]), cvtpk(st[4], st[5]), cvtpk(st[6], st[7]));
            if (tid == 0) ((float*)(ws + OFF_BKA))[ci] = B;
          } else {
            *(uint4*)((u16*)(ws + OFF_PST) + (size_t)ci * 16384 + eo) = make_uint4(cvtpk(st[0], st[1]), cvtpk(st[2], st[3]), cvtpk(st[4], st[5]), cvtpk(st[6], st[7]));
          }
          const float A = Av[j];
          const float Bn = fmaxf(B, A);
          const float f1 = __expf(B - Bn), f2 = __expf(A - Bn);
          B = Bn;
          if (isn) {
            const float4 g0 = gn0[j], g1 = gn1[j];
            st[0] = f1 * st[0] + f2 * g0.x; st[1] = f1 * st[1] + f2 * g0.y; st[2] = f1 * st[2] + f2 * g0.z; st[3] = f1 * st[3] + f2 * g0.w;
            st[4] = f1 * st[4] + f2 * g1.x; st[5] = f1 * st[5] + f2 * g1.y; st[6] = f1 * st[6] + f2 * g1.z; st[7] = f1 * st[7] + f2 * g1.w;
          } else {
            const uint4 g = gm[j];
            st[0] = f1 * st[0] + f2 * bflo(g.x); st[1] = f1 * st[1] + f2 * bfhi(g.x); st[2] = f1 * st[2] + f2 * bflo(g.y); st[3] = f1 * st[3] + f2 * bfhi(g.y);
            st[4] = f1 * st[4] + f2 * bflo(g.z); st[5] = f1 * st[5] + f2 * bfhi(g.z); st[6] = f1 * st[6] + f2 * bflo(g.w); st[7] = f1 * st[7] + f2 * bfhi(g.w);
          }
        }
      }
    }
    return;
  }
  if (k == 4) {
    const int n_diff = NB * 4 * 66, n_ml = NB * 4 * 66, n_gqa = NB * 4 * 66, n_s5 = NB * 32 * 132 / 4;
    const int n_all = n_diff + n_ml + n_gqa + n_s5;
    const int r32 = lane & 31, h = lane >> 5;
    int* ctr = (int*)(ws + OFF_CTR) + L;
    int it = FETCH_ITEM();
    for (; it < n_diff; it = FETCH_ITEM()) {
      {
        const int qt = it % 66, head = (it / 66) & 3, b = it / (66 * 4);
        const int s = qt * 128 + wave * 32 + r32, pos = b * SB + s;
        const int kbeg = qt < 64 ? 0 : SL, nkeys = qt < 64 ? SB : SC;
        u16* qd = (u16*)(ws + OFF_QD) + (size_t)pos * 512 + head * 128;
        const float lam = ((const float*)(ws + OFF_LAMV))[L];
        const float lam_init = 0.8f - 0.6f * expf(-0.3f * (float)L);
        f32x16 R[4], O[4]; float lsum;
        attn_pass<128>(qd, (const u16*)(ws + OFF_KD) + ((size_t)b * SB + kbeg) * 512 + head * 128, 512,
                       (const u16*)(ws + OFF_VDT) + (size_t)(head * 128) * NP + (size_t)b * SB + kbeg, nkeys, R, lsum, usm);
        float* stash = (float*)(ws + OFF_STASH) + ((size_t)bid * 256 + otid()) * 64;
        {
          const float il = 1.f / lsum;
#pragma unroll
          for (int vb = 0; vb < 4; ++vb)
#pragma unroll
            for (int i = 0; i < 16; ++i) stash[vb * 16 + i] = R[vb][i] * il;
        }
        attn_pass<128>(qd + 64, (const u16*)(ws + OFF_KD) + ((size_t)b * SB + kbeg) * 512 + head * 128 + 64, 512,
                       (const u16*)(ws + OFF_VDT) + (size_t)(head * 128) * NP + (size_t)b * SB + kbeg, nkeys, O, lsum, usm);
        float ss = 0.f;
        {
          const float il = lam / lsum;
#pragma unroll
          for (int vb = 0; vb < 4; ++vb)
#pragma unroll
            for (int i = 0; i < 16; ++i) { R[vb][i] = stash[vb * 16 + i] - O[vb][i] * il; ss += R[vb][i] * R[vb][i]; }
        }
        ss += SHX(ss, 32);
        const float rn = rsqrtf(ss * (1.f / 128.f) + LN_EPS) * (1.f - lam_init);
        const float* ng = IN(9) + L * 128;
#pragma unroll
        for (int vb = 0; vb < 4; ++vb)
#pragma unroll
          for (int g = 0; g < 4; ++g) {
            const int v0 = vb * 32 + 8 * g + 4 * h;
            const float4 gg = *(const float4*)(ng + v0);
            *(uint2*)(qd + v0) = make_uint2(cvtpk(R[vb][4 * g] * rn * gg.x, R[vb][4 * g + 1] * rn * gg.y), cvtpk(R[vb][4 * g + 2] * rn * gg.z, R[vb][4 * g + 3] * rn * gg.w));
          }
      }
    }
    for (; it < n_diff + n_ml; it = FETCH_ITEM()) {
      {
        const int i2 = it - n_diff;
        const int qt = i2 % 66, head = (i2 / 66) & 3, b = i2 / (66 * 4);
        const int tidm = otid(), lane = tidm & 63, wave = tidm >> 6, r32 = lane & 31, h = lane >> 5;
        const int s = qt * 128 + wave * 32 + r32, pos = b * SB + s;
        bf16x8 qf[8];
        {
          const u16* qrow = (const u16*)(ws + OFF_A) + (size_t)pos * 512 + head * 128;
#pragma unroll
          for (int q = 0; q < 8; ++q) qf[q] = *(const bf16x8*)(qrow + q * 16 + h * 8);
        }
        const u16* Kb = (const u16*)(ws + OFF_A) + (size_t)NP * 512 + (size_t)b * SB * 512 + head * 128;
        const u16* Vt = (const u16*)(ws + OFF_MVT) + (size_t)(head * 128) * NP + (size_t)b * SB;
        f32x16 num[4];
        float* stash = (float*)(ws + OFF_STASH) + ((size_t)bid * 256 + otid()) * 64;
#pragma unroll 1
        for (int dir = 0; dir < 2; ++dir) {
          const int chain = dir * 16 + b * 4 + head;
          const float* Aarr = (const float*)(ws + OFF_AA) + (size_t)chain * SB;
          const float mxq = ((const float*)(ws + OFF_MXA))[(size_t)chain * SB + s] * LOG2E;
          const float mt = ((const float*)(ws + OFF_MTA))[(size_t)chain * SB + s];
          const int cq = chain_idx(dir, s);
          int t0a, t0b, t1a, t1b, kch = 0;
          if (qt < 64) { const int kq = qt >> 1; t0a = 0; t0b = 0; if (dir == 0) { t1a = 4 * kq; t1b = 2 * qt + 2; kch = 1 + kq; } else { t1a = 2 * qt; t1b = 4 * kq + 4; kch = 32 - kq; } }
          else { const int cqt = qt - 64; t1a = 0; t1b = 0; if (dir == 0) { t0a = 0; t0b = 2 * cqt + 2; } else { t0a = 2 * cqt; t0b = 4; } }
          float den = 0.f;
          if (kch > 0) {
            const int ci = chain * 33 + kch;
            const float et = fexp2(fminf(((const float*)(ws + OFF_BKA))[ci] * LOG2E - mxq, 0.f));
            const u16* Pp = (const u16*)(ws + OFF_PST) + (size_t)ci * 16384;
#pragma unroll
            for (int vb = 0; vb < 4; ++vb) {
#pragma unroll
              for (int i = 0; i < 16; ++i) num[vb][i] = 0.f;
#pragma unroll
              for (int q = 0; q < 8; ++q) {
                const bf16x8 pf = *(const bf16x8*)(Pp + (size_t)(32 * vb + r32) * 128 + 16 * q + 8 * h);
                num[vb] = MFMA32(pf, qf[q], num[vb]);
              }
#pragma unroll
              for (int i = 0; i < 16; ++i) num[vb][i] *= et;
              __builtin_amdgcn_sched_barrier(0);
            }
            const u16* np = (const u16*)(ws + OFF_NPST) + (size_t)ci * 128;
            float dp = 0.f;
#pragma unroll
            for (int q = 0; q < 8; ++q) {
              const bf16x8_t qv = __builtin_bit_cast(bf16x8_t, qf[q]);
              const bf16x8_t nv = *(const bf16x8_t*)(np + 16 * q + 8 * h);
              dp = __builtin_amdgcn_fdot2_f32_bf16(__builtin_shufflevector(qv, qv, 0, 1), __builtin_shufflevector(nv, nv, 0, 1), dp, false);
              dp = __builtin_amdgcn_fdot2_f32_bf16(__builtin_shufflevector(qv, qv, 2, 3), __builtin_shufflevector(nv, nv, 2, 3), dp, false);
              dp = __builtin_amdgcn_fdot2_f32_bf16(__builtin_shufflevector(qv, qv, 4, 5), __builtin_shufflevector(nv, nv, 4, 5), dp, false);
              dp = __builtin_amdgcn_fdot2_f32_bf16(__builtin_shufflevector(qv, qv, 6, 7), __builtin_shufflevector(nv, nv, 6, 7), dp, false);
            }
            dp += SHX(dp, 32);
            den = et * dp;
          } else {
#pragma unroll
            for (int vb = 0; vb < 4; ++vb)
#pragma unroll
              for (int i = 0; i < 16; ++i) num[vb][i] = 0.f;
          }
          mlstm_dir(qf, Kb, Vt, Aarr, (const float*)(ws + OFF_TMAX) + chain * 132, dir, t0a, t0b, t1a, t1b, cq, mxq, num, den, smem);
          const float dd = 1.f / fmaxf(fabsf(den), expf(-mt));
          if (dir == 0) {
#pragma unroll
            for (int vb = 0; vb < 4; ++vb)
#pragma unroll
              for (int i = 0; i < 16; ++i) stash[vb * 16 + i] = num[vb][i] * dd;
          } else {
            float ss = 0.f;
#pragma unroll
            for (int vb = 0; vb < 4; ++vb)
#pragma unroll
              for (int i = 0; i < 16; ++i) { num[vb][i] = stash[vb * 16 + i] + num[vb][i] * dd; ss += num[vb][i] * num[vb][i]; }
            ss += SHX(ss, 32);
            const float rn = rsqrtf(ss * (1.f / 128.f) + LN_EPS);
            const float* ng = IN(25) + L * 512 + head * 128;
            u16* mo = (u16*)(ws + OFF_MO) + (size_t)pos * 512 + head * 128;
#pragma unroll
            for (int vb = 0; vb < 4; ++vb)
#pragma unroll
              for (int g = 0; g < 4; ++g) {
                const int v0 = vb * 32 + 8 * g + 4 * h;
                const float4 gg = *(const float4*)(ng + v0);
                const uint2 ov = *(const uint2*)(mo + v0);
                const float y0 = num[vb][4 * g] * rn * gg.x * sigmoidf_(bflo(ov.x)), y1 = num[vb][4 * g + 1] * rn * gg.y * sigmoidf_(bfhi(ov.x));
                const float y2 = num[vb][4 * g + 2] * rn * gg.z * sigmoidf_(bflo(ov.y)), y3 = num[vb][4 * g + 3] * rn * gg.w * sigmoidf_(bfhi(ov.y));
                *(uint2*)(mo + v0) = make_uint2(cvtpk(y0, y1), cvtpk(y2, y3));
              }
          }
        }
      }
    }
    for (; it < n_diff + n_ml + n_gqa; it = FETCH_ITEM()) {
      {
        const int i2 = it - n_diff - n_ml;
        const int qt = i2 % 66, hp = (i2 / 66) & 3, b = i2 / (66 * 4);
        const int kv = hp >> 1;
        const int s = qt * 128 + wave * 32 + r32, pos = b * SB + s;
        const int kbeg = qt < 64 ? 0 : SL, nkeys = qt < 64 ? SB : SC;
        u16* qg = (u16*)(ws + OFF_QG) + (size_t)pos * 512 + hp * 128;
        f32x16 O[2][2]; float lsum[2];
        attn_pass_gqa2(qg, qg + 64, (const u16*)(ws + OFF_KG) + ((size_t)b * SB + kbeg) * 128 + kv * 64, 128,
                       (const u16*)(ws + OFF_VGT) + (size_t)(kv * 64) * NP + (size_t)b * SB + kbeg, nkeys, O, lsum, usm);
#pragma unroll
        for (int hd = 0; hd < 2; ++hd) {
          const float il = 1.f / lsum[hd];
#pragma unroll
          for (int vb = 0; vb < 2; ++vb)
#pragma unroll
            for (int g = 0; g < 4; ++g) {
              const int v0 = vb * 32 + 8 * g + 4 * h;
              *(uint2*)(qg + hd * 64 + v0) = make_uint2(cvtpk(O[hd][vb][4 * g] * il, O[hd][vb][4 * g + 1] * il), cvtpk(O[hd][vb][4 * g + 2] * il, O[hd][vb][4 * g + 3] * il));
            }
        }
      }
    }
    for (; it < n_all; it = FETCH_ITEM()) {
      {
        const int item = (it - n_diff - n_ml - n_gqa) * 4 + wave;
        const int T = item % 132, g = (item / 132) & 31, b = item / (132 * 32);
        u16* W = usm + wave * 4352;
        const int recol = lane < 32 ? lane : lane + 32;
        const size_t pos0 = (size_t)b * SB + 64 * T;
        __syncthreads();
        f32x16 ycc[2];
#pragma unroll
        for (int hh = 0; hh < 2; ++hh)
#pragma unroll
          for (int i = 0; i < 16; ++i) ycc[hh][i] = 0.f;
#pragma unroll 1
        for (int dir = 0; dir < 2; ++dir) {
          const int kk = dir == 0 ? (T < 128 ? T + 4 : T - 128) : (T < 128 ? 4 + 127 - T : 3 - (T - 128));
          const int ldg = (L * 2 + dir) * 32 + g;
          const float2 lam = ((const float2*)(ws + OFF_LAMB))[ldg * 64 + lane];
          bf16x8 bfr[4];
#pragma unroll
          for (int j = 0; j < 4; ++j) bfr[j] = *(const bf16x8*)((const u16*)(ws + OFF_BBT) + ((size_t)ldg * 128 + 32 * j + r32) * 16 + 8 * h);
          const float2 cy = ((const float2*)(ws + OFF_CARRY))[((size_t)((b * 2 + dir) * 32 + g) * 132 + kk) * 64 + lane];
          float hr = cy.x, hi = cy.y;
          const u16* cm = (const u16*)(ws + OFF_CMT) + ((size_t)ldg * 16 + (r32 & 15)) * 128 + 8 * h;
#pragma unroll 1
          for (int hq = 0; hq < 2; ++hq) {
            const int hh = dir ? 1 - hq : hq;
            s5_bu_half((const u16*)(ws + OFF_S5U) + (pos0 + 32 * hh + r32) * 512 + g * 16 + 8 * h, bfr, W, r32, h);
            s5_scan_half<true>(W, dir, recol, lam, hr, hi);
            f32x16 yy;
#pragma unroll
            for (int i = 0; i < 16; ++i) yy[i] = 0.f;
#pragma unroll
            for (int sk = 0; sk < 8; ++sk) {
              const bf16x8 af = *(const bf16x8*)(W + r32 * 136 + 16 * sk + 8 * h);
              const bf16x8 cf = *(const bf16x8*)(cm + 16 * sk);
              yy = MFMA32(af, cf, yy);
            }
            if (hh == 0) { ycc[0] += yy; } else { ycc[1] += yy; }
          }
        }
        if (r32 < 16) {
          const float dsk = IN(19)[L * 512 + g * 16 + r32];
#pragma unroll
          for (int hh = 0; hh < 2; ++hh)
#pragma unroll
            for (int i = 0; i < 16; ++i) {
              const int t = 32 * hh + (i & 3) + 8 * (i >> 2) + 4 * h;
              u16* up = (u16*)(ws + OFF_S5U) + (pos0 + t) * 512 + g * 16 + r32;
              *up = f2bf(gelu_erf(ycc[hh][i] + bf2f(*up) * dsk));
            }
        }
      }
    }
    return;
  }
  if (k == 5) {
    const int n_g = 264 * 8;
    const int n_all = n_g + NP / 4;
    for (int it = bid; it < n_all; it += G) {
      if (it < n_g) {
        const int mt = it / 8, nt = it % 8;
        f32x16 acc[2][2]; acc_zero(acc);
        gemm_core((const u16*)(ws + OFF_S5U) + (size_t)mt * 128 * 512, 512, (const u16*)(ws + OFF_WGLU) + (size_t)nt * 128 * 512, 512, 512, acc, usm);
        {
          u16* YS = (u16*)(ws + OFF_MVT);
          const int e_r = lane & 31, e_h = lane >> 5, e_wm = wave >> 1, e_wn = wave & 1;
          const int ca = nt * 64 + e_wn * 32 + e_r;
          const float ba = IN(21)[L * 1024 + ca], bgt = IN(21)[L * 1024 + 512 + ca];
#pragma unroll
          for (int mi = 0; mi < 2; ++mi)
#pragma unroll
            for (int i = 0; i < 16; ++i) {
              const int row = e_wm * 64 + mi * 32 + (i & 3) + 8 * (i >> 2) + 4 * e_h;
              YS[(size_t)(mt * 128 + row) * 512 + ca] = f2bf((acc[mi][0][i] + ba) * sigmoidf_(acc[mi][1][i] + bgt));
            }
        }
      } else {
        const int pos = (it - n_g) * 4 + wave;
        const float* md = mod_ptr(p, L, pos);
        ln_mod_wave(h_in_ptr(p, L, pos), md, md + 1024, XM + (size_t)pos * DM, lane);
      }
    }
    return;
  }
  if (k == 6) {
    const int n_all = NP * 512 / 2048;
    for (int it = bid; it < n_all; it += G) {
      const size_t e = (size_t)it * 2048 + tid * 8;
      const size_t pos = e >> 9; const int c = (int)(e & 511);
      const u16* z = (const u16*)(ws + OFF_Z) + pos * 1024 + c;
      const uint4 a = *(const uint4*)z, g = *(const uint4*)(z + 512);
      uint4 o;
      o.x = cvtpk(bflo(a.x) * sigmoidf_(bflo(g.x)), bfhi(a.x) * sigmoidf_(bfhi(g.x)));
      o.y = cvtpk(bflo(a.y) * sigmoidf_(bflo(g.y)), bfhi(a.y) * sigmoidf_(bfhi(g.y)));
      o.z = cvtpk(bflo(a.z) * sigmoidf_(bflo(g.z)), bfhi(a.z) * sigmoidf_(bfhi(g.z)));
      o.w = cvtpk(bflo(a.w) * sigmoidf_(bflo(g.w)), bfhi(a.w) * sigmoidf_(bfhi(g.w)));
      *(uint4*)((u16*)(ws + OFF_S5U) + pos * 512 + c) = o;
    }
    return;
  }
  if (k == 7) {
    const int n_g = 264 * 8, n_all = n_g + 1024;
    int* ctr = (int*)(ws + OFF_CTR) + 2 + L * 2;
    for (int it = FETCH_ITEM(); it < n_all; it = FETCH_ITEM()) {
      if (it >= n_g) {
        for (int c = 0; c < 8; ++c) convert_chunk_fp8(IN(34) + (size_t)L * 16384 * 1024, (unsigned char*)(ws + OFF_PU), (size_t)(it - n_g) * 8 + c, 64.f);
        continue;
      }
      const int mt = it / 8, nt = it % 8;
      f32x16 mg[2][2]; acc_zero(mg);
#pragma unroll 1
      for (int kb = 0; kb < 4; ++kb) {
        f32x16 a1[2][2]; acc_zero(a1);
        gemm_core(XM + (size_t)mt * 128 * DM, DM, WinT + (size_t)(4880 + kb * 1024 + nt * 128) * DM, DM, DM, a1, usm);
        const float* bg = IN(7) + L * 4096 + kb * 1024 + nt * 128;
        unsigned gp[2][2][8];
        {
          const int r32 = lane & 31, wn = wave & 1;
#pragma unroll
          for (int ni = 0; ni < 2; ++ni) {
            const float bv = bg[wn * 64 + ni * 32 + r32];
#pragma unroll
            for (int mi = 0; mi < 2; ++mi)
#pragma unroll
              for (int i = 0; i < 8; ++i) gp[mi][ni][i] = cvtpk(sigmoidf_(a1[mi][ni][2 * i] + bv), sigmoidf_(a1[mi][ni][2 * i + 1] + bv));
          }
        }
        f32x16 a2[2][2]; acc_zero(a2);
        const size_t yo = kb == 0 ? OFF_QD : (kb == 1 ? OFF_MVT : (kb == 2 ? OFF_MO : OFF_QG));
        gemm_core((const u16*)(ws + yo) + (size_t)mt * 128 * 512, 512, (const u16*)(ws + OFF_WBR) + ((size_t)kb * DM + nt * 128) * 512, 512, 512, a2, usm);
#pragma unroll
        for (int mi = 0; mi < 2; ++mi)
#pragma unroll
          for (int ni = 0; ni < 2; ++ni)
#pragma unroll
            for (int i = 0; i < 8; ++i) { mg[mi][ni][2 * i] += bflo(gp[mi][ni][i]) * a2[mi][ni][2 * i]; mg[mi][ni][2 * i + 1] += bfhi(gp[mi][ni][i]) * a2[mi][ni][2 * i + 1]; }
      }
      u16* MG = (u16*)(ws + OFF_Z);
      EPI_LOOP(mg, { MG[(size_t)(mt * 128 + row) * 1024 + nt * 128 + col] = f2bf(val); })
    }
    return;
  }
  if (k == 8) {
    const int n_g = 264 * 8, n_cv = 1024;
    const int n_all = n_g + n_cv;
    int* ctr = (int*)(ws + OFF_CTR) + 3 + L * 2;
    for (int it = FETCH_ITEM(); it < n_all; it = FETCH_ITEM()) {
      if (it < n_g) {
        const int mt = it / 8, nt = it % 8;
        f32x16 acc[2][2]; acc_zero(acc);
        gemm_core((const u16*)(ws + OFF_Z) + (size_t)mt * 128 * DM, DM, (const u16*)(ws + OFF_WO) + (size_t)nt * 128 * DM, DM, DM, acc, usm);
        const float* g1 = mod_ptr(p, L, mt * 128) + 2048 + nt * 128;
        const float* hin0 = h_in_ptr(p, L, mt * 128) + nt * 128;
        float* hout0 = h_out_ptr(p, mt * 128) + nt * 128;
        EPI_LOOP(acc, { hout0[(size_t)row * DM + col] = ALPHA * hin0[(size_t)row * DM + col] + g1[col] * val; })
      } else {
        for (int c = 0; c < 8; ++c) convert_chunk_fp8(IN(35) + (size_t)L * 16384 * 1024, (unsigned char*)(ws + OFF_PV), (size_t)(it - n_g) * 8 + c, 8.f);
      }
    }
    return;
  }
  if (k == 9) {
    for (int it = bid; it < NP / 4; it += G) {
      const int pos = it * 4 + wave;
      float* hrow = h_out_ptr(p, pos);
      float4 x[4];
#pragma unroll
      for (int i = 0; i < 4; ++i) x[i] = *(const float4*)(hrow + lane * 4 + 256 * i);
      float sm = 0.f;
#pragma unroll
      for (int i = 0; i < 4; ++i) sm += x[i].x + x[i].y + x[i].z + x[i].w;
      const float mean = wave_sum(sm) * (1.f / DM);
      float vs = 0.f;
#pragma unroll
      for (int i = 0; i < 4; ++i) { x[i].x -= mean; x[i].y -= mean; x[i].z -= mean; x[i].w -= mean; vs += x[i].x * x[i].x + x[i].y * x[i].y + x[i].z * x[i].z + x[i].w * x[i].w; }
      const float rs = rsqrtf(wave_sum(vs) * (1.f / DM) + LN_EPS);
      float sm2 = 0.f;
#pragma unroll
      for (int i = 0; i < 4; ++i) {
        const float4 g = *(const float4*)(IN(28) + L * DM + lane * 4 + 256 * i), be = *(const float4*)(IN(29) + L * DM + lane * 4 + 256 * i);
        x[i] = make_float4(x[i].x * rs * g.x + be.x, x[i].y * rs * g.y + be.y, x[i].z * rs * g.z + be.z, x[i].w * rs * g.w + be.w);
        *(float4*)(hrow + lane * 4 + 256 * i) = x[i];
        sm2 += x[i].x + x[i].y + x[i].z + x[i].w;
      }
      const float mean2 = wave_sum(sm2) * (1.f / DM);
      float vs2 = 0.f;
#pragma unroll
      for (int i = 0; i < 4; ++i) { x[i].x -= mean2; x[i].y -= mean2; x[i].z -= mean2; x[i].w -= mean2; vs2 += x[i].x * x[i].x + x[i].y * x[i].y + x[i].z * x[i].z + x[i].w * x[i].w; }
      const float rs2 = rsqrtf(wave_sum(vs2) * (1.f / DM) + LN_EPS);
      const float* md = mod_ptr(p, L, pos);
#pragma unroll
      for (int i = 0; i < 4; ++i) {
        const float4 sh = *(const float4*)(md + 3072 + lane * 4 + 256 * i), sc = *(const float4*)(md + 4096 + lane * 4 + 256 * i);
        *(uint2*)(XM + (size_t)pos * DM + lane * 4 + 256 * i) = make_uint2(cvtpk(x[i].x * rs2 * (1.f + sc.x) + sh.x, x[i].y * rs2 * (1.f + sc.y) + sh.y), cvtpk(x[i].z * rs2 * (1.f + sc.z) + sh.z, x[i].w * rs2 * (1.f + sc.w) + sh.w));
      }
    }
    return;
  }
  if (k == 10) {
    const int n_all = 264 * 16;
    for (int it = bid; it < n_all; it += G) {
      const int mt = it / 16, nt = it % 16;
      f32x16 acc[2][2]; acc_zero(acc);
      gemm_core(XM + (size_t)mt * 128 * DM, DM, (const u16*)(ws + OFF_WQ) + (size_t)nt * 128 * DM, DM, DM, acc, usm);
      u16* Q2 = (u16*)(ws + OFF_Q2);
      EPI_LOOP(acc, { Q2[(size_t)(mt * 128 + row) * 2048 + nt * 128 + col] = f2bf(val); })
    }
    return;
  }
  if (k == 11) {
    const int n_all = NP / 8;
    float* sc = fsm;
    float* T1v = fsm + 64 * 132;
    float* T2v = T1v + 1024;
    int* T1i = (int*)(T2v + 1024);
    int* T2i = T1i + 1024;
    float* Sv = (float*)(T2i + 1024) + wave * 64;
    int* Si = (int*)((float*)(T2i + 1024) + 256) + wave * 64;
    const int r32 = lane & 31, h = lane >> 5;
    for (int it = bid; it < n_all; it += G) {
      const size_t row0 = (size_t)it * 64;
#pragma unroll 1
      for (int half = 0; half < 2; ++half) {
        f32x16 a[2];
#pragma unroll
        for (int ni = 0; ni < 2; ++ni)
#pragma unroll
          for (int i = 0; i < 16; ++i) a[ni][i] = 0.f;
        const u16* qa = (const u16*)(ws + OFF_Q2) + (row0 + (wave >> 1) * 32 + r32) * 256 + half * 128;
        const u16* kbp = (const u16*)(ws + OFF_SK) + (size_t)half * 16384 + (size_t)((wave & 1) * 64 + r32) * 128;
#pragma unroll
        for (int s = 0; s < 8; ++s) {
          const bf16x8 af = *(const bf16x8*)(qa + s * 16 + h * 8);
#pragma unroll
          for (int ni = 0; ni < 2; ++ni) {
            const bf16x8 bf = *(const bf16x8*)(kbp + (size_t)ni * 32 * 128 + s * 16 + h * 8);
            a[ni] = MFMA32(af, bf, a[ni]);
          }
        }
        __syncthreads();
#pragma unroll
        for (int ni = 0; ni < 2; ++ni)
#pragma unroll
          for (int i = 0; i < 16; ++i) sc[((wave >> 1) * 32 + (i & 3) + 8 * (i >> 2) + 4 * h) * 132 + (wave & 1) * 64 + ni * 32 + r32] = a[ni][i];
        __syncthreads();
        float* Tv = half ? T2v : T1v; int* Ti = half ? T2i : T1i;
#pragma unroll 1
        for (int g = 0; g < 4; ++g) {
          float v0[4], v1[4]; unsigned k0[4], k1[4], T[4];
#pragma unroll
          for (int r = 0; r < 4; ++r) {
            const int row = wave * 16 + g * 4 + r;
            v0[r] = sc[row * 132 + lane]; v1[r] = sc[row * 132 + 64 + lane];
            unsigned u0 = __float_as_uint(v0[r]), u1 = __float_as_uint(v1[r]);
            u0 = (u0 >> 31) ? ~u0 : (u0 | 0x80000000u); u1 = (u1 >> 31) ? ~u1 : (u1 | 0x80000000u);
            k0[r] = (u0 & 0xFFFFFF80u) | (unsigned)(127 - lane); k1[r] = (u1 & 0xFFFFFF80u) | (unsigned)(63 - lane);
            T[r] = 0u;
          }
          bool dn0 = false, dn1 = false, dn2 = false, dn3 = false;
#pragma unroll 1
          for (int bit = 31; bit >= 0; --bit) {
#pragma unroll
            for (int r = 0; r < 4; ++r) {
              bool& dn = r == 0 ? dn0 : (r == 1 ? dn1 : (r == 2 ? dn2 : dn3));
              const unsigned cand = T[r] | (1u << bit);
              const int cnt = __popcll(__ballot(k0[r] >= cand)) + __popcll(__ballot(k1[r] >= cand));
              T[r] = cnt >= 16 ? cand : T[r];
              dn = dn | (cnt == 16);
            }
            if (dn0 && dn1 && dn2 && dn3) break;
          }
#pragma unroll
          for (int r = 0; r < 4; ++r) {
            const int row = wave * 16 + g * 4 + r;
            const bool s0 = k0[r] >= T[r], s1 = k1[r] >= T[r];
            const unsigned long long m0 = __ballot(s0), m1 = __ballot(s1);
            const int p0 = __builtin_amdgcn_mbcnt_hi((unsigned)(m0 >> 32), __builtin_amdgcn_mbcnt_lo((unsigned)m0, 0u));
            const int p1 = __popcll(m0) + __builtin_amdgcn_mbcnt_hi((unsigned)(m1 >> 32), __builtin_amdgcn_mbcnt_lo((unsigned)m1, 0u));
            if (s0) { Tv[row * 16 + p0] = v0[r]; Ti[row * 16 + p0] = lane; }
            if (s1) { Tv[row * 16 + p1] = v1[r]; Ti[row * 16 + p1] = lane + 64; }
          }
        }
      }
#pragma unroll 1
      for (int g = 0; g < 4; ++g) {
        {
          const int rowl = wave * 16 + g * 4 + (lane >> 4), j = lane & 15;
#pragma unroll
          for (int half = 0; half < 2; ++half) {
            float* Tv = half ? T2v : T1v; int* Ti = half ? T2i : T1i;
            const float v = Tv[rowl * 16 + j]; const int vi = Ti[rowl * 16 + j];
            int rank = 0;
#pragma unroll
            for (int i = 0; i < 16; ++i) { const float o = Tv[rowl * 16 + i]; rank += (o > v || (o == v && i < j)) ? 1 : 0; }
            Tv[rowl * 16 + rank] = v; Ti[rowl * 16 + rank] = vi;
          }
        }
        unsigned kk[4], T[4]; float cv[4];
        const int pr = PEER_PAIRS[lane], ia = pr >> 4, ib = pr & 15;
#pragma unroll
        for (int r = 0; r < 4; ++r) {
          const int row = wave * 16 + g * 4 + r;
          cv[r] = T1v[row * 16 + ia] + T2v[row * 16 + ib];
          unsigned u = __float_as_uint(cv[r]); u = (u >> 31) ? ~u : (u | 0x80000000u);
          kk[r] = lane < 50 ? ((u & 0xFFFFFFC0u) | (unsigned)(63 - lane)) : 0u;
          T[r] = 0u;
        }
        bool dn0 = false, dn1 = false, dn2 = false, dn3 = false;
#pragma unroll 1
        for (int bit = 31; bit >= 0; --bit) {
#pragma unroll
          for (int r = 0; r < 4; ++r) {
            bool& dn = r == 0 ? dn0 : (r == 1 ? dn1 : (r == 2 ? dn2 : dn3));
            const unsigned cand = T[r] | (1u << bit);
            const int cnt = __popcll(__ballot(kk[r] >= cand));
            T[r] = cnt >= 16 ? cand : T[r];
            dn = dn | (cnt == 16);
          }
          if (dn0 && dn1 && dn2 && dn3) break;
        }
#pragma unroll
        for (int r = 0; r < 4; ++r) {
          const int row = wave * 16 + g * 4 + r;
          const bool se = kk[r] >= T[r] && T[r] != 0u;
          const unsigned long long me = __ballot(se);
          const int pe = __builtin_amdgcn_mbcnt_hi((unsigned)(me >> 32), __builtin_amdgcn_mbcnt_lo((unsigned)me, 0u));
          if (se) {
            Sv[r * 16 + pe] = cv[r];
            Si[r * 16 + pe] = T1i[row * 16 + ia] * 128 + T2i[row * 16 + ib];
          }
        }
        {
          const float val = Sv[lane]; const int idx = Si[lane];
          float mx = val;
          mx = fmaxf(mx, SHX(mx, 8)); mx = fmaxf(mx, SHX(mx, 4)); mx = fmaxf(mx, SHX(mx, 2)); mx = fmaxf(mx, SHX(mx, 1));
          const float ev = __expf(val - mx);
          float sm = ev;
          sm += SHX(sm, 8); sm += SHX(sm, 4); sm += SHX(sm, 2); sm += SHX(sm, 1);
          const size_t o = (row0 + wave * 16 + g * 4) * 16 + lane;
          ((int*)(ws + OFF_IDX))[o] = idx;
          ((float*)(ws + OFF_GATE))[o] = ev / sm;
        }
      }
      __syncthreads();
    }
    return;
  }
  if (k == 12) {
    const unsigned char* PU = (const unsigned char*)(ws + OFF_PU); const unsigned char* PV = (const unsigned char*)(ws + OFF_PV);
    float* wl = fsm + 8 + wave * 32;
    float* fs = fsm + 8 + 128;
    for (int it = bid; it < NP; it += G) {
      const int pos = it;
      float tf[16];
      {
        const u16* xr = XM + (size_t)pos * DM + lane * 16;
        const u32x4 a = *(const u32x4*)xr, b = *(const u32x4*)(xr + 8);
        tf[0] = bflo(a.x); tf[1] = bfhi(a.x); tf[2] = bflo(a.y); tf[3] = bfhi(a.y); tf[4] = bflo(a.z); tf[5] = bfhi(a.z); tf[6] = bflo(a.w); tf[7] = bfhi(a.w);
        tf[8] = bflo(b.x); tf[9] = bfhi(b.x); tf[10] = bflo(b.y); tf[11] = bfhi(b.y); tf[12] = bflo(b.z); tf[13] = bfhi(b.z); tf[14] = bflo(b.w); tf[15] = bfhi(b.w);
      }
      const size_t r0 = (size_t)pos * 8 + wave * 2;
      const int myidx = lane < 32 ? ((const int*)(ws + OFF_IDX))[r0 * 16 + lane] : 0;
      const float myg = lane < 32 ? ((const float*)(ws + OFF_GATE))[r0 * 16 + lane] : 0.f;
      u32x4 A[8], B[8], C[8];
      const bool b5 = lane & 32, b4 = lane & 16, b3 = lane & 8;
#define LOADROWS(X, TAB, E0)                                                             \
      _Pragma("unroll") for (int j = 0; j < 8; ++j) {                                    \
        const int idx = __builtin_amdgcn_readlane(myidx, (E0) + j);                      \
        X[j] = *(const u32x4*)((TAB) + (size_t)idx * DM + lane * 16);                    \
      }
#define UNPK(X, j, q) const f32x2 q##0 = __builtin_amdgcn_cvt_pk_f32_fp8((int)X[j].x, false), q##1 = __builtin_amdgcn_cvt_pk_f32_fp8((int)X[j].x, true), \
                                  q##2 = __builtin_amdgcn_cvt_pk_f32_fp8((int)X[j].y, false), q##3 = __builtin_amdgcn_cvt_pk_f32_fp8((int)X[j].y, true), \
                                  q##4 = __builtin_amdgcn_cvt_pk_f32_fp8((int)X[j].z, false), q##5 = __builtin_amdgcn_cvt_pk_f32_fp8((int)X[j].z, true), \
                                  q##6 = __builtin_amdgcn_cvt_pk_f32_fp8((int)X[j].w, false), q##7 = __builtin_amdgcn_cvt_pk_f32_fp8((int)X[j].w, true);
#define DOTS(X, E0)                                                                  \
      {                                                                                  \
        float d[8];                                                                      \
        _Pragma("unroll") for (int j = 0; j < 8; ++j) {                                  \
          UNPK(X, j, q)                                                                  \
          d[j] = tf[0] * q0.x + tf[1] * q0.y + tf[2] * q1.x + tf[3] * q1.y + tf[4] * q2.x + tf[5] * q2.y + tf[6] * q3.x + tf[7] * q3.y \
               + tf[8] * q4.x + tf[9] * q4.y + tf[10] * q5.x + tf[11] * q5.y + tf[12] * q6.x + tf[13] * q6.y + tf[14] * q7.x + tf[15] * q7.y; \
          asm volatile("" : "+v"(d[j]));                                                 \
        }                                                                                \
        float d4[4], d2[2], d1;                                                          \
        _Pragma("unroll") for (int i = 0; i < 4; ++i) { const float keep = b5 ? d[i + 4] : d[i], send = b5 ? d[i] : d[i + 4]; d4[i] = keep + SHX(send, 32); } \
        _Pragma("unroll") for (int i = 0; i < 2; ++i) { const float keep = b4 ? d4[i + 2] : d4[i], send = b4 ? d4[i] : d4[i + 2]; d2[i] = keep + SHX(send, 16); } \
        { const float keep = b3 ? d2[1] : d2[0], send = b3 ? d2[0] : d2[1]; d1 = keep + SHX(send, 8); } \
        d1 += SHX(d1, 4); d1 += SHX(d1, 2); d1 += SHX(d1, 1);                            \
        const float gt = __int_as_float(__builtin_amdgcn_ds_bpermute(((E0) + (lane >> 3)) << 2, __float_as_int(myg))); \
        if ((lane & 7) == 0) wl[(E0) + (lane >> 3)] = gt * gelu_erf(d1 * (1.f / 64.f)) * 0.125f; \
        __builtin_amdgcn_sched_barrier(0);                                               \
      }
#define ACCV(X, E0)                                                                      \
      _Pragma("unroll") for (int j = 0; j < 8; ++j) {                                    \
        const float w = wl[(E0) + j];                                                    \
        UNPK(X, j, q)                                                                    \
        ov[0] += w * q0.x; ov[1] += w * q0.y; ov[2] += w * q1.x; ov[3] += w * q1.y; ov[4] += w * q2.x; ov[5] += w * q2.y; ov[6] += w * q3.x; ov[7] += w * q3.y; \
        ov[8] += w * q4.x; ov[9] += w * q4.y; ov[10] += w * q5.x; ov[11] += w * q5.y; ov[12] += w * q6.x; ov[13] += w * q6.y; ov[14] += w * q7.x; ov[15] += w * q7.y; \
        _Pragma("unroll") for (int i = 0; i < 16; ++i) asm volatile("" : "+v"(ov[i]));   \
      }
      __syncthreads();
      LOADROWS(A, PU, 0)
      LOADROWS(B, PU, 8)
      LOADROWS(C, PU, 16)
      DOTS(A, 0)
      LOADROWS(A, PU, 24)
      DOTS(B, 8)
      LOADROWS(B, PV, 0)
      DOTS(C, 16)
      LOADROWS(C, PV, 8)
      DOTS(A, 24)
      LOADROWS(A, PV, 16)
      float ov[16];
#pragma unroll
      for (int i = 0; i < 16; ++i) ov[i] = 0.f;
      ACCV(B, 0)
      __builtin_amdgcn_sched_barrier(0);
      LOADROWS(B, PV, 24)
      ACCV(C, 8)
      __builtin_amdgcn_sched_barrier(0);
      ACCV(A, 16)
      __builtin_amdgcn_sched_barrier(0);
      ACCV(B, 24)
#undef LOADROWS
#undef UNPK
#undef DOTS
#undef ACCV
#pragma unroll
      for (int i = 0; i < 16; ++i) fs[wave * 1024 + lane * 16 + i] = ov[i];
      __syncthreads();
      const int tid2 = otid();
      float f[4];
#pragma unroll
      for (int i = 0; i < 4; ++i) f[i] = fs[tid2 * 4 + i] + fs[1024 + tid2 * 4 + i] + fs[2048 + tid2 * 4 + i] + fs[3072 + tid2 * 4 + i];
      float* hrow = h_out_ptr(p, pos);
      const float4 hm = *(const float4*)(hrow + tid2 * 4);
      const float4 g2 = *(const float4*)(mod_ptr(p, L, pos) + 5120 + tid2 * 4);
      const float x0 = ALPHA * hm.x + g2.x * f[0], x1 = ALPHA * hm.y + g2.y * f[1], x2 = ALPHA * hm.z + g2.z * f[2], x3 = ALPHA * hm.w + g2.w * f[3];
      const float mean = block_sum(x0 + x1 + x2 + x3, fsm) * (1.f / DM);
      const float a = x0 - mean, b = x1 - mean, c = x2 - mean, d = x3 - mean;
      const float var = block_sum(a * a + b * b + c * c + d * d, fsm) * (1.f / DM);
      const float rs = rsqrtf(var + LN_EPS);
      const float4 g = *(const float4*)(IN(30) + L * DM + tid2 * 4), be = *(const float4*)(IN(31) + L * DM + tid2 * 4);
      *(float4*)(hrow + tid2 * 4) = make_float4(a * rs * g.x + be.x, b * rs * g.y + be.y, c * rs * g.z + be.z, d * rs * g.w + be.w);
    }
    return;
  }
}

#if MULTI_LAUNCH
__global__ void __launch_bounds__(256, 2) k_phase(P p, int ph) {
  __shared__ __attribute__((aligned(16))) char smem[57344];
  run_phase(p, ph, smem);
}
#endif

#if !MULTI_LAUNCH
#define XB_TMO      128
#define XB_XCNT(j)  (256  + 64 * (j))
#define XB_XSUB(j)  (1280 + 64 * (j))
#define XB_XGEN(j)  (2304 + 64 * (j))
#define XB_TOP      3328
#define XB_TOPGEN   3392
#define XCD_BAR_WORDS 3456
#define XB_SPIN_CAP (1u << 18)
#define LAS __attribute__((address_space(3)))

__device__ __forceinline__ unsigned xb_ld(unsigned* p)              { return __hip_atomic_load(p, __ATOMIC_RELAXED, __HIP_MEMORY_SCOPE_AGENT); }
__device__ __forceinline__ unsigned xb_add(unsigned* p, unsigned v) { return __hip_atomic_fetch_add(p, v, __ATOMIC_RELAXED, __HIP_MEMORY_SCOPE_AGENT); }
__device__ __forceinline__ unsigned xb_xcc_id() { return (unsigned)__builtin_amdgcn_s_getreg((3 << 11) | 20) & 0xFu; }
#define XB_SPIN(cond, bar) do { unsigned _sp = 0; while (cond) { __builtin_amdgcn_s_sleep(1); \
    if ((++_sp & 255u) == 0u) { if (xb_ld(&(bar)[XB_TMO])) break; if (_sp > XB_SPIN_CAP) { atomicAdd(&(bar)[XB_TMO], 1u); break; } } } } while (0)

struct XcdBarrier {
    unsigned* bar; unsigned x;
    volatile LAS unsigned* st;
};

__device__ __forceinline__ XcdBarrier xcd_barrier_post(unsigned* bar, volatile LAS unsigned* st) {
    XcdBarrier b; b.bar = bar; b.x = xb_xcc_id(); b.st = st;
    if (threadIdx.x == 0) (void)xb_add(&bar[XB_XCNT(b.x)], 1u);
    return b;
}
__device__ __forceinline__ void xcd_barrier_complete(unsigned* bar, unsigned x, unsigned& nloc, unsigned& nx) {
    const unsigned G = gridDim.x * gridDim.y * gridDim.z;
    unsigned sum, cnt, mine, sp = 0u;
    for (;;) {
        sum = 0u; cnt = 0u; mine = 0u;
#pragma unroll
        for (unsigned j = 0; j < 16; ++j) { const unsigned c = xb_ld(&bar[XB_XCNT(j)]); sum += c; cnt += (c > 0u) ? 1u : 0u; mine = (j == x) ? c : mine; }
        if (sum == G) break;
        __builtin_amdgcn_s_sleep(1);
        if ((++sp & 255u) == 0u) { if (xb_ld(&bar[XB_TMO])) break; if (sp > XB_SPIN_CAP) { atomicAdd(&bar[XB_TMO], 1u); break; } }
    }
    nloc = mine > 0u ? mine : 1u; nx = cnt > 0u ? cnt : 1u;
}

__device__ __forceinline__ void xcd_barrier(const XcdBarrier& b) {
    asm volatile("s_waitcnt vmcnt(0)" ::: "memory");
    __syncthreads();
    if (threadIdx.x == 0) {
        unsigned* bar = b.bar;
        __builtin_amdgcn_s_waitcnt(0);
        unsigned nloc = b.st[0], nx = b.st[1];
        if (nloc == 0u) { xcd_barrier_complete(bar, b.x, nloc, nx); b.st[0] = nloc; b.st[1] = nx; }
        const unsigned old = xb_add(&bar[XB_XSUB(b.x)], 1u);
        const unsigned gen = old / nloc;
        if (old + 1u == (gen + 1u) * nloc) {
            __builtin_amdgcn_fence(__ATOMIC_RELEASE, "agent");
            asm volatile("s_waitcnt vmcnt(0)" ::: "memory");
            const unsigned og = xb_add(&bar[XB_TOP], 1u);
            const unsigned tg = og / nx;
            if (og + 1u == (tg + 1u) * nx) xb_add(&bar[XB_TOPGEN], 1u);
            else XB_SPIN(xb_ld(&bar[XB_TOPGEN]) == tg, bar);
            __builtin_amdgcn_fence(__ATOMIC_ACQUIRE, "agent");
            xb_add(&bar[XB_XGEN(b.x)], 1u);
            asm volatile("s_waitcnt vmcnt(0)" ::: "memory");
        } else {
            XB_SPIN(xb_ld(&bar[XB_XGEN(b.x)]) == gen, bar);
            __builtin_amdgcn_fence(__ATOMIC_ACQUIRE, "agent");
            asm volatile("s_waitcnt vmcnt(0)" ::: "memory");
        }
    }
    __syncthreads();
}


__global__ void __launch_bounds__(256, 2) k_mega(P p) {
  __shared__ __attribute__((aligned(16))) char smem[57344];
  cg::grid_group grid = cg::this_grid();
  __shared__ uint4 xb_words;
  if (threadIdx.x == 0) xb_words = make_uint4(0u, 0u, 0u, 0u);
  __syncthreads();
  (void)xcd_barrier_post((unsigned*)(WSP + OFF_BAR), (volatile LAS unsigned*)&xb_words);
#define XBAR() { XcdBarrier xb_; xb_.bar = (unsigned*)(WSP + OFF_BAR); xb_.x = xb_xcc_id(); xb_.st = (volatile LAS unsigned*)&xb_words; xcd_barrier(xb_); }
  run_phase(p, 0, smem); grid.sync();
  run_phase(p, 1, smem); XBAR()
  run_phase(p, 2, smem); XBAR()
  run_phase(p, 3, smem); XBAR()
  run_phase(p, 4, smem); XBAR()
  run_phase(p, 5, smem); XBAR()
  run_phase(p, 15, smem); XBAR()
  run_phase(p, 6, smem); XBAR()
  run_phase(p, 7, smem); XBAR()
  run_phase(p, 9, smem); XBAR()
  run_phase(p, 10, smem); XBAR()
  run_phase(p, 11, smem); XBAR()
  run_phase(p, 12, smem); XBAR()
  run_phase(p, 13, smem); XBAR()
  run_phase(p, 14, smem); XBAR()
  run_phase(p, 16, smem); XBAR()
  run_phase(p, 17, smem); XBAR()
  run_phase(p, 18, smem); XBAR()
  run_phase(p, 19, smem); XBAR()
  run_phase(p, 29, smem); XBAR()
  run_phase(p, 20, smem); XBAR()
  run_phase(p, 21, smem); XBAR()
  run_phase(p, 23, smem); XBAR()
  run_phase(p, 24, smem); XBAR()
  run_phase(p, 25, smem); XBAR()
  run_phase(p, 26, smem); XBAR()
  run_phase(p, 27, smem); XBAR()
  run_phase(p, 28, smem);
#undef XBAR
}
#endif

extern "C" void kernel_launch(void* const* d_in, const int* in_sizes, int n_in, void* d_out, int out_size, void* d_ws, size_t ws_size, hipStream_t stream) {
  if (n_in != 36 || ws_size < WS_END) { fprintf(stderr, "kernel_launch: need 36 inputs and %zu bytes of workspace (got %d, %zu)\n", (size_t)WS_END, n_in, ws_size); return; }
  P p{};
  for (int i = 0; i < 36; ++i) p.in[i] = (const float*)d_in[i];
  p.out = (float*)d_out; p.ws = (char*)d_ws;
#if MULTI_LAUNCH
  for (int ph = 0; ph < NPHASES; ++ph) hipLaunchKernelGGL(k_phase, dim3(512), dim3(256), 0, stream, p, ph);
#else
  static int grid_blocks = 0;
  if (!grid_blocks) {
    int dev = 0, cus = 0, per_cu = 0;
    hipGetDevice(&dev);
    hipDeviceGetAttribute(&cus, hipDeviceAttributeMultiprocessorCount, dev);
    hipOccupancyMaxActiveBlocksPerMultiprocessor(&per_cu, k_mega, 256, 0);
    if (per_cu < 1) per_cu = 1;
    grid_blocks = cus * per_cu;
    if (grid_blocks > 512) grid_blocks = 512;
  }
  hipMemsetAsync((char*)d_ws + OFF_BAR, 0, 16384, stream);
  void* args[] = {&p};
  hipError_t e = hipLaunchCooperativeKernel((void*)k_mega, dim3(grid_blocks), dim3(256), args, 0, stream);
  if (e != hipSuccess) fprintf(stderr, "cooperative launch failed: %s (grid %d)\n", hipGetErrorString(e), grid_blocks);
#endif
}
```

```cpp
#include <hip/hip_runtime.h>
#include <hip/hip_cooperative_groups.h>
#include <cstdio>
namespace cg = cooperative_groups;

#ifndef MULTI_LAUNCH
#define MULTI_LAUNCH 0
#endif

#define DI __device__ __forceinline__
typedef unsigned short u16;
typedef short bf16x8 __attribute__((ext_vector_type(8)));
typedef short s16x4 __attribute__((ext_vector_type(4)));
typedef float f32x16 __attribute__((ext_vector_type(16)));
typedef float f32x2 __attribute__((ext_vector_type(2)));
typedef __bf16 bf16x2_t __attribute__((ext_vector_type(2)));
typedef unsigned u32x4 __attribute__((ext_vector_type(4)));
typedef __bf16 bf16x8_t __attribute__((ext_vector_type(8)));
#define MFMA32(a, b, c) __builtin_amdgcn_mfma_f32_32x32x16_bf16((a), (b), (c), 0, 0, 0)

constexpr int NB = 4, SL = 8192, SC = 256, SB = 8448, NP = NB * SB, DM = 1024, NIN = 8976;
constexpr float LN_EPS = 1e-6f;
constexpr float ALPHA = 1.41421356237f;
constexpr float LOG2E = 1.44269504089f;

constexpr size_t SZ512 = (size_t)NP * 512 * 2;
constexpr size_t OFF_A = 0;
constexpr size_t OFF_QD = OFF_A + 2 * SZ512;
constexpr size_t OFF_KD = OFF_QD + SZ512;
constexpr size_t OFF_VDT = OFF_KD + SZ512;
constexpr size_t OFF_S5U = OFF_VDT + SZ512;
constexpr size_t OFF_MQ = OFF_S5U + SZ512;
constexpr size_t OFF_MK = OFF_MQ + SZ512;
constexpr size_t OFF_MVT = OFF_MK + SZ512;
constexpr size_t OFF_MO = OFF_MVT + SZ512;
constexpr size_t OFF_QG = OFF_MO + SZ512;
constexpr size_t OFF_KG = OFF_QG + SZ512;
constexpr size_t OFF_VGT = OFF_KG + SZ512 / 4;
constexpr size_t OFF_MGATE = OFF_VGT + SZ512 / 4;
constexpr size_t OFF_WIN = OFF_MGATE + (size_t)NP * 16 * 4;
constexpr size_t OFF_WBR = OFF_WIN + (size_t)9088 * 1024 * 2;
constexpr size_t OFF_WO = OFF_WBR + (size_t)4 * 1024 * 512 * 2;
constexpr size_t OFF_WGLU = OFF_WO + (size_t)1024 * 1024 * 2;
constexpr size_t OFF_WQ = OFF_WGLU + (size_t)1024 * 512 * 2;
constexpr size_t OFF_SK = OFF_WQ + (size_t)2048 * 1024 * 2;
constexpr size_t OFF_MODP = OFF_SK + 65536;
constexpr size_t OFF_MOD = OFF_MODP + (size_t)2 * 8 * 5 * 6144 * 4;
constexpr size_t OFF_LAMB = OFF_MOD + (size_t)2 * 5 * 6144 * 4;
constexpr size_t OFF_BBAR = OFF_LAMB + 65536;
constexpr size_t OFF_LAMV = OFF_BBAR + 1048576;
constexpr size_t SZCH = (size_t)32 * SB * 4;
constexpr size_t OFF_GI = OFF_LAMV + 256;
constexpr size_t OFF_GF = OFF_GI + SZCH;
constexpr size_t OFF_AA = OFF_GF + SZCH;
constexpr size_t OFF_MXA = OFF_AA + SZCH;
constexpr size_t OFF_MTA = OFF_MXA + SZCH;
constexpr size_t SZHE = (size_t)NB * 2 * 32 * 132 * 64 * 8;
constexpr size_t OFF_HEND = OFF_MTA + SZCH;
constexpr size_t OFF_CARRY = OFF_HEND + SZHE;
constexpr size_t OFF_HC = OFF_CARRY + SZHE;
constexpr size_t OFF_STASH = OFF_HC + (size_t)1024 * 1024 * 4;
constexpr size_t OFF_PU = OFF_STASH;
constexpr size_t OFF_PV = OFF_STASH + (size_t)16384 * 1024;
constexpr size_t OFF_ROPE = OFF_STASH + (size_t)512 * 64 * 256 * 4;
constexpr size_t OFF_TMAX = OFF_ROPE + 32768;
constexpr size_t OFF_BBT = OFF_TMAX + 32768;
constexpr size_t OFF_CMT = OFF_BBT + 524288;
constexpr size_t OFF_NST = OFF_CMT + 524288;
constexpr size_t OFF_NPST = OFF_NST + (size_t)1056 * 128 * 4;
constexpr size_t OFF_ALOC = OFF_NPST + (size_t)1056 * 128 * 4;
constexpr size_t OFF_BKA = OFF_ALOC + 8192;
constexpr size_t OFF_CTR = OFF_BKA + 8192;
constexpr size_t OFF_BAR = OFF_CTR + 256;
constexpr size_t WS_END = OFF_BAR + 16384;
constexpr size_t OFF_GST = OFF_MQ;
constexpr size_t OFF_PST = OFF_MK;
constexpr size_t OFF_Z = OFF_MQ;

constexpr size_t OFF_Q2 = OFF_S5U;
constexpr size_t OFF_IDX = OFF_MO;
constexpr size_t OFF_GATE = OFF_MO + (size_t)NP * 8 * 16 * 4;

struct P {
  const float* in[36];
  float* out;
  char* ws;
};

typedef const float* const __attribute__((address_space(4)))* kargp_t;
DI kargp_t karg() { kargp_t k = (kargp_t)__builtin_amdgcn_kernarg_segment_ptr(); asm volatile("" : "+s"(k)); return k; }
#define IN(i) (karg()[i])
#define OUTP ((float*)karg()[36])
#define WSP ((char*)karg()[37])
DI int otid() { int t = threadIdx.x; asm volatile("" : "+v"(t)); return t; }
template <int M> DI int shx_i(int v) {
  if constexpr (M < 32) return __builtin_amdgcn_ds_swizzle(v, 0x1f | (M << 10));
  else return __builtin_amdgcn_ds_bpermute(((otid() & 63) ^ M) << 2, v);
}
#define SHX(v, M) __int_as_float(shx_i<M>(__float_as_int(v)))
#define SHXI(v, M) shx_i<M>(v)
DI unsigned cvtpk(float lo, float hi) { f32x2 v = {lo, hi}; bf16x2_t b = __builtin_convertvector(v, bf16x2_t); return __builtin_bit_cast(unsigned, b); }
DI u16 f2bf(float x) { return (u16)(cvtpk(x, 0.f) & 0xffffu); }
DI float bf2f(u16 x) { return __uint_as_float(((unsigned)x) << 16); }
DI float bflo(unsigned u) { return __uint_as_float(u << 16); }
DI float bfhi(unsigned u) { return __uint_as_float(u & 0xffff0000u); }
DI float wave_sum(float v) { v += SHX(v, 32); v += SHX(v, 16); v += SHX(v, 8); v += SHX(v, 4); v += SHX(v, 2); v += SHX(v, 1); return v; }
DI float wave_max(float v) { v = fmaxf(v, SHX(v, 32)); v = fmaxf(v, SHX(v, 16)); v = fmaxf(v, SHX(v, 8)); v = fmaxf(v, SHX(v, 4)); v = fmaxf(v, SHX(v, 2)); v = fmaxf(v, SHX(v, 1)); return v; }
DI float block_sum(float v, float* red) {
  v = wave_sum(v);
  __syncthreads();
  if ((otid() & 63) == 0) red[otid() >> 6] = v;
  __syncthreads();
  return red[0] + red[1] + red[2] + red[3];
}
DI float sigmoidf_(float x) { return __builtin_amdgcn_rcpf(1.f + __expf(-x)); }
DI float gelu_erf(float x) { return 0.5f * x * (1.f + erff(x * 0.70710678118f)); }
DI float silu_(float x) { return x * __builtin_amdgcn_rcpf(1.f + __expf(-x)); }
DI float fexp2(float x) { return __builtin_amdgcn_exp2f(x); }

DI const float* h_in_ptr(const P& p, int L, int pos) {
  int b = pos / SB, s = pos - b * SB;
  if (L == 0) return s < SL ? IN(0) + ((size_t)b * SL + s) * DM : IN(2) + ((size_t)b * SC + (s - SL)) * DM;
  return s < SL ? OUTP + ((size_t)b * SL + s) * DM : (const float*)(WSP + OFF_HC) + ((size_t)b * SC + (s - SL)) * DM;
}
DI float* h_out_ptr(const P& p, int pos) {
  int b = pos / SB, s = pos - b * SB;
  return s < SL ? OUTP + ((size_t)b * SL + s) * DM : (float*)(WSP + OFF_HC) + ((size_t)b * SC + (s - SL)) * DM;
}
DI const float* mod_ptr(const P& p, int L, int pos) {
  int b = pos / SB, s = pos - b * SB;
  int v = s < SL ? b : 4;
  return (const float*)(WSP + OFF_MOD) + ((size_t)L * 5 + v) * 6144;
}

DI void gemm_core(const u16* __restrict__ A, int lda, const u16* __restrict__ B, int ldb, int K, f32x16 (&acc)[2][2], u16* lds) {
  const int tid = otid(), lane = tid & 63, wave = tid >> 6;
  const int wm = wave >> 1, wn = wave & 1, r32 = lane & 31, h = lane >> 5;
  u16* As = lds; u16* Bs = lds + 128 * 72;
  const int lr = tid >> 3, lc = (tid & 7) * 8;
  u32x4 ra[4], rb[4];
  const int nk = K >> 6;
#pragma unroll
  for (int i = 0; i < 4; ++i) {
    ra[i] = *(const u32x4*)(A + (size_t)(lr + 32 * i) * lda + lc);
    rb[i] = *(const u32x4*)(B + (size_t)(lr + 32 * i) * ldb + lc);
  }
#pragma unroll 1
  for (int kt = 0; kt < nk; ++kt) {
    __syncthreads();
#pragma unroll
    for (int i = 0; i < 4; ++i) {
      *(u32x4*)(As + (lr + 32 * i) * 72 + lc) = ra[i];
      *(u32x4*)(Bs + (lr + 32 * i) * 72 + lc) = rb[i];
    }
    __syncthreads();
    if (kt + 1 < nk) {
#pragma unroll
      for (int i = 0; i < 4; ++i) {
        ra[i] = *(const u32x4*)(A + (size_t)(lr + 32 * i) * lda + (kt + 1) * 64 + lc);
        rb[i] = *(const u32x4*)(B + (size_t)(lr + 32 * i) * ldb + (kt + 1) * 64 + lc);
      }
    }
#pragma unroll
    for (int s = 0; s < 4; ++s) {
      bf16x8 af[2], bfr[2];
#pragma unroll
      for (int mi = 0; mi < 2; ++mi) af[mi] = *(const bf16x8*)(As + (wm * 64 + mi * 32 + r32) * 72 + s * 16 + h * 8);
#pragma unroll
      for (int ni = 0; ni < 2; ++ni) bfr[ni] = *(const bf16x8*)(Bs + (wn * 64 + ni * 32 + r32) * 72 + s * 16 + h * 8);
#pragma unroll
      for (int mi = 0; mi < 2; ++mi)
#pragma unroll
        for (int ni = 0; ni < 2; ++ni) acc[mi][ni] = MFMA32(af[mi], bfr[ni], acc[mi][ni]);
    }
  }
}
DI void acc_zero(f32x16 (&acc)[2][2]) {
#pragma unroll
  for (int mi = 0; mi < 2; ++mi)
#pragma unroll
    for (int ni = 0; ni < 2; ++ni)
#pragma unroll
      for (int i = 0; i < 16; ++i) acc[mi][ni][i] = 0.f;
}
#define EPI_LOOP(acc, BODY)                                                                   \
  {                                                                                           \
    const int e_lane = otid() & 63, e_wave = otid() >> 6;                           \
    const int e_wm = e_wave >> 1, e_wn = e_wave & 1, e_r = e_lane & 31, e_h = e_lane >> 5;    \
    _Pragma("unroll") for (int mi = 0; mi < 2; ++mi) _Pragma("unroll") for (int ni = 0; ni < 2; ++ni) \
    _Pragma("unroll") for (int i = 0; i < 16; ++i) {                                         \
      const int row = e_wm * 64 + mi * 32 + (i & 3) + 8 * (i >> 2) + 4 * e_h;                 \
      const int col = e_wn * 64 + ni * 32 + e_r;                                              \
      const float val = acc[mi][ni][i];                                                       \
      BODY                                                                                    \
    }                                                                                         \
  }

template <bool GLUPERM = false>
DI void transpose_tile(const float* __restrict__ src, int K, int N, u16* __restrict__ dst, int tile, float* lds) {
  const int ntn = (N + 63) >> 6;
  const int k0 = (tile / ntn) * 64, n0 = (tile % ntn) * 64;
  const int tid = otid();
  __syncthreads();
  {
    const int r = tid >> 4, c4 = (tid & 15) * 4;
#pragma unroll
    for (int i = 0; i < 4; ++i) {
      const int kk = r + 16 * i;
      float4 v = make_float4(0.f, 0.f, 0.f, 0.f);
      if (n0 + c4 < N) v = *(const float4*)(src + (size_t)(k0 + kk) * N + n0 + c4);
      lds[kk * 65 + c4 + 0] = v.x; lds[kk * 65 + c4 + 1] = v.y; lds[kk * 65 + c4 + 2] = v.z; lds[kk * 65 + c4 + 3] = v.w;
    }
  }
  __syncthreads();
  {
    const int n = tid >> 2, kc = (tid & 3) * 16;
    if (n0 + n < N) {
      unsigned w[8];
#pragma unroll
      for (int j = 0; j < 8; ++j) w[j] = cvtpk(lds[(kc + 2 * j) * 65 + n], lds[(kc + 2 * j + 1) * 65 + n]);
      int nd = n0 + n;
      if (GLUPERM) { const int ca = nd & 511; nd = (ca >> 6) * 128 + ((ca >> 5) & 1) * 64 + (nd >= 512 ? 32 : 0) + (ca & 31); }
      uint4* d = (uint4*)(dst + (size_t)nd * K + k0 + kc);
      d[0] = make_uint4(w[0], w[1], w[2], w[3]);
      d[1] = make_uint4(w[4], w[5], w[6], w[7]);
    }
  }
}
DI void convert_chunk(const float* __restrict__ src, u16* __restrict__ dst, size_t chunk) {
  const size_t o = chunk * 2048 + (size_t)otid() * 8;
  const float4 a = *(const float4*)(src + o), b = *(const float4*)(src + o + 4);
  *(uint4*)(dst + o) = make_uint4(cvtpk(a.x, a.y), cvtpk(a.z, a.w), cvtpk(b.x, b.y), cvtpk(b.z, b.w));
}

DI void convert_chunk_fp8(const float* __restrict__ src, unsigned char* __restrict__ dst, size_t chunk, float scale) {
  const size_t o = chunk * 2048 + (size_t)otid() * 8;
  const float4 a = *(const float4*)(src + o), b = *(const float4*)(src + o + 4);
  int w0 = 0, w1 = 0;
  w0 = __builtin_amdgcn_cvt_pk_fp8_f32(a.x * scale, a.y * scale, w0, false); w0 = __builtin_amdgcn_cvt_pk_fp8_f32(a.z * scale, a.w * scale, w0, true);
  w1 = __builtin_amdgcn_cvt_pk_fp8_f32(b.x * scale, b.y * scale, w1, false); w1 = __builtin_amdgcn_cvt_pk_fp8_f32(b.z * scale, b.w * scale, w1, true);
  *(uint2*)(dst + o) = make_uint2((unsigned)w0, (unsigned)w1);
}

DI void ln_mod_row(const float* __restrict__ hrow, const float* __restrict__ shift, const float* __restrict__ scale, u16* __restrict__ dst, float* red) {
  const int tid = otid();
  const float4 x = *(const float4*)(hrow + tid * 4);
  const float mean = block_sum(x.x + x.y + x.z + x.w, red) * (1.f / DM);
  const float a = x.x - mean, b = x.y - mean, c = x.z - mean, d = x.w - mean;
  const float var = block_sum(a * a + b * b + c * c + d * d, red) * (1.f / DM);
  const float rs = rsqrtf(var + LN_EPS);
  const float4 sh = *(const float4*)(shift + tid * 4), sc = *(const float4*)(scale + tid * 4);
  const float y0 = a * rs * (1.f + sc.x) + sh.x, y1 = b * rs * (1.f + sc.y) + sh.y, y2 = c * rs * (1.f + sc.z) + sh.z, y3 = d * rs * (1.f + sc.w) + sh.w;
  *(uint2*)(dst + tid * 4) = make_uint2(cvtpk(y0, y1), cvtpk(y2, y3));
}

DI void ln_mod_wave(const float* __restrict__ hrow, const float* __restrict__ shift, const float* __restrict__ scale, u16* __restrict__ dst, int lane) {
  float4 x[4];
#pragma unroll
  for (int i = 0; i < 4; ++i) x[i] = *(const float4*)(hrow + lane * 4 + 256 * i);
  float sm = 0.f;
#pragma unroll
  for (int i = 0; i < 4; ++i) sm += x[i].x + x[i].y + x[i].z + x[i].w;
  const float mean = wave_sum(sm) * (1.f / DM);
  float vs = 0.f;
#pragma unroll
  for (int i = 0; i < 4; ++i) { x[i].x -= mean; x[i].y -= mean; x[i].z -= mean; x[i].w -= mean; vs += x[i].x * x[i].x + x[i].y * x[i].y + x[i].z * x[i].z + x[i].w * x[i].w; }
  const float rs = rsqrtf(wave_sum(vs) * (1.f / DM) + LN_EPS);
#pragma unroll
  for (int i = 0; i < 4; ++i) {
    const float4 sh = *(const float4*)(shift + lane * 4 + 256 * i), sc = *(const float4*)(scale + lane * 4 + 256 * i);
    *(uint2*)(dst + lane * 4 + 256 * i) = make_uint2(cvtpk(x[i].x * rs * (1.f + sc.x) + sh.x, x[i].y * rs * (1.f + sc.y) + sh.y), cvtpk(x[i].z * rs * (1.f + sc.z) + sh.z, x[i].w * rs * (1.f + sc.w) + sh.w));
  }
}

template <int VD>
DI void attn_pass(const u16* __restrict__ qrow, const u16* __restrict__ Kb, int ldk, const u16* __restrict__ Vt, int nkeys, f32x16 (&O)[VD / 32], float& lsum, u16* lds) {
  constexpr int NV = VD / 32;
  const int tid = otid(), lane = tid & 63, r32 = lane & 31, h = lane >> 5;
  u16* Ks = lds; u16* Vs = lds + 64 * 72;
  bf16x8 qf[4];
#pragma unroll
  for (int s = 0; s < 4; ++s) qf[s] = *(const bf16x8*)(qrow + s * 16 + h * 8);
#pragma unroll
  for (int vb = 0; vb < NV; ++vb)
#pragma unroll
    for (int i = 0; i < 16; ++i) O[vb][i] = 0.f;
  float m = -INFINITY, l = 0.f;
  const float c = 0.125f * LOG2E;
  const int lr = tid >> 3, lc = (tid & 7) * 8;
  u32x4 rk[2], rv[NV];
#pragma unroll
  for (int i = 0; i < 2; ++i) rk[i] = *(const u32x4*)(Kb + (size_t)(lr + 32 * i) * ldk + lc);
#pragma unroll
  for (int i = 0; i < NV; ++i) rv[i] = *(const u32x4*)(Vt + (size_t)(lr + 32 * i) * NP + lc);
  for (int k0 = 0; k0 < nkeys; k0 += 64) {
    __syncthreads();
#pragma unroll
    for (int i = 0; i < 2; ++i) *(u32x4*)(Ks + (lr + 32 * i) * 72 + lc) = rk[i];
#pragma unroll
    for (int i = 0; i < NV; ++i) *(u32x4*)(Vs + (lr + 32 * i) * 72 + lc) = rv[i];
    __syncthreads();
    if (k0 + 64 < nkeys) {
#pragma unroll
      for (int i = 0; i < 2; ++i) rk[i] = *(const u32x4*)(Kb + (size_t)(k0 + 64 + lr + 32 * i) * ldk + lc);
#pragma unroll
      for (int i = 0; i < NV; ++i) rv[i] = *(const u32x4*)(Vt + (size_t)(lr + 32 * i) * NP + k0 + 64 + lc);
    }
    f32x16 S[2];
#pragma unroll
    for (int kb = 0; kb < 2; ++kb)
#pragma unroll
      for (int i = 0; i < 16; ++i) S[kb][i] = 0.f;
#pragma unroll
    for (int s = 0; s < 4; ++s)
#pragma unroll
      for (int kb = 0; kb < 2; ++kb) {
        const bf16x8 kf = *(const bf16x8*)(Ks + (kb * 32 + r32) * 72 + s * 16 + h * 8);
        S[kb] = MFMA32(kf, qf[s], S[kb]);
      }
    float mx = S[0][0];
#pragma unroll
    for (int kb = 0; kb < 2; ++kb)
#pragma unroll
      for (int i = 0; i < 16; ++i) mx = fmaxf(mx, S[kb][i]);
    mx = fmaxf(mx, SHX(mx, 32));
    if (__ballot(mx > m + 40.f) != 0ull) {
      const float mn = fmaxf(m, mx);
      const float alpha = fexp2((m - mn) * c);
      m = mn;
      l *= alpha;
#pragma unroll
      for (int vb = 0; vb < NV; ++vb)
#pragma unroll
        for (int i = 0; i < 16; ++i) O[vb][i] *= alpha;
    }
    const float mc = m * c;
    float rs = 0.f;
#pragma unroll
    for (int kb = 0; kb < 2; ++kb)
#pragma unroll
      for (int i = 0; i < 16; ++i) { const float pv = fexp2(S[kb][i] * c - mc); S[kb][i] = pv; rs += pv; }
    l += rs;
#pragma unroll
    for (int kb = 0; kb < 2; ++kb)
#pragma unroll
      for (int s2 = 0; s2 < 2; ++s2) {
        uint4 pw;
        pw.x = cvtpk(S[kb][8 * s2 + 0], S[kb][8 * s2 + 1]); pw.y = cvtpk(S[kb][8 * s2 + 2], S[kb][8 * s2 + 3]);
        pw.z = cvtpk(S[kb][8 * s2 + 4], S[kb][8 * s2 + 5]); pw.w = cvtpk(S[kb][8 * s2 + 6], S[kb][8 * s2 + 7]);
        const bf16x8 pf = __builtin_bit_cast(bf16x8, pw);
#pragma unroll
        for (int vb = 0; vb < NV; ++vb) {
          const u16* vp = Vs + (vb * 32 + r32) * 72 + kb * 32 + s2 * 16 + 4 * h;
          const s16x4 lo = *(const s16x4*)vp, hi = *(const s16x4*)(vp + 8);
          const bf16x8 vf = __builtin_shufflevector(lo, hi, 0, 1, 2, 3, 4, 5, 6, 7);
          O[vb] = MFMA32(vf, pf, O[vb]);
        }
      }
  }
  lsum = l + SHX(l, 32);
}

DI void attn_pass_gqa2(const u16* __restrict__ qrow0, const u16* __restrict__ qrow1, const u16* __restrict__ Kb, int ldk, const u16* __restrict__ Vt, int nkeys,
                       f32x16 (&O)[2][2], float (&lsum)[2], u16* lds) {
  const int tid = otid(), lane = tid & 63, r32 = lane & 31, h = lane >> 5;
  u16* Ks = lds; u16* Vs = lds + 64 * 72;
  bf16x8 qf[2][4];
#pragma unroll
  for (int s = 0; s < 4; ++s) { qf[0][s] = *(const bf16x8*)(qrow0 + s * 16 + h * 8); qf[1][s] = *(const bf16x8*)(qrow1 + s * 16 + h * 8); }
#pragma unroll
  for (int hd = 0; hd < 2; ++hd)
#pragma unroll
    for (int vb = 0; vb < 2; ++vb)
#pragma unroll
      for (int i = 0; i < 16; ++i) O[hd][vb][i] = 0.f;
  float m[2] = {-INFINITY, -INFINITY}, l[2] = {0.f, 0.f};
  const float c = 0.125f * LOG2E;
  const int lr = tid >> 3, lc = (tid & 7) * 8;
  u32x4 rk[2], rv[2];
#pragma unroll
  for (int i = 0; i < 2; ++i) rk[i] = *(const u32x4*)(Kb + (size_t)(lr + 32 * i) * ldk + lc);
#pragma unroll
  for (int i = 0; i < 2; ++i) rv[i] = *(const u32x4*)(Vt + (size_t)(lr + 32 * i) * NP + lc);
  for (int k0 = 0; k0 < nkeys; k0 += 64) {
    __syncthreads();
#pragma unroll
    for (int i = 0; i < 2; ++i) *(u32x4*)(Ks + (lr + 32 * i) * 72 + lc) = rk[i];
#pragma unroll
    for (int i = 0; i < 2; ++i) *(u32x4*)(Vs + (lr + 32 * i) * 72 + lc) = rv[i];
    __syncthreads();
    if (k0 + 64 < nkeys) {
#pragma unroll
      for (int i = 0; i < 2; ++i) rk[i] = *(const u32x4*)(Kb + (size_t)(k0 + 64 + lr + 32 * i) * ldk + lc);
#pragma unroll
      for (int i = 0; i < 2; ++i) rv[i] = *(const u32x4*)(Vt + (size_t)(lr + 32 * i) * NP + k0 + 64 + lc);
    }
#pragma unroll
    for (int hd = 0; hd < 2; ++hd) {
      f32x16 S[2];
#pragma unroll
      for (int kb = 0; kb < 2; ++kb)
#pragma unroll
        for (int i = 0; i < 16; ++i) S[kb][i] = 0.f;
#pragma unroll
      for (int s = 0; s < 4; ++s)
#pragma unroll
        for (int kb = 0; kb < 2; ++kb) {
          const bf16x8 kf = *(const bf16x8*)(Ks + (kb * 32 + r32) * 72 + s * 16 + h * 8);
          S[kb] = MFMA32(kf, qf[hd][s], S[kb]);
        }
      float mx = S[0][0];
#pragma unroll
      for (int kb = 0; kb < 2; ++kb)
#pragma unroll
        for (int i = 0; i < 16; ++i) mx = fmaxf(mx, S[kb][i]);
      mx = fmaxf(mx, SHX(mx, 32));
      if (__ballot(mx > m[hd] + 40.f) != 0ull) {
        const float mn = fmaxf(m[hd], mx);
        const float alpha = fexp2((m[hd] - mn) * c);
        m[hd] = mn;
        l[hd] *= alpha;
#pragma unroll
        for (int vb = 0; vb < 2; ++vb)
#pragma unroll
          for (int i = 0; i < 16; ++i) O[hd][vb][i] *= alpha;
      }
      const float mc = m[hd] * c;
      float rs = 0.f;
#pragma unroll
      for (int kb = 0; kb < 2; ++kb)
#pragma unroll
        for (int i = 0; i < 16; ++i) { const float pv = fexp2(S[kb][i] * c - mc); S[kb][i] = pv; rs += pv; }
      l[hd] += rs;
#pragma unroll
      for (int kb = 0; kb < 2; ++kb)
#pragma unroll
        for (int s2 = 0; s2 < 2; ++s2) {
          uint4 pw;
          pw.x = cvtpk(S[kb][8 * s2 + 0], S[kb][8 * s2 + 1]); pw.y = cvtpk(S[kb][8 * s2 + 2], S[kb][8 * s2 + 3]);
          pw.z = cvtpk(S[kb][8 * s2 + 4], S[kb][8 * s2 + 5]); pw.w = cvtpk(S[kb][8 * s2 + 6], S[kb][8 * s2 + 7]);
          const bf16x8 pf = __builtin_bit_cast(bf16x8, pw);
#pragma unroll
          for (int vb = 0; vb < 2; ++vb) {
            const u16* vp = Vs + (vb * 32 + r32) * 72 + kb * 32 + s2 * 16 + 4 * h;
            const s16x4 lo = *(const s16x4*)vp, hi = *(const s16x4*)(vp + 8);
            const bf16x8 vf = __builtin_shufflevector(lo, hi, 0, 1, 2, 3, 4, 5, 6, 7);
            O[hd][vb] = MFMA32(vf, pf, O[hd][vb]);
          }
        }
    }
  }
  lsum[0] = l[0] + SHX(l[0], 32);
  lsum[1] = l[1] + SHX(l[1], 32);
}

DI int chain_idx(int dir, int s) { return dir == 0 ? (s < SL ? s + SC : s - SL) : (SB - 1 - s); }
DI void mlstm_dir(const bf16x8 (&qf)[8], const u16* __restrict__ Kb, const u16* __restrict__ Vt, const float* __restrict__ Aarr, const float* __restrict__ tmax, int dir,
                  int t0a, int t0b, int t1a, int t1b, int cq, float mxq, f32x16 (&num)[4], float& den_out, char* smem) {
  const int tid = otid(), lane = tid & 63, r32 = lane & 31, h = lane >> 5;
  u16* Ks = (u16*)smem; u16* Vs = (u16*)(smem + 17408); float* As = (float*)(smem + 17408 + 18432);
  float den = 0.f;
  const int n0 = t0b - t0a, nall = n0 + (t1b - t1a);
  const int kr = tid >> 4, kc = (tid & 15) * 8, vr = tid >> 3, vc = (tid & 7) * 8;
  u32x4 rk[4], rv[4]; float ra = 0.f;
  int* tlist = (int*)(smem + 17408 + 18432 + 256);
  float* tred = (float*)(smem + 17408 + 18432 + 256 + 544);
  {
    float mn = fminf(mxq, SHX(mxq, 32));
    mn = fminf(mn, SHX(mn, 16)); mn = fminf(mn, SHX(mn, 8)); mn = fminf(mn, SHX(mn, 4)); mn = fminf(mn, SHX(mn, 2)); mn = fminf(mn, SHX(mn, 1));
    __syncthreads();
    if (lane == 0) tred[tid >> 6] = mn;
    __syncthreads();
    if (tid == 0) {
      const float bmin = fminf(fminf(tred[0], tred[1]), fminf(tred[2], tred[3]));
      int cnt = 0;
      for (int u = 0; u < nall; ++u) {
        const int k0 = u < n0 ? SL + 64 * (t0a + u) : 64 * (t1a + u - n0);
        if (tmax[k0 >> 6] * LOG2E - bmin > -64.f) tlist[1 + cnt++] = k0;
      }
      tlist[0] = cnt;
    }
    __syncthreads();
  }
  const int ntile = tlist[0];
  auto tile_k0 = [&](int u) { return tlist[1 + u]; };
  for (int u = 0; u < ntile; ++u) {
    const int k0 = tile_k0(u);
    __syncthreads();
    {
#pragma unroll
      for (int i = 0; i < 4; ++i) rk[i] = *(const u32x4*)(Kb + (size_t)(k0 + kr + 16 * i) * 512 + kc);
#pragma unroll
      for (int i = 0; i < 4; ++i) rv[i] = *(const u32x4*)(Vt + (size_t)(vr + 32 * i) * NP + k0 + vc);
      if (tid < 64) ra = Aarr[k0 + tid] * LOG2E;
#pragma unroll
      for (int i = 0; i < 4; ++i) *(u32x4*)(Ks + (kr + 16 * i) * 136 + kc) = rk[i];
#pragma unroll
      for (int i = 0; i < 4; ++i) *(u32x4*)(Vs + (vr + 32 * i) * 72 + vc) = rv[i];
      if (tid < 64) As[tid] = ra;
    }
    __syncthreads();
    f32x16 S[2];
#pragma unroll
    for (int kb = 0; kb < 2; ++kb)
#pragma unroll
      for (int i = 0; i < 16; ++i) S[kb][i] = 0.f;
#pragma unroll
    for (int s = 0; s < 8; ++s)
#pragma unroll
      for (int kb = 0; kb < 2; ++kb) {
        const bf16x8 kf = *(const bf16x8*)(Ks + (kb * 32 + r32) * 136 + s * 16 + h * 8);
        S[kb] = MFMA32(kf, qf[s], S[kb]);
      }
#pragma unroll
    for (int kb = 0; kb < 2; ++kb)
#pragma unroll
      for (int g = 0; g < 4; ++g) {
        const float4 a4 = *(const float4*)(As + kb * 32 + 8 * g + 4 * h);
        const float av[4] = {a4.x, a4.y, a4.z, a4.w};
#pragma unroll
        for (int e = 0; e < 4; ++e) {
          const int sk = k0 + kb * 32 + 8 * g + 4 * h + e;
          const int ck = chain_idx(dir, sk);
          const float w = (ck <= cq) ? fexp2(fminf(av[e] - mxq, 0.f)) : 0.f;
          const float pv = S[kb][4 * g + e] * w;
          S[kb][4 * g + e] = pv; den += pv;
        }
      }
#pragma unroll
    for (int kb = 0; kb < 2; ++kb)
#pragma unroll
      for (int s2 = 0; s2 < 2; ++s2) {
        uint4 pw;
        pw.x = cvtpk(S[kb][8 * s2 + 0], S[kb][8 * s2 + 1]); pw.y = cvtpk(S[kb][8 * s2 + 2], S[kb][8 * s2 + 3]);
        pw.z = cvtpk(S[kb][8 * s2 + 4], S[kb][8 * s2 + 5]); pw.w = cvtpk(S[kb][8 * s2 + 6], S[kb][8 * s2 + 7]);
        const bf16x8 pf = __builtin_bit_cast(bf16x8, pw);
#pragma unroll
        for (int vb = 0; vb < 4; ++vb) {
          const u16* vp = Vs + (vb * 32 + r32) * 72 + kb * 32 + s2 * 16 + 4 * h;
          const s16x4 lo = *(const s16x4*)vp, hi = *(const s16x4*)(vp + 8);
          const bf16x8 vf = __builtin_shufflevector(lo, hi, 0, 1, 2, 3, 4, 5, 6, 7);
          num[vb] = MFMA32(vf, pf, num[vb]);
        }
      }
  }
  den_out += den + SHX(den, 32);
}

DI void s5_load_u(const u16* __restrict__ S5U, int b, int lo, int g, float* lu, int lane) {
  const u16* src = S5U + ((size_t)b * SB + lo + lane) * 512 + g * 16;
  const uint4 a = *(const uint4*)src, c = *(const uint4*)(src + 8);
  float* d = lu + lane * 16;
  d[0] = bflo(a.x); d[1] = bfhi(a.x); d[2] = bflo(a.y); d[3] = bfhi(a.y); d[4] = bflo(a.z); d[5] = bfhi(a.z); d[6] = bflo(a.w); d[7] = bfhi(a.w);
  d[8] = bflo(c.x); d[9] = bfhi(c.x); d[10] = bflo(c.y); d[11] = bfhi(c.y); d[12] = bflo(c.z); d[13] = bfhi(c.z); d[14] = bflo(c.w); d[15] = bfhi(c.w);
}

DI void s5_bu_half(const u16* __restrict__ urow, const bf16x8 (&bfr)[4], u16* W, int r32, int h) {
  const bf16x8 af = *(const bf16x8*)urow;
#pragma unroll
  for (int j = 0; j < 4; ++j) {
    f32x16 z;
#pragma unroll
    for (int i = 0; i < 16; ++i) z[i] = 0.f;
    const f32x16 acc = MFMA32(af, bfr[j], z);
#pragma unroll
    for (int i = 0; i < 16; ++i) W[((i & 3) + 8 * (i >> 2) + 4 * h) * 136 + 32 * j + r32] = f2bf(acc[i]);
  }
}
template <bool WB>
DI void s5_scan_half(u16* W, int dir, int recol, float2 lam, float& hr, float& hi) {
#pragma unroll 4
  for (int q = 0; q < 32; ++q) {
    const int t = dir ? 31 - q : q;
    const float br = bf2f(W[t * 136 + recol]), bi = bf2f(W[t * 136 + recol + 32]);
    const float nr = lam.x * hr - lam.y * hi + br, ni = lam.x * hi + lam.y * hr + bi;
    hr = nr; hi = ni;
    if (WB) { W[t * 136 + recol] = f2bf(hr); W[t * 136 + recol + 32] = f2bf(hi); }
  }
}

__device__ const unsigned char PEER_PAIRS[64] = {0, 1, 2, 3, 4, 5, 6, 7, 8, 9, 10, 11, 12, 13, 14, 15, 16, 17, 18, 19, 20, 21, 22, 23, 32, 33, 34, 35, 36, 48, 49, 50, 51, 64, 65, 66, 80, 81, 96, 97, 112, 113, 128, 144, 160, 176, 192, 208, 224, 240, 0, 0, 0, 0, 0, 0, 0, 0, 0, 0, 0, 0, 0, 0};

constexpr int NPH_LAYER = 14;
constexpr int NPHASES = 2 + 2 * NPH_LAYER;

__device__ __forceinline__ void run_phase(const P& p, int ph, char* smem) {
  const int tid = otid(), lane = tid & 63, wave = tid >> 6;
  const int G = gridDim.x, bid = blockIdx.x;
  char* ws = WSP;
  float* fsm = (float*)smem;
  u16* usm = (u16*)smem;

  if (ph == 0) {
    const int n_mod = 2 * 8 * 24, n_s5 = 32, n_all = n_mod + n_s5 + 2;
    for (int it = bid; it < n_all; it += G) {
      if (it < n_mod) {
        const int L = it / 192, ic = (it / 24) % 8, jc = it % 24;
        __syncthreads();
        for (int e = tid; e < 5 * 128; e += 256) {
          const int v = e / 128, i = ic * 128 + (e % 128);
          const float cv = v < 4 ? IN(1)[v * DM + i] : IN(3)[i];
          fsm[e] = silu_(cv);
        }
        __syncthreads();
        const int j = jc * 256 + tid;
        const float* w = IN(4) + ((size_t)L * DM + ic * 128) * 6144 + j;
        float a0 = 0, a1 = 0, a2 = 0, a3 = 0, a4 = 0;
#pragma unroll 8
        for (int i = 0; i < 128; ++i) {
          const float wv = w[(size_t)i * 6144];
          a0 += fsm[i] * wv; a1 += fsm[128 + i] * wv; a2 += fsm[256 + i] * wv; a3 += fsm[384 + i] * wv; a4 += fsm[512 + i] * wv;
        }
        float* o = (float*)(ws + OFF_MODP) + ((size_t)(L * 8 + ic) * 5) * 6144 + j;
        o[0] = a0; o[6144] = a1; o[2 * 6144] = a2; o[3 * 6144] = a3; o[4 * 6144] = a4;
      } else if (it < n_mod + n_s5) {
        const int e = (it - n_mod) * 256 + tid;
        const int n = e & 63, g = (e >> 6) & 31, ld = e >> 11;
        const float dt = expf(IN(14)[ld * 32 + g]);
        const float ar = IN(12)[e], ai = IN(13)[e];
        const float mag = expf(ar * dt);
        float sn, cs; sincosf(ai * dt, &sn, &cs);
        const float lr = mag * cs, li = mag * sn;
        const float dn = ar * ar + ai * ai;
        const float cr = ((lr - 1.f) * ar + li * ai) / dn, ci = (li * ar - (lr - 1.f) * ai) / dn;
        ((float2*)(ws + OFF_LAMB))[e] = make_float2(lr, li);
        float2* bb = (float2*)(ws + OFF_BBAR) + (size_t)e * 16;
        const float* br = IN(15) + (size_t)e * 16; const float* bi = IN(16) + (size_t)e * 16;
        const int colre = n < 32 ? n : n + 32, colim = colre + 32;
        u16* bbt = (u16*)(ws + OFF_BBT) + (size_t)(e >> 6) * 2048;
        u16* cmt = (u16*)(ws + OFF_CMT) + (size_t)(e >> 6) * 2048;
        for (int c = 0; c < 16; ++c) {
          const float2 v = make_float2(cr * br[c] - ci * bi[c], cr * bi[c] + ci * br[c]);
          bb[c] = v;
          bbt[colre * 16 + c] = f2bf(v.x); bbt[colim * 16 + c] = f2bf(v.y);
          cmt[c * 128 + colre] = f2bf(IN(17)[((size_t)(e >> 6) * 16 + c) * 64 + n]);
          cmt[c * 128 + colim] = f2bf(-IN(18)[((size_t)(e >> 6) * 16 + c) * 64 + n]);
        }
      } else if (it == n_mod + n_s5 + 1) {
        for (int e = tid; e < 192 * 16; e += 256) {
          const int r = e >> 4, i = e & 15;
          const float inv = exp2f(-(float)i * (13.287712379549449f / 16.f));
          float sn, cs; sincosf((float)(r < 128 ? r : r - 128) * inv, &sn, &cs);
          ((float2*)(ws + OFF_ROPE))[e] = make_float2(cs, sn);
        }
      } else {
        if (tid >= 64 && tid < 72) ((int*)(ws + OFF_CTR))[tid - 64] = 0;
        if (tid < 2) {
          const float* lv = IN(8) + tid * 256;
          float s01 = 0.f, s23 = 0.f;
          for (int i = 0; i < 64; ++i) { s01 += lv[i] * lv[64 + i]; s23 += lv[128 + i] * lv[192 + i]; }
          const float lam_init = 0.8f - 0.6f * expf(-0.3f * (float)tid);
          ((float*)(ws + OFF_LAMV))[tid] = expf(s01) - expf(s23) + lam_init;
        }
      }
    }
    return;
  }
  if (ph == 1) {
    const int n_all = 2 * 5 * 6144 / 256;
    for (int it = bid; it < n_all; it += G) {
      const int e = it * 256 + tid;
      const int L = e / (5 * 6144), v = (e / 6144) % 5, j = e % 6144;
      float a = IN(5)[L * 6144 + j];
      for (int ic = 0; ic < 8; ++ic) a += ((const float*)(ws + OFF_MODP))[((size_t)(L * 8 + ic) * 5 + v) * 6144 + j];
      ((float*)(ws + OFF_MOD))[e] = a;
    }
    return;
  }
  const int L = (ph - 2) / NPH_LAYER, k = (ph - 2) % NPH_LAYER;
  u16* XM = (u16*)(ws + OFF_A);
  u16* WinT = (u16*)(ws + OFF_WIN);

  int* s_next = (int*)(smem + 57336);
#define FETCH_ITEM() ([&]() { __syncthreads(); if (otid() == 0) *s_next = atomicAdd(ctr, 1); __syncthreads(); return *s_next; }())
  if (k == 0) {
    const int n_win = 16 * 141, n_wbr = 4 * 8 * 16, n_wo = 256, n_wg = 128, n_wq = 512, n_sk = 16;
    const int n_w = n_win + n_wbr + n_wo + n_wg + n_wq + n_sk;
    const int n_all = n_w + NP / 4;
    for (int it = bid; it < n_all; it += G) {
      if (it < n_w) {
        int t = it;
        if (t < n_win) { transpose_tile(IN(6) + (size_t)L * DM * NIN, DM, NIN, WinT, t, fsm); continue; }
        t -= n_win;
        if (t < n_wbr) { const int kb = t / 128; transpose_tile(IN(26) + ((size_t)L * 4 + kb) * 512 * DM, 512, DM, (u16*)(ws + OFF_WBR) + (size_t)kb * DM * 512, t % 128, fsm); continue; }
        t -= n_wbr;
        if (t < n_wo) { transpose_tile(IN(27) + (size_t)L * DM * DM, DM, DM, (u16*)(ws + OFF_WO), t, fsm); continue; }
        t -= n_wo;
        if (t < n_wg) { transpose_tile<true>(IN(20) + (size_t)L * 512 * DM, 512, DM, (u16*)(ws + OFF_WGLU), t, fsm); continue; }
        t -= n_wg;
        if (t < n_wq) { transpose_tile(IN(32) + (size_t)L * DM * 2048, DM, 2048, (u16*)(ws + OFF_WQ), t, fsm); continue; }
        t -= n_wq;
        convert_chunk(IN(33) + (size_t)L * 32768, (u16*)(ws + OFF_SK), t);
      } else {
        const int pos = (it - n_w) * 4 + wave;
        const float* md = mod_ptr(p, L, pos);
        ln_mod_wave(h_in_ptr(p, L, pos), md, md + 1024, XM + (size_t)pos * DM, lane);
      }
    }
    return;
  }
  if (k == 1) {
    const int n_all = 264 * 39;
    for (int it = bid; it < n_all; it += G) {
      const int mt = it / 39, j = it % 39;
      f32x16 acc[2][2]; acc_zero(acc);
      if (j < 30) {
        int src; u16* dst; int ldd = 512, dcol;
        if (j < 4) { src = j * 128; dst = (u16*)(ws + OFF_QD); dcol = j * 128; }
        else if (j < 8) { src = 512 + (j - 4) * 128; dst = (u16*)(ws + OFF_KD); dcol = (j - 4) * 128; }
        else if (j < 12) { src = 1536 + (j - 8) * 128; dst = (u16*)(ws + OFF_S5U); dcol = (j - 8) * 128; }
        else if (j < 16) { src = 2048 + (j - 12) * 128; dst = (u16*)(ws + OFF_MQ); dcol = (j - 12) * 128; }
        else if (j < 20) { src = 2560 + (j - 16) * 128; dst = (u16*)(ws + OFF_MK); dcol = (j - 16) * 128; }
        else if (j < 24) { src = 3584 + (j - 20) * 128; dst = (u16*)(ws + OFF_MO); dcol = (j - 20) * 128; }
        else if (j < 28) { src = 4112 + (j - 24) * 128; dst = (u16*)(ws + OFF_QG); dcol = (j - 24) * 128; }
        else if (j == 28) { src = 4624; dst = (u16*)(ws + OFF_KG); dcol = 0; ldd = 128; }
        else { src = 4096; dst = nullptr; dcol = 0; }
        gemm_core(XM + (size_t)mt * 128 * DM, DM, WinT + (size_t)src * DM, DM, DM, acc, usm);
        if (j < 29) {
          EPI_LOOP(acc, { dst[(size_t)(mt * 128 + row) * ldd + dcol + col] = f2bf(val); })
        } else {
          float* mg = (float*)(ws + OFF_MGATE);
          EPI_LOOP(acc, { if (col < 16) mg[(size_t)(mt * 128 + row) * 16 + col] = val; })
        }
      } else {
        const int jj = j - 30;
        int src; u16* dst; int drow;
        if (jj < 4) { src = 1024 + jj * 128; dst = (u16*)(ws + OFF_VDT); drow = jj * 128; }
        else if (jj < 8) { src = 3072 + (jj - 4) * 128; dst = (u16*)(ws + OFF_MVT); drow = (jj - 4) * 128; }
        else { src = 4752; dst = (u16*)(ws + OFF_VGT); drow = 0; }
        gemm_core(WinT + (size_t)src * DM, DM, XM + (size_t)mt * 128 * DM, DM, DM, acc, usm);
        EPI_LOOP(acc, { dst[(size_t)(drow + row) * NP + mt * 128 + col] = f2bf(val); })
      }
    }
    return;
  }
  if (k == 2) {
    const int n_s5 = NB * 2 * 32 * 132 / 4;
    const int n_pp = NP / 4;
    const int n_all = n_pp + n_s5;
    for (int it = bid; it < n_all; it += G) {
      if (it < n_pp) {
        const int pos = it * 4 + wave, b = pos / SB, s = pos - b * SB;
        const bool lat = s < SL;
        const int rrow = s >> 6, rcol = 128 + (s & 63);
        if (lat) {
          const int vec = lane >> 2, half = (lane >> 1) & 1, i0 = (lane & 1) * 8;
          u16* base = (u16*)(ws + (vec < 8 ? OFF_QD : OFF_KD)) + (size_t)pos * 512 + (vec & 7) * 64 + half * 32 + i0;
          const u32x4 a = *(const u32x4*)base, b = *(const u32x4*)(base + 16);
          const float4* tb = (const float4*)((const float2*)(ws + OFF_ROPE) + (half ? rcol : rrow) * 16 + i0);
          const float4 t0 = tb[0], t1 = tb[1], t2 = tb[2], t3 = tb[3];
          const float x1[8] = {bflo(a.x), bfhi(a.x), bflo(a.y), bfhi(a.y), bflo(a.z), bfhi(a.z), bflo(a.w), bfhi(a.w)};
          const float x2[8] = {bflo(b.x), bfhi(b.x), bflo(b.y), bfhi(b.y), bflo(b.z), bfhi(b.z), bflo(b.w), bfhi(b.w)};
          const float cs[8] = {t0.x, t0.z, t1.x, t1.z, t2.x, t2.z, t3.x, t3.z};
          const float sn[8] = {t0.y, t0.w, t1.y, t1.w, t2.y, t2.w, t3.y, t3.w};
          float o1[8], o2[8];
#pragma unroll
          for (int e = 0; e < 8; ++e) { o1[e] = x1[e] * cs[e] - x2[e] * sn[e]; o2[e] = x2[e] * cs[e] + x1[e] * sn[e]; }
          u32x4 w1, w2;
          w1.x = cvtpk(o1[0], o1[1]); w1.y = cvtpk(o1[2], o1[3]); w1.z = cvtpk(o1[4], o1[5]); w1.w = cvtpk(o1[6], o1[7]);
          w2.x = cvtpk(o2[0], o2[1]); w2.y = cvtpk(o2[2], o2[3]); w2.z = cvtpk(o2[4], o2[5]); w2.w = cvtpk(o2[6], o2[7]);
          *(u32x4*)base = w1; *(u32x4*)(base + 16) = w2;
        }
        {
          const int c = lane & 7, hh = c >> 2, ie = (c & 1) * 8;
          const float4* tb = (const float4*)((const float2*)(ws + OFF_ROPE) + (hh ? rcol : rrow) * 16 + ie);
          const float4 t0 = tb[0], t1 = tb[1], t2 = tb[2], t3 = tb[3];
          const float cs[8] = {t0.x, t0.z, t1.x, t1.z, t2.x, t2.z, t3.x, t3.z};
          const float sn[8] = {t0.y, t0.w, t1.y, t1.w, t2.y, t2.w, t3.y, t3.w};
#pragma unroll
          for (int rnd = 0; rnd < 2; ++rnd) {
            const bool act = rnd == 0 || lane < 16;
            const int vec = lane >> 3;
            u16* ptr = rnd == 0 ? (u16*)(ws + OFF_QG) + (size_t)pos * 512 + vec * 64 + c * 8 : (u16*)(ws + OFF_KG) + (size_t)pos * 128 + (vec & 1) * 64 + c * 8;
            const float* gp = (rnd == 0 ? IN(10) : IN(11)) + L * 64 + c * 8;
            const u32x4 a = *(const u32x4*)ptr;
            const float4 g0 = *(const float4*)gp, g1 = *(const float4*)(gp + 4);
            float x[8] = {bflo(a.x), bfhi(a.x), bflo(a.y), bfhi(a.y), bflo(a.z), bfhi(a.z), bflo(a.w), bfhi(a.w)};
            float ss = 0.f;
#pragma unroll
            for (int e = 0; e < 8; ++e) ss += x[e] * x[e];
            ss += SHX(ss, 1); ss += SHX(ss, 2); ss += SHX(ss, 4);
            const float rs = rsqrtf(ss * (1.f / 64.f) + LN_EPS);
            const float gg[8] = {g0.x, g0.y, g0.z, g0.w, g1.x, g1.y, g1.z, g1.w};
            float y[8];
#pragma unroll
            for (int e = 0; e < 8; ++e) y[e] = x[e] * rs * gg[e];
            if (lat) {
#pragma unroll
              for (int e = 0; e < 8; ++e) {
                const float yp = SHX(y[e], 2);
                x[e] = (c & 2) ? (y[e] * cs[e] + yp * sn[e]) : (y[e] * cs[e] - yp * sn[e]);
              }
#pragma unroll
              for (int e = 0; e < 8; ++e) y[e] = x[e];
            }
            if (act) { u32x4 w; w.x = cvtpk(y[0], y[1]); w.y = cvtpk(y[2], y[3]); w.z = cvtpk(y[4], y[5]); w.w = cvtpk(y[6], y[7]); *(u32x4*)ptr = w; }
          }
        }
        {
          const int seg_lo = lat ? 0 : SL, seg_hi = lat ? SL - 1 : SB - 1;
#pragma unroll
          for (int q = 0; q < 4; ++q) {
            const int ch = (lane + 64 * q) * 4;
            const u16* raw = (const u16*)(ws + (ch < 512 ? OFF_MQ : OFF_MK)) + (ch & 511);
            const uint2 xc = *(const uint2*)(raw + (size_t)pos * 512);
            uint2 xm = make_uint2(0, 0), xp = make_uint2(0, 0);
            if (s > seg_lo) xm = *(const uint2*)(raw + (size_t)(pos - 1) * 512);
            if (s < seg_hi) xp = *(const uint2*)(raw + (size_t)(pos + 1) * 512);
            const float* cw = IN(22) + (size_t)L * 3 * 1024 + ch; const float* cb = IN(23) + (size_t)L * 1024 + ch;
            const float4 w0 = *(const float4*)cw, w1 = *(const float4*)(cw + 1024), w2 = *(const float4*)(cw + 2048), bb = *(const float4*)cb;
            float o0 = bb.x + w0.x * bflo(xm.x) + w1.x * bflo(xc.x) + w2.x * bflo(xp.x);
            float o1 = bb.y + w0.y * bfhi(xm.x) + w1.y * bfhi(xc.x) + w2.y * bfhi(xp.x);
            float o2 = bb.z + w0.z * bflo(xm.y) + w1.z * bflo(xc.y) + w2.z * bflo(xp.y);
            float o3 = bb.w + w0.w * bfhi(xm.y) + w1.w * bfhi(xc.y) + w2.w * bfhi(xp.y);
            const float ksc = ch < 512 ? 1.f : 0.08838834764831845f;
            o0 = silu_(o0) * ksc; o1 = silu_(o1) * ksc; o2 = silu_(o2) * ksc; o3 = silu_(o3) * ksc;
            u16* dstc = (u16*)(ws + OFF_A) + (ch < 512 ? (size_t)0 : (size_t)NP * 512) + (size_t)pos * 512 + (ch & 511);
            *(uint2*)dstc = make_uint2(cvtpk(o0, o1), cvtpk(o2, o3));
          }
        }
        if (lane < 16) {
          const float g = ((const float*)(ws + OFF_MGATE))[(size_t)pos * 16 + lane] + IN(24)[L * 16 + lane];
          const int type = lane >> 2, head = lane & 3, dir = type >> 1;
          const int chain = dir * 16 + b * 4 + head;
          if (type & 1) ((float*)(ws + OFF_GF))[(size_t)chain * SB + s] = fminf(g, 0.f) - log1pf(expf(-fabsf(g)));
          else ((float*)(ws + OFF_GI))[(size_t)chain * SB + s] = g;
        }
      } else {
        const int item = (it - n_pp) * 4 + wave;
        const int kk = item % 132, g = (item / 132) & 31, dir = (item / (132 * 32)) & 1, b = item / (132 * 64);
        const int lo = dir == 0 ? (kk < 4 ? SL + 64 * kk : 64 * (kk - 4)) : (kk < 4 ? SL + 192 - 64 * kk : 8128 - 64 * (kk - 4));
        const int r32 = lane & 31, h = lane >> 5;
        const int ldg = (L * 2 + dir) * 32 + g;
        u16* W = usm + wave * 4352;
        __syncthreads();
        const float2 lam = ((const float2*)(ws + OFF_LAMB))[ldg * 64 + lane];
        bf16x8 bfr[4];
#pragma unroll
        for (int j = 0; j < 4; ++j) bfr[j] = *(const bf16x8*)((const u16*)(ws + OFF_BBT) + ((size_t)ldg * 128 + 32 * j + r32) * 16 + 8 * h);
        const int recol = lane < 32 ? lane : lane + 32;
        float hr = 0.f, hi = 0.f;
#pragma unroll 1
        for (int hq = 0; hq < 2; ++hq) {
          const int hh = dir ? 1 - hq : hq;
          s5_bu_half((const u16*)(ws + OFF_S5U) + ((size_t)b * SB + lo + 32 * hh + r32) * 512 + g * 16 + 8 * h, bfr, W, r32, h);
          s5_scan_half<false>(W, dir, recol, lam, hr, hi);
        }
        ((float2*)(ws + OFF_HEND))[(size_t)item * 64 + lane] = make_float2(hr, hi);
      }
    }
    return;
  }
  if (k == 3) {
    const int n_all = 32 + 64 + 1056;
    for (int it = bid; it < n_all; it += G) {
      if (it >= 96) {
        const int i2 = it - 96, chain = i2 / 33, j = i2 % 33, dir = chain >> 4, b = (chain >> 2) & 3, head = chain & 3;
        const int p0 = j == 0 ? SL : (dir == 0 ? 256 * (j - 1) : SL - 256 * j);
        const int r32 = lane & 31, h = lane >> 5;
        u16* Ks = usm;
        float* wS = fsm + 4352;
        float* red = fsm + 4352 + 256;
        __syncthreads();
        {
          const int so = dir == 0 ? tid : 255 - tid;
          const float lf = ((const float*)(ws + OFF_GF))[(size_t)chain * SB + p0 + so];
          const float ig = ((const float*)(ws + OFF_GI))[(size_t)chain * SB + p0 + so];
          float x = lf;
#pragma unroll
          for (int d = 1; d < 64; d <<= 1) { const float y = __int_as_float(__builtin_amdgcn_ds_bpermute(((lane - d) & 63) << 2, __float_as_int(x))); if (lane >= d) x += y; }
          if (lane == 63) red[wave] = x;
          __syncthreads();
          float off = 0.f;
          for (int w = 0; w < wave; ++w) off += red[w];
          const float aloc = ig - (x + off);
          const float mx = wave_max(aloc);
          if (lane == 0) red[4 + wave] = mx;
          __syncthreads();
          const float am = fmaxf(fmaxf(red[4], red[5]), fmaxf(red[6], red[7]));
          wS[so] = __expf(aloc - am);
          if (tid == 0) ((float*)(ws + OFF_ALOC))[i2] = am;
        }
        f32x16 acc[4];
#pragma unroll
        for (int vb = 0; vb < 4; ++vb)
#pragma unroll
          for (int i = 0; i < 16; ++i) acc[vb][i] = 0.f;
        float nacc = 0.f;
        const u16* Kg = (const u16*)(ws + OFF_A) + (size_t)NP * 512 + ((size_t)b * SB + p0) * 512 + head * 128;
        const u16* Vg = (const u16*)(ws + OFF_MVT) + (size_t)(head * 128) * NP + (size_t)b * SB + p0;
#pragma unroll 1
        for (int sub = 0; sub < 4; ++sub) {
          __syncthreads();
          {
            const int kr = tid >> 4, kc = (tid & 15) * 8;
#pragma unroll
            for (int i = 0; i < 4; ++i) *(u32x4*)(Ks + (kr + 16 * i) * 136 + kc) = *(const u32x4*)(Kg + (size_t)(sub * 64 + kr + 16 * i) * 512 + kc);
          }
          __syncthreads();
#pragma unroll
          for (int s16 = 0; s16 < 4; ++s16) {
            float kv[8];
#pragma unroll
            for (int jj = 0; jj < 8; ++jj) {
              const int sl = 16 * s16 + 8 * h + jj;
              kv[jj] = bf2f(Ks[sl * 136 + 32 * wave + r32]) * wS[sub * 64 + sl];
              nacc += kv[jj];
            }
            u32x4 aw; aw.x = cvtpk(kv[0], kv[1]); aw.y = cvtpk(kv[2], kv[3]); aw.z = cvtpk(kv[4], kv[5]); aw.w = cvtpk(kv[6], kv[7]);
            const bf16x8 af = __builtin_bit_cast(bf16x8, aw);
#pragma unroll
            for (int vb = 0; vb < 4; ++vb) {
              const bf16x8 vf = *(const bf16x8*)(Vg + (size_t)(32 * vb + r32) * NP + sub * 64 + 16 * s16 + 8 * h);
              acc[vb] = MFMA32(af, vf, acc[vb]);
            }
          }
        }
        u16* Gd = (u16*)(ws + OFF_GST) + (size_t)i2 * 16384;
#pragma unroll
        for (int vb = 0; vb < 4; ++vb)
#pragma unroll
          for (int g = 0; g < 4; ++g)
            *(uint2*)(Gd + (size_t)(32 * vb + r32) * 128 + 32 * wave + 8 * g + 4 * h) = make_uint2(cvtpk(acc[vb][4 * g], acc[vb][4 * g + 1]), cvtpk(acc[vb][4 * g + 2], acc[vb][4 * g + 3]));
        nacc += SHX(nacc, 32);
        if (h == 0) ((float*)(ws + OFF_NST))[(size_t)i2 * 128 + 32 * wave + r32] = nacc;
      } else if (it < 32) {
        const int chain = it, dir = chain >> 4;
        const float* gi = (const float*)(ws + OFF_GI) + (size_t)chain * SB;
        const float* gf = (const float*)(ws + OFF_GF) + (size_t)chain * SB;
        auto spos = [&](int c) { return dir == 0 ? (c < SC ? SL + c : c - SC) : (SB - 1 - c); };
        float tot = 0.f;
        for (int j = 0; j < 33; ++j) tot += gf[spos(tid * 33 + j)];
        __syncthreads();
        fsm[tid] = tot;
        __syncthreads();
        float pre = 0.f;
        for (int i = 0; i < tid; ++i) pre += fsm[i];
        float F = pre, lm = -INFINITY;
        for (int j = 0; j < 33; ++j) { const int sp = spos(tid * 33 + j); F += gf[sp]; lm = fmaxf(lm, gi[sp] - F); }
        __syncthreads();
        fsm[256 + tid] = lm;
        __syncthreads();
        float pm = 0.f;
        for (int i = 0; i < tid; ++i) pm = fmaxf(pm, fsm[256 + i]);
        F = pre;
        for (int j = 0; j < 33; ++j) {
          const int sp = spos(tid * 33 + j);
          F += gf[sp];
          const float a = gi[sp] - F;
          pm = fmaxf(pm, a);
          ((float*)(ws + OFF_AA))[(size_t)chain * SB + sp] = a;
          ((float*)(ws + OFF_MXA))[(size_t)chain * SB + sp] = pm;
          ((float*)(ws + OFF_MTA))[(size_t)chain * SB + sp] = F + pm;
        }
        __threadfence_block();
        __syncthreads();
        if (tid < 132) {
          const float* aa = (const float*)(ws + OFF_AA) + (size_t)chain * SB + tid * 64;
          float mxv = aa[0];
          for (int j = 1; j < 64; ++j) mxv = fmaxf(mxv, aa[j]);
          ((float*)(ws + OFF_TMAX))[chain * 132 + tid] = mxv;
        }
      } else {
        const int item = (it - 32) * 4 + wave;
        const int g = item & 31, dir = (item >> 5) & 1;
        float2 lam = ((const float2*)(ws + OFF_LAMB))[((L * 2 + dir) * 32 + g) * 64 + lane];
#pragma unroll
        for (int q = 0; q < 6; ++q) lam = make_float2(lam.x * lam.x - lam.y * lam.y, 2.f * lam.x * lam.y);
        float cr = 0.f, ci = 0.f;
        const float2* he = (const float2*)(ws + OFF_HEND) + (size_t)item * 132 * 64 + lane;
        float2* ca = (float2*)(ws + OFF_CARRY) + (size_t)item * 132 * 64 + lane;
#pragma unroll 1
        for (int kk0 = 0; kk0 < 132; kk0 += 12) {
          float2 e[12];
#pragma unroll
          for (int j = 0; j < 12; ++j) e[j] = he[(kk0 + j) * 64];
#pragma unroll
          for (int j = 0; j < 12; ++j) {
            ca[(kk0 + j) * 64] = make_float2(cr, ci);
            const float nr = lam.x * cr - lam.y * ci + e[j].x, ni = lam.x * ci + lam.y * cr + e[j].y;
            cr = nr; ci = ni;
          }
        }
      }
    }
    return;
  }
  if (k == 13) {
    const int n_all = 32 * 9;
    for (int it = bid; it < n_all; it += G) {
      const int chain = it / 9, e = it % 9, dir = chain >> 4;
      const float* gi = (const float*)(ws + OFF_GI) + (size_t)chain * SB;
      const float* aa = (const float*)(ws + OFF_AA) + (size_t)chain * SB;
      float st[8];
#pragma unroll
      for (int i = 0; i < 8; ++i) st[i] = 0.f;
      float B = -INFINITY;
      const bool isn = e == 8;
      if (isn && tid >= 16) continue;
      const size_t eo = isn ? (size_t)tid * 8 : (size_t)e * 2048 + tid * 8;
#pragma unroll 1
      for (int kk0 = 0; kk0 < 33; kk0 += 11) {
        uint4 gm[11]; float4 gn0[11], gn1[11]; float Av[11];
#pragma unroll
        for (int j = 0; j < 11; ++j) {
          const int kk = kk0 + j, ci = chain * 33 + kk;
          if (isn) { const float* g = (const float*)(ws + OFF_NST) + (size_t)ci * 128 + eo; gn0[j] = *(const float4*)g; gn1[j] = *(const float4*)(g + 4); }
          else gm[j] = *(const uint4*)((const u16*)(ws + OFF_GST) + (size_t)ci * 16384 + eo);
          float fst = 0.f;
          if (kk > 0) { const int c = 256 * kk - 1; const int sp = dir == 0 ? (c < SC ? SL + c : c - SC) : (SB - 1 - c); fst = gi[sp] - aa[sp]; }
          Av[j] = ((const float*)(ws + OFF_ALOC))[ci] - fst;
        }
#pragma unroll
        for (int j = 0; j < 11; ++j) {
          const int ci = chain * 33 + kk0 + j;
          if (isn) {
            *(uint4*)((u16*)(ws + OFF_NPST) + (size_t)ci * 128 + eo) = make_uint4(cvtpk(st[0], st[1]), cvtpk(st[2], st[3]), cvtpk(st[4], st[5]), cvtpk(st[6], st[7]));
            if (tid == 0) ((float*)(ws + OFF_BKA))[ci] = B;
          } else {
            *(uint4*)((u16*)(ws + OFF_PST) + (size_t)ci * 16384 + eo) = make_uint4(cvtpk(st[0], st[1]), cvtpk(st[2], st[3]), cvtpk(st[4], st[5]), cvtpk(st[6], st[7]));
          }
          const float A = Av[j];
          const float Bn = fmaxf(B, A);
          const float f1 = __expf(B - Bn), f2 = __expf(A - Bn);
          B = Bn;
          if (isn) {
            const float4 g0 = gn0[j], g1 = gn1[j];
            st[0] = f1 * st[0] + f2 * g0.x; st[1] = f1 * st[1] + f2 * g0.y; st[2] = f1 * st[2] + f2 * g0.z; st[3] = f1 * st[3] + f2 * g0.w;
            st[4] = f1 * st[4] + f2 * g1.x; st[5] = f1 * st[5] + f2 * g1.y; st[6] = f1 * st[6] + f2 * g1.z; st[7] = f1 * st[7] + f2 * g1.w;
          } else {
            const uint4 g = gm[j];
            st[0] = f1 * st[0] + f2 * bflo(g.x); st[1] = f1 * st[1] + f2 * bfhi(g.x); st[2] = f1 * st[2] + f2 * bflo(g.y); st[3] = f1 * st[3] + f2 * bfhi(g.y);
            st[4] = f1 * st[4] + f2 * bflo(g.z); st[5] = f1 * st[5] + f2 * bfhi(g.z); st[6] = f1 * st[6] + f2 * bflo(g.w); st[7] = f1 * st[7] + f2 * bfhi(g.w);
          }
        }
      }
    }
    return;
  }
  if (k == 4) {
    const int n_diff = NB * 4 * 66, n_ml = NB * 4 * 66, n_gqa = NB * 4 * 66, n_s5 = NB * 32 * 132 / 4;
    const int n_all = n_diff + n_ml + n_gqa + n_s5;
    const int r32 = lane & 31, h = lane >> 5;
    int* ctr = (int*)(ws + OFF_CTR) + L;
    int it = FETCH_ITEM();
    for (; it < n_diff; it = FETCH_ITEM()) {
      {
        const int qt = it % 66, head = (it / 66) & 3, b = it / (66 * 4);
        const int s = qt * 128 + wave * 32 + r32, pos = b * SB + s;
        const int kbeg = qt < 64 ? 0 : SL, nkeys = qt < 64 ? SB : SC;
        u16* qd = (u16*)(ws + OFF_QD) + (size_t)pos * 512 + head * 128;
        const float lam = ((const float*)(ws + OFF_LAMV))[L];
        const float lam_init = 0.8f - 0.6f * expf(-0.3f * (float)L);
        f32x16 R[4], O[4]; float lsum;
        attn_pass<128>(qd, (const u16*)(ws + OFF_KD) + ((size_t)b * SB + kbeg) * 512 + head * 128, 512,
                       (const u16*)(ws + OFF_VDT) + (size_t)(head * 128) * NP + (size_t)b * SB + kbeg, nkeys, R, lsum, usm);
        float* stash = (float*)(ws + OFF_STASH) + ((size_t)bid * 256 + otid()) * 64;
        {
          const float il = 1.f / lsum;
#pragma unroll
          for (int vb = 0; vb < 4; ++vb)
#pragma unroll
            for (int i = 0; i < 16; ++i) stash[vb * 16 + i] = R[vb][i] * il;
        }
        attn_pass<128>(qd + 64, (const u16*)(ws + OFF_KD) + ((size_t)b * SB + kbeg) * 512 + head * 128 + 64, 512,
                       (const u16*)(ws + OFF_VDT) + (size_t)(head * 128) * NP + (size_t)b * SB + kbeg, nkeys, O, lsum, usm);
        float ss = 0.f;
        {
          const float il = lam / lsum;
#pragma unroll
          for (int vb = 0; vb < 4; ++vb)
#pragma unroll
            for (int i = 0; i < 16; ++i) { R[vb][i] = stash[vb * 16 + i] - O[vb][i] * il; ss += R[vb][i] * R[vb][i]; }
        }
        ss += SHX(ss, 32);
        const float rn = rsqrtf(ss * (1.f / 128.f) + LN_EPS) * (1.f - lam_init);
        const float* ng = IN(9) + L * 128;
#pragma unroll
        for (int vb = 0; vb < 4; ++vb)
#pragma unroll
          for (int g = 0; g < 4; ++g) {
            const int v0 = vb * 32 + 8 * g + 4 * h;
            const float4 gg = *(const float4*)(ng + v0);
            *(uint2*)(qd + v0) = make_uint2(cvtpk(R[vb][4 * g] * rn * gg.x, R[vb][4 * g + 1] * rn * gg.y), cvtpk(R[vb][4 * g + 2] * rn * gg.z, R[vb][4 * g + 3] * rn * gg.w));
          }
      }
    }
    for (; it < n_diff + n_ml; it = FETCH_ITEM()) {
      {
        const int i2 = it - n_diff;
        const int qt = i2 % 66, head = (i2 / 66) & 3, b = i2 / (66 * 4);
        const int tidm = otid(), lane = tidm & 63, wave = tidm >> 6, r32 = lane & 31, h = lane >> 5;
        const int s = qt * 128 + wave * 32 + r32, pos = b * SB + s;
        bf16x8 qf[8];
        {
          const u16* qrow = (const u16*)(ws + OFF_A) + (size_t)pos * 512 + head * 128;
#pragma unroll
          for (int q = 0; q < 8; ++q) qf[q] = *(const bf16x8*)(qrow + q * 16 + h * 8);
        }
        const u16* Kb = (const u16*)(ws + OFF_A) + (size_t)NP * 512 + (size_t)b * SB * 512 + head * 128;
        const u16* Vt = (const u16*)(ws + OFF_MVT) + (size_t)(head * 128) * NP + (size_t)b * SB;
        f32x16 num[4];
        float* stash = (float*)(ws + OFF_STASH) + ((size_t)bid * 256 + otid()) * 64;
#pragma unroll 1
        for (int dir = 0; dir < 2; ++dir) {
          const int chain = dir * 16 + b * 4 + head;
          const float* Aarr = (const float*)(ws + OFF_AA) + (size_t)chain * SB;
          const float mxq = ((const float*)(ws + OFF_MXA))[(size_t)chain * SB + s] * LOG2E;
          const float mt = ((const float*)(ws + OFF_MTA))[(size_t)chain * SB + s];
          const int cq = chain_idx(dir, s);
          int t0a, t0b, t1a, t1b, kch = 0;
          if (qt < 64) { const int kq = qt >> 1; t0a = 0; t0b = 0; if (dir == 0) { t1a = 4 * kq; t1b = 2 * qt + 2; kch = 1 + kq; } else { t1a = 2 * qt; t1b = 4 * kq + 4; kch = 32 - kq; } }
          else { const int cqt = qt - 64; t1a = 0; t1b = 0; if (dir == 0) { t0a = 0; t0b = 2 * cqt + 2; } else { t0a = 2 * cqt; t0b = 4; } }
          float den = 0.f;
          if (kch > 0) {
            const int ci = chain * 33 + kch;
            const float et = fexp2(fminf(((const float*)(ws + OFF_BKA))[ci] * LOG2E - mxq, 0.f));
            const u16* Pp = (const u16*)(ws + OFF_PST) + (size_t)ci * 16384;
#pragma unroll
            for (int vb = 0; vb < 4; ++vb) {
#pragma unroll
              for (int i = 0; i < 16; ++i) num[vb][i] = 0.f;
#pragma unroll
              for (int q = 0; q < 8; ++q) {
                const bf16x8 pf = *(const bf16x8*)(Pp + (size_t)(32 * vb + r32) * 128 + 16 * q + 8 * h);
                num[vb] = MFMA32(pf, qf[q], num[vb]);
              }
#pragma unroll
              for (int i = 0; i < 16; ++i) num[vb][i] *= et;
              __builtin_amdgcn_sched_barrier(0);
            }
            const u16* np = (const u16*)(ws + OFF_NPST) + (size_t)ci * 128;
            float dp = 0.f;
#pragma unroll
            for (int q = 0; q < 8; ++q) {
              const bf16x8_t qv = __builtin_bit_cast(bf16x8_t, qf[q]);
              const bf16x8_t nv = *(const bf16x8_t*)(np + 16 * q + 8 * h);
              dp = __builtin_amdgcn_fdot2_f32_bf16(__builtin_shufflevector(qv, qv, 0, 1), __builtin_shufflevector(nv, nv, 0, 1), dp, false);
              dp = __builtin_amdgcn_fdot2_f32_bf16(__builtin_shufflevector(qv, qv, 2, 3), __builtin_shufflevector(nv, nv, 2, 3), dp, false);
              dp = __builtin_amdgcn_fdot2_f32_bf16(__builtin_shufflevector(qv, qv, 4, 5), __builtin_shufflevector(nv, nv, 4, 5), dp, false);
              dp = __builtin_amdgcn_fdot2_f32_bf16(__builtin_shufflevector(qv, qv, 6, 7), __builtin_shufflevector(nv, nv, 6, 7), dp, false);
            }
            dp += SHX(dp, 32);
            den = et * dp;
          } else {
#pragma unroll
            for (int vb = 0; vb < 4; ++vb)
#pragma unroll
              for (int i = 0; i < 16; ++i) num[vb][i] = 0.f;
          }
          mlstm_dir(qf, Kb, Vt, Aarr, (const float*)(ws + OFF_TMAX) + chain * 132, dir, t0a, t0b, t1a, t1b, cq, mxq, num, den, smem);
          const float dd = 1.f / fmaxf(fabsf(den), expf(-mt));
          if (dir == 0) {
#pragma unroll
            for (int vb = 0; vb < 4; ++vb)
#pragma unroll
              for (int i = 0; i < 16; ++i) stash[vb * 16 + i] = num[vb][i] * dd;
          } else {
            float ss = 0.f;
#pragma unroll
            for (int vb = 0; vb < 4; ++vb)
#pragma unroll
              for (int i = 0; i < 16; ++i) { num[vb][i] = stash[vb * 16 + i] + num[vb][i] * dd; ss += num[vb][i] * num[vb][i]; }
            ss += SHX(ss, 32);
            const float rn = rsqrtf(ss * (1.f / 128.f) + LN_EPS);
            const float* ng = IN(25) + L * 512 + head * 128;
            u16* mo = (u16*)(ws + OFF_MO) + (size_t)pos * 512 + head * 128;
#pragma unroll
            for (int vb = 0; vb < 4; ++vb)
#pragma unroll
              for (int g = 0; g < 4; ++g) {
                const int v0 = vb * 32 + 8 * g + 4 * h;
                const float4 gg = *(const float4*)(ng + v0);
                const uint2 ov = *(const uint2*)(mo + v0);
                const float y0 = num[vb][4 * g] * rn * gg.x * sigmoidf_(bflo(ov.x)), y1 = num[vb][4 * g + 1] * rn * gg.y * sigmoidf_(bfhi(ov.x));
                const float y2 = num[vb][4 * g + 2] * rn * gg.z * sigmoidf_(bflo(ov.y)), y3 = num[vb][4 * g + 3] * rn * gg.w * sigmoidf_(bfhi(ov.y));
                *(uint2*)(mo + v0) = make_uint2(cvtpk(y0, y1), cvtpk(y2, y3));
              }
          }
        }
      }
    }
    for (; it < n_diff + n_ml + n_gqa; it = FETCH_ITEM()) {
      {
        const int i2 = it - n_diff - n_ml;
        const int qt = i2 % 66, hp = (i2 / 66) & 3, b = i2 / (66 * 4);
        const int kv = hp >> 1;
        const int s = qt * 128 + wave * 32 + r32, pos = b * SB + s;
        const int kbeg = qt < 64 ? 0 : SL, nkeys = qt < 64 ? SB : SC;
        u16* qg = (u16*)(ws + OFF_QG) + (size_t)pos * 512 + hp * 128;
        f32x16 O[2][2]; float lsum[2];
        attn_pass_gqa2(qg, qg + 64, (const u16*)(ws + OFF_KG) + ((size_t)b * SB + kbeg) * 128 + kv * 64, 128,
                       (const u16*)(ws + OFF_VGT) + (size_t)(kv * 64) * NP + (size_t)b * SB + kbeg, nkeys, O, lsum, usm);
#pragma unroll
        for (int hd = 0; hd < 2; ++hd) {
          const float il = 1.f / lsum[hd];
#pragma unroll
          for (int vb = 0; vb < 2; ++vb)
#pragma unroll
            for (int g = 0; g < 4; ++g) {
              const int v0 = vb * 32 + 8 * g + 4 * h;
              *(uint2*)(qg + hd * 64 + v0) = make_uint2(cvtpk(O[hd][vb][4 * g] * il, O[hd][vb][4 * g + 1] * il), cvtpk(O[hd][vb][4 * g + 2] * il, O[hd][vb][4 * g + 3] * il));
            }
        }
      }
    }
    for (; it < n_all; it = FETCH_ITEM()) {
      {
        const int item = (it - n_diff - n_ml - n_gqa) * 4 + wave;
        const int T = item % 132, g = (item / 132) & 31, b = item / (132 * 32);
        u16* W = usm + wave * 4352;
        const int recol = lane < 32 ? lane : lane + 32;
        const size_t pos0 = (size_t)b * SB + 64 * T;
        __syncthreads();
        f32x16 ycc[2];
#pragma unroll
        for (int hh = 0; hh < 2; ++hh)
#pragma unroll
          for (int i = 0; i < 16; ++i) ycc[hh][i] = 0.f;
#pragma unroll 1
        for (int dir = 0; dir < 2; ++dir) {
          const int kk = dir == 0 ? (T < 128 ? T + 4 : T - 128) : (T < 128 ? 4 + 127 - T : 3 - (T - 128));
          const int ldg = (L * 2 + dir) * 32 + g;
          const float2 lam = ((const float2*)(ws + OFF_LAMB))[ldg * 64 + lane];
          bf16x8 bfr[4];
#pragma unroll
          for (int j = 0; j < 4; ++j) bfr[j] = *(const bf16x8*)((const u16*)(ws + OFF_BBT) + ((size_t)ldg * 128 + 32 * j + r32) * 16 + 8 * h);
          const float2 cy = ((const float2*)(ws + OFF_CARRY))[((size_t)((b * 2 + dir) * 32 + g) * 132 + kk) * 64 + lane];
          float hr = cy.x, hi = cy.y;
          const u16* cm = (const u16*)(ws + OFF_CMT) + ((size_t)ldg * 16 + (r32 & 15)) * 128 + 8 * h;
#pragma unroll 1
          for (int hq = 0; hq < 2; ++hq) {
            const int hh = dir ? 1 - hq : hq;
            s5_bu_half((const u16*)(ws + OFF_S5U) + (pos0 + 32 * hh + r32) * 512 + g * 16 + 8 * h, bfr, W, r32, h);
            s5_scan_half<true>(W, dir, recol, lam, hr, hi);
            f32x16 yy;
#pragma unroll
            for (int i = 0; i < 16; ++i) yy[i] = 0.f;
#pragma unroll
            for (int sk = 0; sk < 8; ++sk) {
              const bf16x8 af = *(const bf16x8*)(W + r32 * 136 + 16 * sk + 8 * h);
              const bf16x8 cf = *(const bf16x8*)(cm + 16 * sk);
              yy = MFMA32(af, cf, yy);
            }
            if (hh == 0) { ycc[0] += yy; } else { ycc[1] += yy; }
          }
        }
        if (r32 < 16) {
          const float dsk = IN(19)[L * 512 + g * 16 + r32];
#pragma unroll
          for (int hh = 0; hh < 2; ++hh)
#pragma unroll
            for (int i = 0; i < 16; ++i) {
              const int t = 32 * hh + (i & 3) + 8 * (i >> 2) + 4 * h;
              u16* up = (u16*)(ws + OFF_S5U) + (pos0 + t) * 512 + g * 16 + r32;
              *up = f2bf(gelu_erf(ycc[hh][i] + bf2f(*up) * dsk));
            }
        }
      }
    }
    return;
  }
  if (k == 5) {
    const int n_g = 264 * 8;
    const int n_all = n_g + NP / 4;
    for (int it = bid; it < n_all; it += G) {
      if (it < n_g) {
        const int mt = it / 8, nt = it % 8;
        f32x16 acc[2][2]; acc_zero(acc);
        gemm_core((const u16*)(ws + OFF_S5U) + (size_t)mt * 128 * 512, 512, (const u16*)(ws + OFF_WGLU) + (size_t)nt * 128 * 512, 512, 512, acc, usm);
        {
          u16* YS = (u16*)(ws + OFF_MVT);
          const int e_r = lane & 31, e_h = lane >> 5, e_wm = wave >> 1, e_wn = wave & 1;
          const int ca = nt * 64 + e_wn * 32 + e_r;
          const float ba = IN(21)[L * 1024 + ca], bgt = IN(21)[L * 1024 + 512 + ca];
#pragma unroll
          for (int mi = 0; mi < 2; ++mi)
#pragma unroll
            for (int i = 0; i < 16; ++i) {
              const int row = e_wm * 64 + mi * 32 + (i & 3) + 8 * (i >> 2) + 4 * e_h;
              YS[(size_t)(mt * 128 + row) * 512 + ca] = f2bf((acc[mi][0][i] + ba) * sigmoidf_(acc[mi][1][i] + bgt));
            }
        }
      } else {
        const int pos = (it - n_g) * 4 + wave;
        const float* md = mod_ptr(p, L, pos);
        ln_mod_wave(h_in_ptr(p, L, pos), md, md + 1024, XM + (size_t)pos * DM, lane);
      }
    }
    return;
  }
  if (k == 6) {
    const int n_all = NP * 512 / 2048;
    for (int it = bid; it < n_all; it += G) {
      const size_t e = (size_t)it * 2048 + tid * 8;
      const size_t pos = e >> 9; const int c = (int)(e & 511);
      const u16* z = (const u16*)(ws + OFF_Z) + pos * 1024 + c;
      const uint4 a = *(const uint4*)z, g = *(const uint4*)(z + 512);
      uint4 o;
      o.x = cvtpk(bflo(a.x) * sigmoidf_(bflo(g.x)), bfhi(a.x) * sigmoidf_(bfhi(g.x)));
      o.y = cvtpk(bflo(a.y) * sigmoidf_(bflo(g.y)), bfhi(a.y) * sigmoidf_(bfhi(g.y)));
      o.z = cvtpk(bflo(a.z) * sigmoidf_(bflo(g.z)), bfhi(a.z) * sigmoidf_(bfhi(g.z)));
      o.w = cvtpk(bflo(a.w) * sigmoidf_(bflo(g.w)), bfhi(a.w) * sigmoidf_(bfhi(g.w)));
      *(uint4*)((u16*)(ws + OFF_S5U) + pos * 512 + c) = o;
    }
    return;
  }
  if (k == 7) {
    const int n_g = 264 * 8, n_all = n_g + 1024;
    int* ctr = (int*)(ws + OFF_CTR) + 2 + L * 2;
    for (int it = FETCH_ITEM(); it < n_all; it = FETCH_ITEM()) {
      if (it >= n_g) {
        for (int c = 0; c < 8; ++c) convert_chunk_fp8(IN(34) + (size_t)L * 16384 * 1024, (unsigned char*)(ws + OFF_PU), (size_t)(it - n_g) * 8 + c, 64.f);
        continue;
      }
      const int mt = it / 8, nt = it % 8;
      f32x16 mg[2][2]; acc_zero(mg);
#pragma unroll 1
      for (int kb = 0; kb < 4; ++kb) {
        f32x16 a1[2][2]; acc_zero(a1);
        gemm_core(XM + (size_t)mt * 128 * DM, DM, WinT + (size_t)(4880 + kb * 1024 + nt * 128) * DM, DM, DM, a1, usm);
        const float* bg = IN(7) + L * 4096 + kb * 1024 + nt * 128;
        unsigned gp[2][2][8];
        {
          const int r32 = lane & 31, wn = wave & 1;
#pragma unroll
          for (int ni = 0; ni < 2; ++ni) {
            const float bv = bg[wn * 64 + ni * 32 + r32];
#pragma unroll
            for (int mi = 0; mi < 2; ++mi)
#pragma unroll
              for (int i = 0; i < 8; ++i) gp[mi][ni][i] = cvtpk(sigmoidf_(a1[mi][ni][2 * i] + bv), sigmoidf_(a1[mi][ni][2 * i + 1] + bv));
          }
        }
        f32x16 a2[2][2]; acc_zero(a2);
        const size_t yo = kb == 0 ? OFF_QD : (kb == 1 ? OFF_MVT : (kb == 2 ? OFF_MO : OFF_QG));
        gemm_core((const u16*)(ws + yo) + (size_t)mt * 128 * 512, 512, (const u16*)(ws + OFF_WBR) + ((size_t)kb * DM + nt * 128) * 512, 512, 512, a2, usm);
#pragma unroll
        for (int mi = 0; mi < 2; ++mi)
#pragma unroll
          for (int ni = 0; ni < 2; ++ni)
#pragma unroll
            for (int i = 0; i < 8; ++i) { mg[mi][ni][2 * i] += bflo(gp[mi][ni][i]) * a2[mi][ni][2 * i]; mg[mi][ni][2 * i + 1] += bfhi(gp[mi][ni][i]) * a2[mi][ni][2 * i + 1]; }
      }
      u16* MG = (u16*)(ws + OFF_Z);
      EPI_LOOP(mg, { MG[(size_t)(mt * 128 + row) * 1024 + nt * 128 + col] = f2bf(val); })
    }
    return;
  }
  if (k == 8) {
    const int n_g = 264 * 8, n_cv = 1024;
    const int n_all = n_g + n_cv;
    int* ctr = (int*)(ws + OFF_CTR) + 3 + L * 2;
    for (int it = FETCH_ITEM(); it < n_all; it = FETCH_ITEM()) {
      if (it < n_g) {
        const int mt = it / 8, nt = it % 8;
        f32x16 acc[2][2]; acc_zero(acc);
        gemm_core((const u16*)(ws + OFF_Z) + (size_t)mt * 128 * DM, DM, (const u16*)(ws + OFF_WO) + (size_t)nt * 128 * DM, DM, DM, acc, usm);
        const float* g1 = mod_ptr(p, L, mt * 128) + 2048 + nt * 128;
        const float* hin0 = h_in_ptr(p, L, mt * 128) + nt * 128;
        float* hout0 = h_out_ptr(p, mt * 128) + nt * 128;
        EPI_LOOP(acc, { hout0[(size_t)row * DM + col] = ALPHA * hin0[(size_t)row * DM + col] + g1[col] * val; })
      } else {
        for (int c = 0; c < 8; ++c) convert_chunk_fp8(IN(35) + (size_t)L * 16384 * 1024, (unsigned char*)(ws + OFF_PV), (size_t)(it - n_g) * 8 + c, 8.f);
      }
    }
    return;
  }
  if (k == 9) {
    for (int it = bid; it < NP / 4; it += G) {
      const int pos = it * 4 + wave;
      float* hrow = h_out_ptr(p, pos);
      float4 x[4];
#pragma unroll
      for (int i = 0; i < 4; ++i) x[i] = *(const float4*)(hrow + lane * 4 + 256 * i);
      float sm = 0.f;
#pragma unroll
      for (int i = 0; i < 4; ++i) sm += x[i].x + x[i].y + x[i].z + x[i].w;
      const float mean = wave_sum(sm) * (1.f / DM);
      float vs = 0.f;
#pragma unroll
      for (int i = 0; i < 4; ++i) { x[i].x -= mean; x[i].y -= mean; x[i].z -= mean; x[i].w -= mean; vs += x[i].x * x[i].x + x[i].y * x[i].y + x[i].z * x[i].z + x[i].w * x[i].w; }
      const float rs = rsqrtf(wave_sum(vs) * (1.f / DM) + LN_EPS);
      float sm2 = 0.f;
#pragma unroll
      for (int i = 0; i < 4; ++i) {
        const float4 g = *(const float4*)(IN(28) + L * DM + lane * 4 + 256 * i), be = *(const float4*)(IN(29) + L * DM + lane * 4 + 256 * i);
        x[i] = make_float4(x[i].x * rs * g.x + be.x, x[i].y * rs * g.y + be.y, x[i].z * rs * g.z + be.z, x[i].w * rs * g.w + be.w);
        *(float4*)(hrow + lane * 4 + 256 * i) = x[i];
        sm2 += x[i].x + x[i].y + x[i].z + x[i].w;
      }
      const float mean2 = wave_sum(sm2) * (1.f / DM);
      float vs2 = 0.f;
#pragma unroll
      for (int i = 0; i < 4; ++i) { x[i].x -= mean2; x[i].y -= mean2; x[i].z -= mean2; x[i].w -= mean2; vs2 += x[i].x * x[i].x + x[i].y * x[i].y + x[i].z * x[i].z + x[i].w * x[i].w; }
      const float rs2 = rsqrtf(wave_sum(vs2) * (1.f / DM) + LN_EPS);
      const float* md = mod_ptr(p, L, pos);
#pragma unroll
      for (int i = 0; i < 4; ++i) {
        const float4 sh = *(const float4*)(md + 3072 + lane * 4 + 256 * i), sc = *(const float4*)(md + 4096 + lane * 4 + 256 * i);
        *(uint2*)(XM + (size_t)pos * DM + lane * 4 + 256 * i) = make_uint2(cvtpk(x[i].x * rs2 * (1.f + sc.x) + sh.x, x[i].y * rs2 * (1.f + sc.y) + sh.y), cvtpk(x[i].z * rs2 * (1.f + sc.z) + sh.z, x[i].w * rs2 * (1.f + sc.w) + sh.w));
      }
    }
    return;
  }
  if (k == 10) {
    const int n_all = 264 * 16;
    for (int it = bid; it < n_all; it += G) {
      const int mt = it / 16, nt = it % 16;
      f32x16 acc[2][2]; acc_zero(acc);
      gemm_core(XM + (size_t)mt * 128 * DM, DM, (const u16*)(ws + OFF_WQ) + (size_t)nt * 128 * DM, DM, DM, acc, usm);
      u16* Q2 = (u16*)(ws + OFF_Q2);
      EPI_LOOP(acc, { Q2[(size_t)(mt * 128 + row) * 2048 + nt * 128 + col] = f2bf(val); })
    }
    return;
  }
  if (k == 11) {
    const int n_all = NP / 8;
    float* sc = fsm;
    float* T1v = fsm + 64 * 132;
    float* T2v = T1v + 1024;
    int* T1i = (int*)(T2v + 1024);
    int* T2i = T1i + 1024;
    float* Sv = (float*)(T2i + 1024) + wave * 64;
    int* Si = (int*)((float*)(T2i + 1024) + 256) + wave * 64;
    const int r32 = lane & 31, h = lane >> 5;
    for (int it = bid; it < n_all; it += G) {
      const size_t row0 = (size_t)it * 64;
#pragma unroll 1
      for (int half = 0; half < 2; ++half) {
        f32x16 a[2];
#pragma unroll
        for (int ni = 0; ni < 2; ++ni)
#pragma unroll
          for (int i = 0; i < 16; ++i) a[ni][i] = 0.f;
        const u16* qa = (const u16*)(ws + OFF_Q2) + (row0 + (wave >> 1) * 32 + r32) * 256 + half * 128;
        const u16* kbp = (const u16*)(ws + OFF_SK) + (size_t)half * 16384 + (size_t)((wave & 1) * 64 + r32) * 128;
#pragma unroll
        for (int s = 0; s < 8; ++s) {
          const bf16x8 af = *(const bf16x8*)(qa + s * 16 + h * 8);
#pragma unroll
          for (int ni = 0; ni < 2; ++ni) {
            const bf16x8 bf = *(const bf16x8*)(kbp + (size_t)ni * 32 * 128 + s * 16 + h * 8);
            a[ni] = MFMA32(af, bf, a[ni]);
          }
        }
        __syncthreads();
#pragma unroll
        for (int ni = 0; ni < 2; ++ni)
#pragma unroll
          for (int i = 0; i < 16; ++i) sc[((wave >> 1) * 32 + (i & 3) + 8 * (i >> 2) + 4 * h) * 132 + (wave & 1) * 64 + ni * 32 + r32] = a[ni][i];
        __syncthreads();
        float* Tv = half ? T2v : T1v; int* Ti = half ? T2i : T1i;
#pragma unroll 1
        for (int g = 0; g < 4; ++g) {
          float v0[4], v1[4]; unsigned k0[4], k1[4], T[4];
#pragma unroll
          for (int r = 0; r < 4; ++r) {
            const int row = wave * 16 + g * 4 + r;
            v0[r] = sc[row * 132 + lane]; v1[r] = sc[row * 132 + 64 + lane];
            unsigned u0 = __float_as_uint(v0[r]), u1 = __float_as_uint(v1[r]);
            u0 = (u0 >> 31) ? ~u0 : (u0 | 0x80000000u); u1 = (u1 >> 31) ? ~u1 : (u1 | 0x80000000u);
            k0[r] = (u0 & 0xFFFFFF80u) | (unsigned)(127 - lane); k1[r] = (u1 & 0xFFFFFF80u) | (unsigned)(63 - lane);
            T[r] = 0u;
          }
          bool dn0 = false, dn1 = false, dn2 = false, dn3 = false;
#pragma unroll 1
          for (int bit = 31; bit >= 0; --bit) {
#pragma unroll
            for (int r = 0; r < 4; ++r) {
              bool& dn = r == 0 ? dn0 : (r == 1 ? dn1 : (r == 2 ? dn2 : dn3));
              const unsigned cand = T[r] | (1u << bit);
              const int cnt = __popcll(__ballot(k0[r] >= cand)) + __popcll(__ballot(k1[r] >= cand));
              T[r] = cnt >= 16 ? cand : T[r];
              dn = dn | (cnt == 16);
            }
            if (dn0 && dn1 && dn2 && dn3) break;
          }
#pragma unroll
          for (int r = 0; r < 4; ++r) {
            const int row = wave * 16 + g * 4 + r;
            const bool s0 = k0[r] >= T[r], s1 = k1[r] >= T[r];
            const unsigned long long m0 = __ballot(s0), m1 = __ballot(s1);
            const int p0 = __builtin_amdgcn_mbcnt_hi((unsigned)(m0 >> 32), __builtin_amdgcn_mbcnt_lo((unsigned)m0, 0u));
            const int p1 = __popcll(m0) + __builtin_amdgcn_mbcnt_hi((unsigned)(m1 >> 32), __builtin_amdgcn_mbcnt_lo((unsigned)m1, 0u));
            if (s0) { Tv[row * 16 + p0] = v0[r]; Ti[row * 16 + p0] = lane; }
            if (s1) { Tv[row * 16 + p1] = v1[r]; Ti[row * 16 + p1] = lane + 64; }
          }
        }
      }
#pragma unroll 1
      for (int g = 0; g < 4; ++g) {
        {
          const int rowl = wave * 16 + g * 4 + (lane >> 4), j = lane & 15;
#pragma unroll
          for (int half = 0; half < 2; ++half) {
            float* Tv = half ? T2v : T1v; int* Ti = half ? T2i : T1i;
            const float v = Tv[rowl * 16 + j]; const int vi = Ti[rowl * 16 + j];
            int rank = 0;
#pragma unroll
            for (int i = 0; i < 16; ++i) { const float o = Tv[rowl * 16 + i]; rank += (o > v || (o == v && i < j)) ? 1 : 0; }
            Tv[rowl * 16 + rank] = v; Ti[rowl * 16 + rank] = vi;
          }
        }
        unsigned kk[4], T[4]; float cv[4];
        const int pr = PEER_PAIRS[lane], ia = pr >> 4, ib = pr & 15;
#pragma unroll
        for (int r = 0; r < 4; ++r) {
          const int row = wave * 16 + g * 4 + r;
          cv[r] = T1v[row * 16 + ia] + T2v[row * 16 + ib];
          unsigned u = __float_as_uint(cv[r]); u = (u >> 31) ? ~u : (u | 0x80000000u);
          kk[r] = lane < 50 ? ((u & 0xFFFFFFC0u) | (unsigned)(63 - lane)) : 0u;
          T[r] = 0u;
        }
        bool dn0 = false, dn1 = false, dn2 = false, dn3 = false;
#pragma unroll 1
        for (int bit = 31; bit >= 0; --bit) {
#pragma unroll
          for (int r = 0; r < 4; ++r) {
            bool& dn = r == 0 ? dn0 : (r == 1 ? dn1 : (r == 2 ? dn2 : dn3));
            const unsigned cand = T[r] | (1u << bit);
            const int cnt = __popcll(__ballot(kk[r] >= cand));
            T[r] = cnt >= 16 ? cand : T[r];
            dn = dn | (cnt == 16);
          }
          if (dn0 && dn1 && dn2 && dn3) break;
        }
#pragma unroll
        for (int r = 0; r < 4; ++r) {
          const int row = wave * 16 + g * 4 + r;
          const bool se = kk[r] >= T[r] && T[r] != 0u;
          const unsigned long long me = __ballot(se);
          const int pe = __builtin_amdgcn_mbcnt_hi((unsigned)(me >> 32), __builtin_amdgcn_mbcnt_lo((unsigned)me, 0u));
          if (se) {
            Sv[r * 16 + pe] = cv[r];
            Si[r * 16 + pe] = T1i[row * 16 + ia] * 128 + T2i[row * 16 + ib];
          }
        }
        {
          const float val = Sv[lane]; const int idx = Si[lane];
          float mx = val;
          mx = fmaxf(mx, SHX(mx, 8)); mx = fmaxf(mx, SHX(mx, 4)); mx = fmaxf(mx, SHX(mx, 2)); mx = fmaxf(mx, SHX(mx, 1));
          const float ev = __expf(val - mx);
          float sm = ev;
          sm += SHX(sm, 8); sm += SHX(sm, 4); sm += SHX(sm, 2); sm += SHX(sm, 1);
          const size_t o = (row0 + wave * 16 + g * 4) * 16 + lane;
          ((int*)(ws + OFF_IDX))[o] = idx;
          ((float*)(ws + OFF_GATE))[o] = ev / sm;
        }
      }
      __syncthreads();
    }
    return;
  }
  if (k == 12) {
    const unsigned char* PU = (const unsigned char*)(ws + OFF_PU); const unsigned char* PV = (const unsigned char*)(ws + OFF_PV);
    float* wl = fsm + 8 + wave * 32;
    float* fs = fsm + 8 + 128;
    for (int it = bid; it < NP; it += G) {
      const int pos = it;
      float tf[16];
      {
        const u16* xr = XM + (size_t)pos * DM + lane * 16;
        const u32x4 a = *(const u32x4*)xr, b = *(const u32x4*)(xr + 8);
        tf[0] = bflo(a.x); tf[1] = bfhi(a.x); tf[2] = bflo(a.y); tf[3] = bfhi(a.y); tf[4] = bflo(a.z); tf[5] = bfhi(a.z); tf[6] = bflo(a.w); tf[7] = bfhi(a.w);
        tf[8] = bflo(b.x); tf[9] = bfhi(b.x); tf[10] = bflo(b.y); tf[11] = bfhi(b.y); tf[12] = bflo(b.z); tf[13] = bfhi(b.z); tf[14] = bflo(b.w); tf[15] = bfhi(b.w);
      }
      const size_t r0 = (size_t)pos * 8 + wave * 2;
      const int myidx = lane < 32 ? ((const int*)(ws + OFF_IDX))[r0 * 16 + lane] : 0;
      const float myg = lane < 32 ? ((const float*)(ws + OFF_GATE))[r0 * 16 + lane] : 0.f;
      u32x4 A[8], B[8], C[8];
      const bool b5 = lane & 32, b4 = lane & 16, b3 = lane & 8;
#define LOADROWS(X, TAB, E0)                                                             \
      _Pragma("unroll") for (int j = 0; j < 8; ++j) {                                    \
        const int idx = __builtin_amdgcn_readlane(myidx, (E0) + j);                      \
        X[j] = *(const u32x4*)((TAB) + (size_t)idx * DM + lane * 16);                    \
      }
#define UNPK(X, j, q) const f32x2 q##0 = __builtin_amdgcn_cvt_pk_f32_fp8((int)X[j].x, false), q##1 = __builtin_amdgcn_cvt_pk_f32_fp8((int)X[j].x, true), \
                                  q##2 = __builtin_amdgcn_cvt_pk_f32_fp8((int)X[j].y, false), q##3 = __builtin_amdgcn_cvt_pk_f32_fp8((int)X[j].y, true), \
                                  q##4 = __builtin_amdgcn_cvt_pk_f32_fp8((int)X[j].z, false), q##5 = __builtin_amdgcn_cvt_pk_f32_fp8((int)X[j].z, true), \
                                  q##6 = __builtin_amdgcn_cvt_pk_f32_fp8((int)X[j].w, false), q##7 = __builtin_amdgcn_cvt_pk_f32_fp8((int)X[j].w, true);
#define DOTS(X, E0)                                                                  \
      {                                                                                  \
        float d[8];                                                                      \
        _Pragma("unroll") for (int j = 0; j < 8; ++j) {                                  \
          UNPK(X, j, q)                                                                  \
          d[j] = tf[0] * q0.x + tf[1] * q0.y + tf[2] * q1.x + tf[3] * q1.y + tf[4] * q2.x + tf[5] * q2.y + tf[6] * q3.x + tf[7] * q3.y \
               + tf[8] * q4.x + tf[9] * q4.y + tf[10] * q5.x + tf[11] * q5.y + tf[12] * q6.x + tf[13] * q6.y + tf[14] * q7.x + tf[15] * q7.y; \
          asm volatile("" : "+v"(d[j]));                                                 \
        }                                                                                \
        float d4[4], d2[2], d1;                                                          \
        _Pragma("unroll") for (int i = 0; i < 4; ++i) { const float keep = b5 ? d[i + 4] : d[i], send = b5 ? d[i] : d[i + 4]; d4[i] = keep + SHX(send, 32); } \
        _Pragma("unroll") for (int i = 0; i < 2; ++i) { const float keep = b4 ? d4[i + 2] : d4[i], send = b4 ? d4[i] : d4[i + 2]; d2[i] = keep + SHX(send, 16); } \
        { const float keep = b3 ? d2[1] : d2[0], send = b3 ? d2[0] : d2[1]; d1 = keep + SHX(send, 8); } \
        d1 += SHX(d1, 4); d1 += SHX(d1, 2); d1 += SHX(d1, 1);                            \
        const float gt = __int_as_float(__builtin_amdgcn_ds_bpermute(((E0) + (lane >> 3)) << 2, __float_as_int(myg))); \
        if ((lane & 7) == 0) wl[(E0) + (lane >> 3)] = gt * gelu_erf(d1 * (1.f / 64.f)) * 0.125f; \
        __builtin_amdgcn_sched_barrier(0);                                               \
      }
#define ACCV(X, E0)                                                                      \
      _Pragma("unroll") for (int j = 0; j < 8; ++j) {                                    \
        const float w = wl[(E0) + j];                                                    \
        UNPK(X, j, q)                                                                    \
        ov[0] += w * q0.x; ov[1] += w * q0.y; ov[2] += w * q1.x; ov[3] += w * q1.y; ov[4] += w * q2.x; ov[5] += w * q2.y; ov[6] += w * q3.x; ov[7] += w * q3.y; \
        ov[8] += w * q4.x; ov[9] += w * q4.y; ov[10] += w * q5.x; ov[11] += w * q5.y; ov[12] += w * q6.x; ov[13] += w * q6.y; ov[14] += w * q7.x; ov[15] += w * q7.y; \
        _Pragma("unroll") for (int i = 0; i < 16; ++i) asm volatile("" : "+v"(ov[i]));   \
      }
      __syncthreads();
      LOADROWS(A, PU, 0)
      LOADROWS(B, PU, 8)
      LOADROWS(C, PU, 16)
      DOTS(A, 0)
      LOADROWS(A, PU, 24)
      DOTS(B, 8)
      LOADROWS(B, PV, 0)
      DOTS(C, 16)
      LOADROWS(C, PV, 8)
      DOTS(A, 24)
      LOADROWS(A, PV, 16)
      float ov[16];
#pragma unroll
      for (int i = 0; i < 16; ++i) ov[i] = 0.f;
      ACCV(B, 0)
      __builtin_amdgcn_sched_barrier(0);
      LOADROWS(B, PV, 24)
      ACCV(C, 8)
      __builtin_amdgcn_sched_barrier(0);
      ACCV(A, 16)
      __builtin_amdgcn_sched_barrier(0);
      ACCV(B, 24)
#undef LOADROWS
#undef UNPK
#undef DOTS
#undef ACCV
#pragma unroll
      for (int i = 0; i < 16; ++i) fs[wave * 1024 + lane * 16 + i] = ov[i];
      __syncthreads();
      const int tid2 = otid();
      float f[4];
#pragma unroll
      for (int i = 0; i < 4; ++i) f[i] = fs[tid2 * 4 + i] + fs[1024 + tid2 * 4 + i] + fs[2048 + tid2 * 4 + i] + fs[3072 + tid2 * 4 + i];
      float* hrow = h_out_ptr(p, pos);
      const float4 hm = *(const float4*)(hrow + tid2 * 4);
      const float4 g2 = *(const float4*)(mod_ptr(p, L, pos) + 5120 + tid2 * 4);
      const float x0 = ALPHA * hm.x + g2.x * f[0], x1 = ALPHA * hm.y + g2.y * f[1], x2 = ALPHA * hm.z + g2.z * f[2], x3 = ALPHA * hm.w + g2.w * f[3];
      const float mean = block_sum(x0 + x1 + x2 + x3, fsm) * (1.f / DM);
      const float a = x0 - mean, b = x1 - mean, c = x2 - mean, d = x3 - mean;
      const float var = block_sum(a * a + b * b + c * c + d * d, fsm) * (1.f / DM);
      const float rs = rsqrtf(var + LN_EPS);
      const float4 g = *(const float4*)(IN(30) + L * DM + tid2 * 4), be = *(const float4*)(IN(31) + L * DM + tid2 * 4);
      *(float4*)(hrow + tid2 * 4) = make_float4(a * rs * g.x + be.x, b * rs * g.y + be.y, c * rs * g.z + be.z, d * rs * g.w + be.w);
    }
    return;
  }
}

#if MULTI_LAUNCH
__global__ void __launch_bounds__(256, 2) k_phase(P p, int ph) {
  __shared__ __attribute__((aligned(16))) char smem[57344];
  run_phase(p, ph, smem);
}
#endif

#if !MULTI_LAUNCH
#define XB_TMO      128
#define XB_XCNT(j)  (256  + 64 * (j))
#define XB_XSUB(j)  (1280 + 64 * (j))
#define XB_XGEN(j)  (2304 + 64 * (j))
#define XB_TOP      3328
#define XB_TOPGEN   3392
#define XCD_BAR_WORDS 3456
#define XB_SPIN_CAP (1u << 18)
#define LAS __attribute__((address_space(3)))

__device__ __forceinline__ unsigned xb_ld(unsigned* p)              { return __hip_atomic_load(p, __ATOMIC_RELAXED, __HIP_MEMORY_SCOPE_AGENT); }
__device__ __forceinline__ unsigned xb_add(unsigned* p, unsigned v) { return __hip_atomic_fetch_add(p, v, __ATOMIC_RELAXED, __HIP_MEMORY_SCOPE_AGENT); }
__device__ __forceinline__ unsigned xb_xcc_id() { return (unsigned)__builtin_amdgcn_s_getreg((3 << 11) | 20) & 0xFu; }
#define XB_SPIN(cond, bar) do { unsigned _sp = 0; while (cond) { __builtin_amdgcn_s_sleep(1); \
    if ((++_sp & 255u) == 0u) { if (xb_ld(&(bar)[XB_TMO])) break; if (_sp > XB_SPIN_CAP) { atomicAdd(&(bar)[XB_TMO], 1u); break; } } } } while (0)

struct XcdBarrier {
    unsigned* bar; unsigned x;
    volatile LAS unsigned* st;
};

__device__ __forceinline__ XcdBarrier xcd_barrier_post(unsigned* bar, volatile LAS unsigned* st) {
    XcdBarrier b; b.bar = bar; b.x = xb_xcc_id(); b.st = st;
    if (threadIdx.x == 0) (void)xb_add(&bar[XB_XCNT(b.x)], 1u);
    return b;
}
__device__ __forceinline__ void xcd_barrier_complete(unsigned* bar, unsigned x, unsigned& nloc, unsigned& nx) {
    const unsigned G = gridDim.x * gridDim.y * gridDim.z;
    unsigned sum, cnt, mine, sp = 0u;
    for (;;) {
        sum = 0u; cnt = 0u; mine = 0u;
#pragma unroll
        for (unsigned j = 0; j < 16; ++j) { const unsigned c = xb_ld(&bar[XB_XCNT(j)]); sum += c; cnt += (c > 0u) ? 1u : 0u; mine = (j == x) ? c : mine; }
        if (sum == G) break;
        __builtin_amdgcn_s_sleep(1);
        if ((++sp & 255u) == 0u) { if (xb_ld(&bar[XB_TMO])) break; if (sp > XB_SPIN_CAP) { atomicAdd(&bar[XB_TMO], 1u); break; } }
    }
    nloc = mine > 0u ? mine : 1u; nx = cnt > 0u ? cnt : 1u;
}

__device__ __forceinline__ void xcd_barrier(const XcdBarrier& b) {
    asm volatile("s_waitcnt vmcnt(0)" ::: "memory");
    __syncthreads();
    if (threadIdx.x == 0) {
        unsigned* bar = b.bar;
        __builtin_amdgcn_s_waitcnt(0);
        unsigned nloc = b.st[0], nx = b.st[1];
        if (nloc == 0u) { xcd_barrier_complete(bar, b.x, nloc, nx); b.st[0] = nloc; b.st[1] = nx; }
        const unsigned old = xb_add(&bar[XB_XSUB(b.x)], 1u);
        const unsigned gen = old / nloc;
        if (old + 1u == (gen + 1u) * nloc) {
            __builtin_amdgcn_fence(__ATOMIC_RELEASE, "agent");
            asm volatile("s_waitcnt vmcnt(0)" ::: "memory");
            const unsigned og = xb_add(&bar[XB_TOP], 1u);
            const unsigned tg = og / nx;
            if (og + 1u == (tg + 1u) * nx) xb_add(&bar[XB_TOPGEN], 1u);
            else XB_SPIN(xb_ld(&bar[XB_TOPGEN]) == tg, bar);
            __builtin_amdgcn_fence(__ATOMIC_ACQUIRE, "agent");
            xb_add(&bar[XB_XGEN(b.x)], 1u);
            asm volatile("s_waitcnt vmcnt(0)" ::: "memory");
        } else {
            XB_SPIN(xb_ld(&bar[XB_XGEN(b.x)]) == gen, bar);
            __builtin_amdgcn_fence(__ATOMIC_ACQUIRE, "agent");
            asm volatile("s_waitcnt vmcnt(0)" ::: "memory");
        }
    }
    __syncthreads();
}


__global__ void __launch_bounds__(256, 2) k_mega(P p) {
  __shared__ __attribute__((aligned(16))) char smem[57344];
  cg::grid_group grid = cg::this_grid();
  __shared__ uint4 xb_words;
  if (threadIdx.x == 0) xb_words = make_uint4(0u, 0u, 0u, 0u);
  __syncthreads();
  (void)xcd_barrier_post((unsigned*)(WSP + OFF_BAR), (volatile LAS unsigned*)&xb_words);
#define XBAR() { XcdBarrier xb_; xb_.bar = (unsigned*)(WSP + OFF_BAR); xb_.x = xb_xcc_id(); xb_.st = (volatile LAS unsigned*)&xb_words; xcd_barrier(xb_); }
  run_phase(p, 0, smem); grid.sync();
  run_phase(p, 1, smem); XBAR()
  run_phase(p, 2, smem); XBAR()
  run_phase(p, 3, smem); XBAR()
  run_phase(p, 4, smem); XBAR()
  run_phase(p, 5, smem); XBAR()
  run_phase(p, 15, smem); XBAR()
  run_phase(p, 6, smem); XBAR()
  run_phase(p, 7, smem); XBAR()
  run_phase(p, 9, smem); XBAR()
  run_phase(p, 10, smem); XBAR()
  run_phase(p, 11, smem); XBAR()
  run_phase(p, 12, smem); XBAR()
  run_phase(p, 13, smem); XBAR()
  run_phase(p, 14, smem); XBAR()
  run_phase(p, 16, smem); XBAR()
  run_phase(p, 17, smem); XBAR()
  run_phase(p, 18, smem); XBAR()
  run_phase(p, 19, smem); XBAR()
  run_phase(p, 29, smem); XBAR()
  run_phase(p, 20, smem); XBAR()
  run_phase(p, 21, smem); XBAR()
  run_phase(p, 23, smem); XBAR()
  run_phase(p, 24, smem); XBAR()
  run_phase(p, 25, smem); XBAR()
  run_phase(p, 26, smem); XBAR()
  run_phase(p, 27, smem); XBAR()
  run_phase(p, 28, smem);
#undef XBAR
}
#endif

extern "C" void kernel_launch(void* const* d_in, const int* in_sizes, int n_in, void* d_out, int out_size, void* d_ws, size_t ws_size, hipStream_t stream) {
  if (n_in != 36 || ws_size < WS_END) { fprintf(stderr, "kernel_launch: need 36 inputs and %zu bytes of workspace (got %d, %zu)\n", (size_t)WS_END, n_in, ws_size); return; }
  P p{};
  for (int i = 0; i < 36; ++i) p.in[i] = (const float*)d_in[i];
  p.out = (float*)d_out; p.ws = (char*)d_ws;
#if MULTI_LAUNCH
  for (int ph = 0; ph < NPHASES; ++ph) hipLaunchKernelGGL(k_phase, dim3(512), dim3(256), 0, stream, p, ph);
#else
  static int grid_blocks = 0;
  if (!grid_blocks) {
    int dev = 0, cus = 0, per_cu = 0;
    hipGetDevice(&dev);
    hipDeviceGetAttribute(&cus, hipDeviceAttributeMultiprocessorCount, dev);
    hipOccupancyMaxActiveBlocksPerMultiprocessor(&per_cu, k_mega, 256, 0);
    if (per_cu < 1) per_cu = 1;
    grid_blocks = cus * per_cu;
    if (grid_blocks > 512) grid_blocks = 512;
  }
  hipMemsetAsync((char*)d_ws + OFF_BAR, 0, 16384, stream);
  void* args[] = {&p};
  hipError_t e = hipLaunchCooperativeKernel((void*)k_mega, dim3(grid_blocks), dim3(256), args, 0, stream);
  if (e != hipSuccess) fprintf(stderr, "cooperative launch failed: %s (grid %d)\n", hipGetErrorString(e), grid_blocks);
#endif
}
```

```cpp
#include <hip/hip_runtime.h>
#include <hip/hip_cooperative_groups.h>
#include <cstdio>
namespace cg = cooperative_groups;

#ifndef MULTI_LAUNCH
#define MULTI_LAUNCH 0
#endif

#define DI __device__ __forceinline__
typedef unsigned short u16;
typedef short bf16x8 __attribute__((ext_vector_type(8)));
typedef short s16x4 __attribute__((ext_vector_type(4)));
typedef float f32x16 __attribute__((ext_vector_type(16)));
typedef float f32x2 __attribute__((ext_vector_type(2)));
typedef __bf16 bf16x2_t __attribute__((ext_vector_type(2)));
typedef unsigned u32x4 __attribute__((ext_vector_type(4)));
typedef __bf16 bf16x8_t __attribute__((ext_vector_type(8)));
#define MFMA32(a, b, c) __builtin_amdgcn_mfma_f32_32x32x16_bf16((a), (b), (c), 0, 0, 0)

constexpr int NB = 4, SL = 8192, SC = 256, SB = 8448, NP = NB * SB, DM = 1024, NIN = 8976;
constexpr float LN_EPS = 1e-6f;
constexpr float ALPHA = 1.41421356237f;
constexpr float LOG2E = 1.44269504089f;

constexpr size_t SZ512 = (size_t)NP * 512 * 2;
constexpr size_t OFF_A = 0;
constexpr size_t OFF_QD = OFF_A + 2 * SZ512;
constexpr size_t OFF_KD = OFF_QD + SZ512;
constexpr size_t OFF_VDT = OFF_KD + SZ512;
constexpr size_t OFF_S5U = OFF_VDT + SZ512;
constexpr size_t OFF_MQ = OFF_S5U + SZ512;
constexpr size_t OFF_MK = OFF_MQ + SZ512;
constexpr size_t OFF_MVT = OFF_MK + SZ512;
constexpr size_t OFF_MO = OFF_MVT + SZ512;
constexpr size_t OFF_QG = OFF_MO + SZ512;
constexpr size_t OFF_KG = OFF_QG + SZ512;
constexpr size_t OFF_VGT = OFF_KG + SZ512 / 4;
constexpr size_t OFF_MGATE = OFF_VGT + SZ512 / 4;
constexpr size_t OFF_WIN = OFF_MGATE + (size_t)NP * 16 * 4;
constexpr size_t OFF_WBR = OFF_WIN + (size_t)9088 * 1024 * 2;
constexpr size_t OFF_WO = OFF_WBR + (size_t)4 * 1024 * 512 * 2;
constexpr size_t OFF_WGLU = OFF_WO + (size_t)1024 * 1024 * 2;
constexpr size_t OFF_WQ = OFF_WGLU + (size_t)1024 * 512 * 2;
constexpr size_t OFF_SK = OFF_WQ + (size_t)2048 * 1024 * 2;
constexpr size_t OFF_MODP = OFF_SK + 65536;
constexpr size_t OFF_MOD = OFF_MODP + (size_t)2 * 8 * 5 * 6144 * 4;
constexpr size_t OFF_LAMB = OFF_MOD + (size_t)2 * 5 * 6144 * 4;
constexpr size_t OFF_BBAR = OFF_LAMB + 65536;
constexpr size_t OFF_LAMV = OFF_BBAR + 1048576;
constexpr size_t SZCH = (size_t)32 * SB * 4;
constexpr size_t OFF_GI = OFF_LAMV + 256;
constexpr size_t OFF_GF = OFF_GI + SZCH;
constexpr size_t OFF_AA = OFF_GF + SZCH;
constexpr size_t OFF_MXA = OFF_AA + SZCH;
constexpr size_t OFF_MTA = OFF_MXA + SZCH;
constexpr size_t SZHE = (size_t)NB * 2 * 32 * 132 * 64 * 8;
constexpr size_t OFF_HEND = OFF_MTA + SZCH;
constexpr size_t OFF_CARRY = OFF_HEND + SZHE;
constexpr size_t OFF_HC = OFF_CARRY + SZHE;
constexpr size_t OFF_STASH = OFF_HC + (size_t)1024 * 1024 * 4;
constexpr size_t OFF_PU = OFF_STASH;
constexpr size_t OFF_PV = OFF_STASH + (size_t)16384 * 1024;
constexpr size_t OFF_ROPE = OFF_STASH + (size_t)512 * 64 * 256 * 4;
constexpr size_t OFF_TMAX = OFF_ROPE + 32768;
constexpr size_t OFF_BBT = OFF_TMAX + 32768;
constexpr size_t OFF_CMT = OFF_BBT + 524288;
constexpr size_t OFF_NST = OFF_CMT + 524288;
constexpr size_t OFF_NPST = OFF_NST + (size_t)1056 * 128 * 4;
constexpr size_t OFF_ALOC = OFF_NPST + (size_t)1056 * 128 * 4;
constexpr size_t OFF_BKA = OFF_ALOC + 8192;
constexpr size_t OFF_CTR = OFF_BKA + 8192;
constexpr size_t OFF_BAR = OFF_CTR + 256;
constexpr size_t WS_END = OFF_BAR + 16384;
constexpr size_t OFF_GST = OFF_MQ;
constexpr size_t OFF_PST = OFF_MK;
constexpr size_t OFF_Z = OFF_MQ;

constexpr size_t OFF_Q2 = OFF_S5U;
constexpr size_t OFF_IDX = OFF_MO;
constexpr size_t OFF_GATE = OFF_MO + (size_t)NP * 8 * 16 * 4;

struct P {
  const float* in[36];
  float* out;
  char* ws;
};

typedef const float* const __attribute__((address_space(4)))* kargp_t;
DI kargp_t karg() { kargp_t k = (kargp_t)__builtin_amdgcn_kernarg_segment_ptr(); asm volatile("" : "+s"(k)); return k; }
#define IN(i) (karg()[i])
#define OUTP ((float*)karg()[36])
#define WSP ((char*)karg()[37])
DI int otid() { int t = threadIdx.x; asm volatile("" : "+v"(t)); return t; }
template <int M> DI int shx_i(int v) {
  if constexpr (M < 32) return __builtin_amdgcn_ds_swizzle(v, 0x1f | (M << 10));
  else return __builtin_amdgcn_ds_bpermute(((otid() & 63) ^ M) << 2, v);
}
#define SHX(v, M) __int_as_float(shx_i<M>(__float_as_int(v)))
#define SHXI(v, M) shx_i<M>(v)
DI unsigned cvtpk(float lo, float hi) { f32x2 v = {lo, hi}; bf16x2_t b = __builtin_convertvector(v, bf16x2_t); return __builtin_bit_cast(unsigned, b); }
DI u16 f2bf(float x) { return (u16)(cvtpk(x, 0.f) & 0xffffu); }
DI float bf2f(u16 x) { return __uint_as_float(((unsigned)x) << 16); }
DI float bflo(unsigned u) { return __uint_as_float(u << 16); }
DI float bfhi(unsigned u) { return __uint_as_float(u & 0xffff0000u); }
DI float wave_sum(float v) { v += SHX(v, 32); v += SHX(v, 16); v += SHX(v, 8); v += SHX(v, 4); v += SHX(v, 2); v += SHX(v, 1); return v; }
DI float wave_max(float v) { v = fmaxf(v, SHX(v, 32)); v = fmaxf(v, SHX(v, 16)); v = fmaxf(v, SHX(v, 8)); v = fmaxf(v, SHX(v, 4)); v = fmaxf(v, SHX(v, 2)); v = fmaxf(v, SHX(v, 1)); return v; }
DI float block_sum(float v, float* red) {
  v = wave_sum(v);
  __syncthreads();
  if ((otid() & 63) == 0) red[otid() >> 6] = v;
  __syncthreads();
  return red[0] + red[1] + red[2] + red[3];
}
DI float sigmoidf_(float x) { return __builtin_amdgcn_rcpf(1.f + __expf(-x)); }
DI float gelu_erf(float x) {
  const float z = fabsf(x) * 0.70710678118f;
  const float t = __builtin_amdgcn_rcpf(1.f + 0.3275911f * z);
  const float poly = t * (0.254829592f + t * (-0.284496736f + t * (1.421413741f + t * (-1.453152027f + t * 1.061405429f))));
  const float e = 1.f - poly * __expf(-z * z);
  return 0.5f * x * (1.f + copysignf(e, x));
}
DI float silu_(float x) { return x * __builtin_amdgcn_rcpf(1.f + __expf(-x)); }
DI float fexp2(float x) { return __builtin_amdgcn_exp2f(x); }

DI const float* h_in_ptr(const P& p, int L, int pos) {
  int b = pos / SB, s = pos - b * SB;
  if (L == 0) return s < SL ? IN(0) + ((size_t)b * SL + s) * DM : IN(2) + ((size_t)b * SC + (s - SL)) * DM;
  return s < SL ? OUTP + ((size_t)b * SL + s) * DM : (const float*)(WSP + OFF_HC) + ((size_t)b * SC + (s - SL)) * DM;
}
DI float* h_out_ptr(const P& p, int pos) {
  int b = pos / SB, s = pos - b * SB;
  return s < SL ? OUTP + ((size_t)b * SL + s) * DM : (float*)(WSP + OFF_HC) + ((size_t)b * SC + (s - SL)) * DM;
}
DI const float* mod_ptr(const P& p, int L, int pos) {
  int b = pos / SB, s = pos - b * SB;
  int v = s < SL ? b : 4;
  return (const float*)(WSP + OFF_MOD) + ((size_t)L * 5 + v) * 6144;
}

DI void gemm_core(const u16* __restrict__ A, int lda, const u16* __restrict__ B, int ldb, int K, f32x16 (&acc)[2][2], u16* lds) {
  const int tid = otid(), lane = tid & 63, wave = tid >> 6;
  const int wm = wave >> 1, wn = wave & 1, r32 = lane & 31, h = lane >> 5;
  u16* As = lds; u16* Bs = lds + 128 * 72;
  const int lr = tid >> 3, lc = (tid & 7) * 8;
  u32x4 ra[4], rb[4];
  const int nk = K >> 6;
#pragma unroll
  for (int i = 0; i < 4; ++i) {
    ra[i] = *(const u32x4*)(A + (size_t)(lr + 32 * i) * lda + lc);
    rb[i] = *(const u32x4*)(B + (size_t)(lr + 32 * i) * ldb + lc);
  }
#pragma unroll 1
  for (int kt = 0; kt < nk; ++kt) {
    __syncthreads();
#pragma unroll
    for (int i = 0; i < 4; ++i) {
      *(u32x4*)(As + (lr + 32 * i) * 72 + lc) = ra[i];
      *(u32x4*)(Bs + (lr + 32 * i) * 72 + lc) = rb[i];
    }
    __syncthreads();
    if (kt + 1 < nk) {
#pragma unroll
      for (int i = 0; i < 4; ++i) {
        ra[i] = *(const u32x4*)(A + (size_t)(lr + 32 * i) * lda + (kt + 1) * 64 + lc);
        rb[i] = *(const u32x4*)(B + (size_t)(lr + 32 * i) * ldb + (kt + 1) * 64 + lc);
      }
    }
#pragma unroll
    for (int s = 0; s < 4; ++s) {
      bf16x8 af[2], bfr[2];
#pragma unroll
      for (int mi = 0; mi < 2; ++mi) af[mi] = *(const bf16x8*)(As + (wm * 64 + mi * 32 + r32) * 72 + s * 16 + h * 8);
#pragma unroll
      for (int ni = 0; ni < 2; ++ni) bfr[ni] = *(const bf16x8*)(Bs + (wn * 64 + ni * 32 + r32) * 72 + s * 16 + h * 8);
#pragma unroll
      for (int mi = 0; mi < 2; ++mi)
#pragma unroll
        for (int ni = 0; ni < 2; ++ni) acc[mi][ni] = MFMA32(af[mi], bfr[ni], acc[mi][ni]);
    }
  }
}
DI void acc_zero(f32x16 (&acc)[2][2]) {
#pragma unroll
  for (int mi = 0; mi < 2; ++mi)
#pragma unroll
    for (int ni = 0; ni < 2; ++ni)
#pragma unroll
      for (int i = 0; i < 16; ++i) acc[mi][ni][i] = 0.f;
}
#define EPI_LOOP(acc, BODY)                                                                   \
  {                                                                                           \
    const int e_lane = otid() & 63, e_wave = otid() >> 6;                           \
    const int e_wm = e_wave >> 1, e_wn = e_wave & 1, e_r = e_lane & 31, e_h = e_lane >> 5;    \
    _Pragma("unroll") for (int mi = 0; mi < 2; ++mi) _Pragma("unroll") for (int ni = 0; ni < 2; ++ni) \
    _Pragma("unroll") for (int i = 0; i < 16; ++i) {                                         \
      const int row = e_wm * 64 + mi * 32 + (i & 3) + 8 * (i >> 2) + 4 * e_h;                 \
      const int col = e_wn * 64 + ni * 32 + e_r;                                              \
      const float val = acc[mi][ni][i];                                                       \
      BODY                                                                                    \
    }                                                                                         \
  }

template <bool GLUPERM = false>
DI void transpose_tile(const float* __restrict__ src, int K, int N, u16* __restrict__ dst, int tile, float* lds) {
  const int ntn = (N + 63) >> 6;
  const int k0 = (tile / ntn) * 64, n0 = (tile % ntn) * 64;
  const int tid = otid();
  __syncthreads();
  {
    const int r = tid >> 4, c4 = (tid & 15) * 4;
#pragma unroll
    for (int i = 0; i < 4; ++i) {
      const int kk = r + 16 * i;
      float4 v = make_float4(0.f, 0.f, 0.f, 0.f);
      if (n0 + c4 < N) v = *(const float4*)(src + (size_t)(k0 + kk) * N + n0 + c4);
      lds[kk * 65 + c4 + 0] = v.x; lds[kk * 65 + c4 + 1] = v.y; lds[kk * 65 + c4 + 2] = v.z; lds[kk * 65 + c4 + 3] = v.w;
    }
  }
  __syncthreads();
  {
    const int n = tid >> 2, kc = (tid & 3) * 16;
    if (n0 + n < N) {
      unsigned w[8];
#pragma unroll
      for (int j = 0; j < 8; ++j) w[j] = cvtpk(lds[(kc + 2 * j) * 65 + n], lds[(kc + 2 * j + 1) * 65 + n]);
      int nd = n0 + n;
      if (GLUPERM) { const int ca = nd & 511; nd = (ca >> 6) * 128 + ((ca >> 5) & 1) * 64 + (nd >= 512 ? 32 : 0) + (ca & 31); }
      uint4* d = (uint4*)(dst + (size_t)nd * K + k0 + kc);
      d[0] = make_uint4(w[0], w[1], w[2], w[3]);
      d[1] = make_uint4(w[4], w[5], w[6], w[7]);
    }
  }
}
DI void convert_chunk(const float* __restrict__ src, u16* __restrict__ dst, size_t chunk) {
  const size_t o = chunk * 2048 + (size_t)otid() * 8;
  const float4 a = *(const float4*)(src + o), b = *(const float4*)(src + o + 4);
  *(uint4*)(dst + o) = make_uint4(cvtpk(a.x, a.y), cvtpk(a.z, a.w), cvtpk(b.x, b.y), cvtpk(b.z, b.w));
}

DI void convert_chunk_fp8(const float* __restrict__ src, unsigned char* __restrict__ dst, size_t chunk, float scale) {
  const size_t o = chunk * 2048 + (size_t)otid() * 8;
  const float4 a = *(const float4*)(src + o), b = *(const float4*)(src + o + 4);
  int w0 = 0, w1 = 0;
  w0 = __builtin_amdgcn_cvt_pk_fp8_f32(a.x * scale, a.y * scale, w0, false); w0 = __builtin_amdgcn_cvt_pk_fp8_f32(a.z * scale, a.w * scale, w0, true);
  w1 = __builtin_amdgcn_cvt_pk_fp8_f32(b.x * scale, b.y * scale, w1, false); w1 = __builtin_amdgcn_cvt_pk_fp8_f32(b.z * scale, b.w * scale, w1, true);
  *(uint2*)(dst + o) = make_uint2((unsigned)w0, (unsigned)w1);
}

DI void ln_mod_row(const float* __restrict__ hrow, const float* __restrict__ shift, const float* __restrict__ scale, u16* __restrict__ dst, float* red) {
  const int tid = otid();
  const float4 x = *(const float4*)(hrow + tid * 4);
  const float mean = block_sum(x.x + x.y + x.z + x.w, red) * (1.f / DM);
  const float a = x.x - mean, b = x.y - mean, c = x.z - mean, d = x.w - mean;
  const float var = block_sum(a * a + b * b + c * c + d * d, red) * (1.f / DM);
  const float rs = rsqrtf(var + LN_EPS);
  const float4 sh = *(const float4*)(shift + tid * 4), sc = *(const float4*)(scale + tid * 4);
  const float y0 = a * rs * (1.f + sc.x) + sh.x, y1 = b * rs * (1.f + sc.y) + sh.y, y2 = c * rs * (1.f + sc.z) + sh.z, y3 = d * rs * (1.f + sc.w) + sh.w;
  *(uint2*)(dst + tid * 4) = make_uint2(cvtpk(y0, y1), cvtpk(y2, y3));
}

DI void ln_mod_wave(const float* __restrict__ hrow, const float* __restrict__ shift, const float* __restrict__ scale, u16* __restrict__ dst, int lane) {
  float4 x[4];
#pragma unroll
  for (int i = 0; i < 4; ++i) x[i] = *(const float4*)(hrow + lane * 4 + 256 * i);
  float sm = 0.f;
#pragma unroll
  for (int i = 0; i < 4; ++i) sm += x[i].x + x[i].y + x[i].z + x[i].w;
  const float mean = wave_sum(sm) * (1.f / DM);
  float vs = 0.f;
#pragma unroll
  for (int i = 0; i < 4; ++i) { x[i].x -= mean; x[i].y -= mean; x[i].z -= mean; x[i].w -= mean; vs += x[i].x * x[i].x + x[i].y * x[i].y + x[i].z * x[i].z + x[i].w * x[i].w; }
  const float rs = rsqrtf(wave_sum(vs) * (1.f / DM) + LN_EPS);
#pragma unroll
  for (int i = 0; i < 4; ++i) {
    const float4 sh = *(const float4*)(shift + lane * 4 + 256 * i), sc = *(const float4*)(scale + lane * 4 + 256 * i);
    *(uint2*)(dst + lane * 4 + 256 * i) = make_uint2(cvtpk(x[i].x * rs * (1.f + sc.x) + sh.x, x[i].y * rs * (1.f + sc.y) + sh.y), cvtpk(x[i].z * rs * (1.f + sc.z) + sh.z, x[i].w * rs * (1.f + sc.w) + sh.w));
  }
}

template <int VD>
DI void attn_pass(const u16* __restrict__ qrow, const u16* __restrict__ Kb, int ldk, const u16* __restrict__ Vt, int nkeys, f32x16 (&O)[VD / 32], float& lsum, u16* lds) {
  constexpr int NV = VD / 32;
  const int tid = otid(), lane = tid & 63, r32 = lane & 31, h = lane >> 5;
  u16* Ks = lds; u16* Vs = lds + 64 * 72;
  bf16x8 qf[4];
#pragma unroll
  for (int s = 0; s < 4; ++s) qf[s] = *(const bf16x8*)(qrow + s * 16 + h * 8);
#pragma unroll
  for (int vb = 0; vb < NV; ++vb)
#pragma unroll
    for (int i = 0; i < 16; ++i) O[vb][i] = 0.f;
  float m = -INFINITY, l = 0.f;
  const float c = 0.125f * LOG2E;
  const int lr = tid >> 3, lc = (tid & 7) * 8;
  u32x4 rk[2], rv[NV];
#pragma unroll
  for (int i = 0; i < 2; ++i) rk[i] = *(const u32x4*)(Kb + (size_t)(lr + 32 * i) * ldk + lc);
#pragma unroll
  for (int i = 0; i < NV; ++i) rv[i] = *(const u32x4*)(Vt + (size_t)(lr + 32 * i) * NP + lc);
  for (int k0 = 0; k0 < nkeys; k0 += 64) {
    __syncthreads();
#pragma unroll
    for (int i = 0; i < 2; ++i) *(u32x4*)(Ks + (lr + 32 * i) * 72 + lc) = rk[i];
#pragma unroll
    for (int i = 0; i < NV; ++i) *(u32x4*)(Vs + (lr + 32 * i) * 72 + lc) = rv[i];
    __syncthreads();
    if (k0 + 64 < nkeys) {
#pragma unroll
      for (int i = 0; i < 2; ++i) rk[i] = *(const u32x4*)(Kb + (size_t)(k0 + 64 + lr + 32 * i) * ldk + lc);
#pragma unroll
      for (int i = 0; i < NV; ++i) rv[i] = *(const u32x4*)(Vt + (size_t)(lr + 32 * i) * NP + k0 + 64 + lc);
    }
    f32x16 S[2];
#pragma unroll
    for (int kb = 0; kb < 2; ++kb)
#pragma unroll
      for (int i = 0; i < 16; ++i) S[kb][i] = 0.f;
#pragma unroll
    for (int s = 0; s < 4; ++s)
#pragma unroll
      for (int kb = 0; kb < 2; ++kb) {
        const bf16x8 kf = *(const bf16x8*)(Ks + (kb * 32 + r32) * 72 + s * 16 + h * 8);
        S[kb] = MFMA32(kf, qf[s], S[kb]);
      }
    float mx = S[0][0];
#pragma unroll
    for (int kb = 0; kb < 2; ++kb)
#pragma unroll
      for (int i = 0; i < 16; ++i) mx = fmaxf(mx, S[kb][i]);
    mx = fmaxf(mx, SHX(mx, 32));
    if (__ballot(mx > m + 40.f) != 0ull) {
      const float mn = fmaxf(m, mx);
      const float alpha = fexp2((m - mn) * c);
      m = mn;
      l *= alpha;
#pragma unroll
      for (int vb = 0; vb < NV; ++vb)
#pragma unroll
        for (int i = 0; i < 16; ++i) O[vb][i] *= alpha;
    }
    const float mc = m * c;
    float rs = 0.f;
#pragma unroll
    for (int kb = 0; kb < 2; ++kb)
#pragma unroll
      for (int i = 0; i < 16; ++i) { const float pv = fexp2(S[kb][i] * c - mc); S[kb][i] = pv; rs += pv; }
    l += rs;
#pragma unroll
    for (int kb = 0; kb < 2; ++kb)
#pragma unroll
      for (int s2 = 0; s2 < 2; ++s2) {
        uint4 pw;
        pw.x = cvtpk(S[kb][8 * s2 + 0], S[kb][8 * s2 + 1]); pw.y = cvtpk(S[kb][8 * s2 + 2], S[kb][8 * s2 + 3]);
        pw.z = cvtpk(S[kb][8 * s2 + 4], S[kb][8 * s2 + 5]); pw.w = cvtpk(S[kb][8 * s2 + 6], S[kb][8 * s2 + 7]);
        const bf16x8 pf = __builtin_bit_cast(bf16x8, pw);
#pragma unroll
        for (int vb = 0; vb < NV; ++vb) {
          const u16* vp = Vs + (vb * 32 + r32) * 72 + kb * 32 + s2 * 16 + 4 * h;
          const s16x4 lo = *(const s16x4*)vp, hi = *(const s16x4*)(vp + 8);
          const bf16x8 vf = __builtin_shufflevector(lo, hi, 0, 1, 2, 3, 4, 5, 6, 7);
          O[vb] = MFMA32(vf, pf, O[vb]);
        }
      }
  }
  lsum = l + SHX(l, 32);
}

DI void attn_pass_gqa2(const u16* __restrict__ qrow0, const u16* __restrict__ qrow1, const u16* __restrict__ Kb, int ldk, const u16* __restrict__ Vt, int nkeys,
                       f32x16 (&O)[2][2], float (&lsum)[2], u16* lds) {
  const int tid = otid(), lane = tid & 63, r32 = lane & 31, h = lane >> 5;
  u16* Ks = lds; u16* Vs = lds + 64 * 72;
  bf16x8 qf[2][4];
#pragma unroll
  for (int s = 0; s < 4; ++s) { qf[0][s] = *(const bf16x8*)(qrow0 + s * 16 + h * 8); qf[1][s] = *(const bf16x8*)(qrow1 + s * 16 + h * 8); }
#pragma unroll
  for (int hd = 0; hd < 2; ++hd)
#pragma unroll
    for (int vb = 0; vb < 2; ++vb)
#pragma unroll
      for (int i = 0; i < 16; ++i) O[hd][vb][i] = 0.f;
  float m[2] = {-INFINITY, -INFINITY}, l[2] = {0.f, 0.f};
  const float c = 0.125f * LOG2E;
  const int lr = tid >> 3, lc = (tid & 7) * 8;
  u32x4 rk[2], rv[2];
#pragma unroll
  for (int i = 0; i < 2; ++i) rk[i] = *(const u32x4*)(Kb + (size_t)(lr + 32 * i) * ldk + lc);
#pragma unroll
  for (int i = 0; i < 2; ++i) rv[i] = *(const u32x4*)(Vt + (size_t)(lr + 32 * i) * NP + lc);
  for (int k0 = 0; k0 < nkeys; k0 += 64) {
    __syncthreads();
#pragma unroll
    for (int i = 0; i < 2; ++i) *(u32x4*)(Ks + (lr + 32 * i) * 72 + lc) = rk[i];
#pragma unroll
    for (int i = 0; i < 2; ++i) *(u32x4*)(Vs + (lr + 32 * i) * 72 + lc) = rv[i];
    __syncthreads();
    if (k0 + 64 < nkeys) {
#pragma unroll
      for (int i = 0; i < 2; ++i) rk[i] = *(const u32x4*)(Kb + (size_t)(k0 + 64 + lr + 32 * i) * ldk + lc);
#pragma unroll
      for (int i = 0; i < 2; ++i) rv[i] = *(const u32x4*)(Vt + (size_t)(lr + 32 * i) * NP + k0 + 64 + lc);
    }
#pragma unroll
    for (int hd = 0; hd < 2; ++hd) {
      f32x16 S[2];
#pragma unroll
      for (int kb = 0; kb < 2; ++kb)
#pragma unroll
        for (int i = 0; i < 16; ++i) S[kb][i] = 0.f;
#pragma unroll
      for (int s = 0; s < 4; ++s)
#pragma unroll
        for (int kb = 0; kb < 2; ++kb) {
          const bf16x8 kf = *(const bf16x8*)(Ks + (kb * 32 + r32) * 72 + s * 16 + h * 8);
          S[kb] = MFMA32(kf, qf[hd][s], S[kb]);
        }
      float mx = S[0][0];
#pragma unroll
      for (int kb = 0; kb < 2; ++kb)
#pragma unroll
        for (int i = 0; i < 16; ++i) mx = fmaxf(mx, S[kb][i]);
      mx = fmaxf(mx, SHX(mx, 32));
      if (__ballot(mx > m[hd] + 40.f) != 0ull) {
        const float mn = fmaxf(m[hd], mx);
        const float alpha = fexp2((m[hd] - mn) * c);
        m[hd] = mn;
        l[hd] *= alpha;
#pragma unroll
        for (int vb = 0; vb < 2; ++vb)
#pragma unroll
          for (int i = 0; i < 16; ++i) O[hd][vb][i] *= alpha;
      }
      const float mc = m[hd] * c;
      float rs = 0.f;
#pragma unroll
      for (int kb = 0; kb < 2; ++kb)
#pragma unroll
        for (int i = 0; i < 16; ++i) { const float pv = fexp2(S[kb][i] * c - mc); S[kb][i] = pv; rs += pv; }
      l[hd] += rs;
#pragma unroll
      for (int kb = 0; kb < 2; ++kb)
#pragma unroll
        for (int s2 = 0; s2 < 2; ++s2) {
          uint4 pw;
          pw.x = cvtpk(S[kb][8 * s2 + 0], S[kb][8 * s2 + 1]); pw.y = cvtpk(S[kb][8 * s2 + 2], S[kb][8 * s2 + 3]);
          pw.z = cvtpk(S[kb][8 * s2 + 4], S[kb][8 * s2 + 5]); pw.w = cvtpk(S[kb][8 * s2 + 6], S[kb][8 * s2 + 7]);
          const bf16x8 pf = __builtin_bit_cast(bf16x8, pw);
#pragma unroll
          for (int vb = 0; vb < 2; ++vb) {
            const u16* vp = Vs + (vb * 32 + r32) * 72 + kb * 32 + s2 * 16 + 4 * h;
            const s16x4 lo = *(const s16x4*)vp, hi = *(const s16x4*)(vp + 8);
            const bf16x8 vf = __builtin_shufflevector(lo, hi, 0, 1, 2, 3, 4, 5, 6, 7);
            O[hd][vb] = MFMA32(vf, pf, O[hd][vb]);
          }
        }
    }
  }
  lsum[0] = l[0] + SHX(l[0], 32);
  lsum[1] = l[1] + SHX(l[1], 32);
}

DI int chain_idx(int dir, int s) { return dir == 0 ? (s < SL ? s + SC : s - SL) : (SB - 1 - s); }
DI void mlstm_dir(const bf16x8 (&qf)[8], const u16* __restrict__ Kb, const u16* __restrict__ Vt, const float* __restrict__ Aarr, const float* __restrict__ tmax, int dir,
                  int t0a, int t0b, int t1a, int t1b, int cq, float mxq, f32x16 (&num)[4], float& den_out, char* smem) {
  const int tid = otid(), lane = tid & 63, r32 = lane & 31, h = lane >> 5;
  u16* Ks = (u16*)smem; u16* Vs = (u16*)(smem + 17408); float* As = (float*)(smem + 17408 + 18432);
  float den = 0.f;
  const int n0 = t0b - t0a, nall = n0 + (t1b - t1a);
  const int kr = tid >> 4, kc = (tid & 15) * 8, vr = tid >> 3, vc = (tid & 7) * 8;
  u32x4 rk[4], rv[4]; float ra = 0.f;
  int* tlist = (int*)(smem + 17408 + 18432 + 256);
  float* tred = (float*)(smem + 17408 + 18432 + 256 + 544);
  {
    float mn = fminf(mxq, SHX(mxq, 32));
    mn = fminf(mn, SHX(mn, 16)); mn = fminf(mn, SHX(mn, 8)); mn = fminf(mn, SHX(mn, 4)); mn = fminf(mn, SHX(mn, 2)); mn = fminf(mn, SHX(mn, 1));
    __syncthreads();
    if (lane == 0) tred[tid >> 6] = mn;
    __syncthreads();
    if (tid == 0) {
      const float bmin = fminf(fminf(tred[0], tred[1]), fminf(tred[2], tred[3]));
      int cnt = 0;
      for (int u = 0; u < nall; ++u) {
        const int k0 = u < n0 ? SL + 64 * (t0a + u) : 64 * (t1a + u - n0);
        if (tmax[k0 >> 6] * LOG2E - bmin > -64.f) tlist[1 + cnt++] = k0;
      }
      tlist[0] = cnt;
    }
    __syncthreads();
  }
  const int ntile = tlist[0];
  auto tile_k0 = [&](int u) { return tlist[1 + u]; };
  for (int u = 0; u < ntile; ++u) {
    const int k0 = tile_k0(u);
    __syncthreads();
    {
#pragma unroll
      for (int i = 0; i < 4; ++i) rk[i] = *(const u32x4*)(Kb + (size_t)(k0 + kr + 16 * i) * 512 + kc);
#pragma unroll
      for (int i = 0; i < 4; ++i) rv[i] = *(const u32x4*)(Vt + (size_t)(vr + 32 * i) * NP + k0 + vc);
      if (tid < 64) ra = Aarr[k0 + tid] * LOG2E;
#pragma unroll
      for (int i = 0; i < 4; ++i) *(u32x4*)(Ks + (kr + 16 * i) * 136 + kc) = rk[i];
#pragma unroll
      for (int i = 0; i < 4; ++i) *(u32x4*)(Vs + (vr + 32 * i) * 72 + vc) = rv[i];
      if (tid < 64) As[tid] = ra;
    }
    __syncthreads();
    f32x16 S[2];
#pragma unroll
    for (int kb = 0; kb < 2; ++kb)
#pragma unroll
      for (int i = 0; i < 16; ++i) S[kb][i] = 0.f;
#pragma unroll
    for (int s = 0; s < 8; ++s)
#pragma unroll
      for (int kb = 0; kb < 2; ++kb) {
        const bf16x8 kf = *(const bf16x8*)(Ks + (kb * 32 + r32) * 136 + s * 16 + h * 8);
        S[kb] = MFMA32(kf, qf[s], S[kb]);
      }
#pragma unroll
    for (int kb = 0; kb < 2; ++kb)
#pragma unroll
      for (int g = 0; g < 4; ++g) {
        const float4 a4 = *(const float4*)(As + kb * 32 + 8 * g + 4 * h);
        const float av[4] = {a4.x, a4.y, a4.z, a4.w};
#pragma unroll
        for (int e = 0; e < 4; ++e) {
          const int sk = k0 + kb * 32 + 8 * g + 4 * h + e;
          const int ck = chain_idx(dir, sk);
          const float w = (ck <= cq) ? fexp2(fminf(av[e] - mxq, 0.f)) : 0.f;
          const float pv = S[kb][4 * g + e] * w;
          S[kb][4 * g + e] = pv; den += pv;
        }
      }
#pragma unroll
    for (int kb = 0; kb < 2; ++kb)
#pragma unroll
      for (int s2 = 0; s2 < 2; ++s2) {
        uint4 pw;
        pw.x = cvtpk(S[kb][8 * s2 + 0], S[kb][8 * s2 + 1]); pw.y = cvtpk(S[kb][8 * s2 + 2], S[kb][8 * s2 + 3]);
        pw.z = cvtpk(S[kb][8 * s2 + 4], S[kb][8 * s2 + 5]); pw.w = cvtpk(S[kb][8 * s2 + 6], S[kb][8 * s2 + 7]);
        const bf16x8 pf = __builtin_bit_cast(bf16x8, pw);
#pragma unroll
        for (int vb = 0; vb < 4; ++vb) {
          const u16* vp = Vs + (vb * 32 + r32) * 72 + kb * 32 + s2 * 16 + 4 * h;
          const s16x4 lo = *(const s16x4*)vp, hi = *(const s16x4*)(vp + 8);
          const bf16x8 vf = __builtin_shufflevector(lo, hi, 0, 1, 2, 3, 4, 5, 6, 7);
          num[vb] = MFMA32(vf, pf, num[vb]);
        }
      }
  }
  den_out += den + SHX(den, 32);
}

DI void s5_load_u(const u16* __restrict__ S5U, int b, int lo, int g, float* lu, int lane) {
  const u16* src = S5U + ((size_t)b * SB + lo + lane) * 512 + g * 16;
  const uint4 a = *(const uint4*)src, c = *(const uint4*)(src + 8);
  float* d = lu + lane * 16;
  d[0] = bflo(a.x); d[1] = bfhi(a.x); d[2] = bflo(a.y); d[3] = bfhi(a.y); d[4] = bflo(a.z); d[5] = bfhi(a.z); d[6] = bflo(a.w); d[7] = bfhi(a.w);
  d[8] = bflo(c.x); d[9] = bfhi(c.x); d[10] = bflo(c.y); d[11] = bfhi(c.y); d[12] = bflo(c.z); d[13] = bfhi(c.z); d[14] = bflo(c.w); d[15] = bfhi(c.w);
}

DI void s5_bu_half(const u16* __restrict__ urow, const bf16x8 (&bfr)[4], u16* W, int r32, int h) {
  const bf16x8 af = *(const bf16x8*)urow;
#pragma unroll
  for (int j = 0; j < 4; ++j) {
    f32x16 z;
#pragma unroll
    for (int i = 0; i < 16; ++i) z[i] = 0.f;
    const f32x16 acc = MFMA32(af, bfr[j], z);
#pragma unroll
    for (int i = 0; i < 16; ++i) W[((i & 3) + 8 * (i >> 2) + 4 * h) * 136 + 32 * j + r32] = f2bf(acc[i]);
  }
}
template <bool WB>
DI void s5_scan_half(u16* W, int dir, int recol, float2 lam, float& hr, float& hi) {
#pragma unroll 4
  for (int q = 0; q < 32; ++q) {
    const int t = dir ? 31 - q : q;
    const float br = bf2f(W[t * 136 + recol]), bi = bf2f(W[t * 136 + recol + 32]);
    const float nr = lam.x * hr - lam.y * hi + br, ni = lam.x * hi + lam.y * hr + bi;
    hr = nr; hi = ni;
    if (WB) { W[t * 136 + recol] = f2bf(hr); W[t * 136 + recol + 32] = f2bf(hi); }
  }
}

__device__ const unsigned char PEER_PAIRS[64] = {0, 1, 2, 3, 4, 5, 6, 7, 8, 9, 10, 11, 12, 13, 14, 15, 16, 17, 18, 19, 20, 21, 22, 23, 32, 33, 34, 35, 36, 48, 49, 50, 51, 64, 65, 66, 80, 81, 96, 97, 112, 113, 128, 144, 160, 176, 192, 208, 224, 240, 0, 0, 0, 0, 0, 0, 0, 0, 0, 0, 0, 0, 0, 0};

constexpr int NPH_LAYER = 14;
constexpr int NPHASES = 2 + 2 * NPH_LAYER;

__device__ __forceinline__ void run_phase(const P& p, int ph, char* smem) {
  const int tid = otid(), lane = tid & 63, wave = tid >> 6;
  const int G = gridDim.x, bid = blockIdx.x;
  char* ws = WSP;
  float* fsm = (float*)smem;
  u16* usm = (u16*)smem;

  if (ph == 0) {
    const int n_mod = 2 * 8 * 24, n_s5 = 32, n_all = n_mod + n_s5 + 2;
    for (int it = bid; it < n_all; it += G) {
      if (it < n_mod) {
        const int L = it / 192, ic = (it / 24) % 8, jc = it % 24;
        __syncthreads();
        for (int e = tid; e < 5 * 128; e += 256) {
          const int v = e / 128, i = ic * 128 + (e % 128);
          const float cv = v < 4 ? IN(1)[v * DM + i] : IN(3)[i];
          fsm[e] = silu_(cv);
        }
        __syncthreads();
        const int j = jc * 256 + tid;
        const float* w = IN(4) + ((size_t)L * DM + ic * 128) * 6144 + j;
        float a0 = 0, a1 = 0, a2 = 0, a3 = 0, a4 = 0;
#pragma unroll 8
        for (int i = 0; i < 128; ++i) {
          const float wv = w[(size_t)i * 6144];
          a0 += fsm[i] * wv; a1 += fsm[128 + i] * wv; a2 += fsm[256 + i] * wv; a3 += fsm[384 + i] * wv; a4 += fsm[512 + i] * wv;
        }
        float* o = (float*)(ws + OFF_MODP) + ((size_t)(L * 8 + ic) * 5) * 6144 + j;
        o[0] = a0; o[6144] = a1; o[2 * 6144] = a2; o[3 * 6144] = a3; o[4 * 6144] = a4;
      } else if (it < n_mod + n_s5) {
        const int e = (it - n_mod) * 256 + tid;
        const int n = e & 63, g = (e >> 6) & 31, ld = e >> 11;
        const float dt = expf(IN(14)[ld * 32 + g]);
        const float ar = IN(12)[e], ai = IN(13)[e];
        const float mag = expf(ar * dt);
        float sn, cs; sincosf(ai * dt, &sn, &cs);
        const float lr = mag * cs, li = mag * sn;
        const float dn = ar * ar + ai * ai;
        const float cr = ((lr - 1.f) * ar + li * ai) / dn, ci = (li * ar - (lr - 1.f) * ai) / dn;
        ((float2*)(ws + OFF_LAMB))[e] = make_float2(lr, li);
        float2* bb = (float2*)(ws + OFF_BBAR) + (size_t)e * 16;
        const float* br = IN(15) + (size_t)e * 16; const float* bi = IN(16) + (size_t)e * 16;
        const int colre = n < 32 ? n : n + 32, colim = colre + 32;
        u16* bbt = (u16*)(ws + OFF_BBT) + (size_t)(e >> 6) * 2048;
        u16* cmt = (u16*)(ws + OFF_CMT) + (size_t)(e >> 6) * 2048;
        for (int c = 0; c < 16; ++c) {
          const float2 v = make_float2(cr * br[c] - ci * bi[c], cr * bi[c] + ci * br[c]);
          bb[c] = v;
          bbt[colre * 16 + c] = f2bf(v.x); bbt[colim * 16 + c] = f2bf(v.y);
          cmt[c * 128 + colre] = f2bf(IN(17)[((size_t)(e >> 6) * 16 + c) * 64 + n]);
          cmt[c * 128 + colim] = f2bf(-IN(18)[((size_t)(e >> 6) * 16 + c) * 64 + n]);
        }
      } else if (it == n_mod + n_s5 + 1) {
        for (int e = tid; e < 192 * 16; e += 256) {
          const int r = e >> 4, i = e & 15;
          const float inv = exp2f(-(float)i * (13.287712379549449f / 16.f));
          float sn, cs; sincosf((float)(r < 128 ? r : r - 128) * inv, &sn, &cs);
          ((float2*)(ws + OFF_ROPE))[e] = make_float2(cs, sn);
        }
      } else {
        if (tid >= 64 && tid < 72) ((int*)(ws + OFF_CTR))[tid - 64] = 0;
        if (tid < 2) {
          const float* lv = IN(8) + tid * 256;
          float s01 = 0.f, s23 = 0.f;
          for (int i = 0; i < 64; ++i) { s01 += lv[i] * lv[64 + i]; s23 += lv[128 + i] * lv[192 + i]; }
          const float lam_init = 0.8f - 0.6f * expf(-0.3f * (float)tid);
          ((float*)(ws + OFF_LAMV))[tid] = expf(s01) - expf(s23) + lam_init;
        }
      }
    }
    return;
  }
  if (ph == 1) {
    const int n_all = 2 * 5 * 6144 / 256;
    for (int it = bid; it < n_all; it += G) {
      const int e = it * 256 + tid;
      const int L = e / (5 * 6144), v = (e / 6144) % 5, j = e % 6144;
      float a = IN(5)[L * 6144 + j];
      for (int ic = 0; ic < 8; ++ic) a += ((const float*)(ws + OFF_MODP))[((size_t)(L * 8 + ic) * 5 + v) * 6144 + j];
      ((float*)(ws + OFF_MOD))[e] = a;
    }
    return;
  }
  const int L = (ph - 2) / NPH_LAYER, k = (ph - 2) % NPH_LAYER;
  u16* XM = (u16*)(ws + OFF_A);
  u16* WinT = (u16*)(ws + OFF_WIN);

  int* s_next = (int*)(smem + 57336);
#define FETCH_ITEM() ([&]() { __syncthreads(); if (otid() == 0) *s_next = atomicAdd(ctr, 1); __syncthreads(); return *s_next; }())
  if (k == 0) {
    const int n_win = 16 * 141, n_wbr = 4 * 8 * 16, n_wo = 256, n_wg = 128, n_wq = 512, n_sk = 16;
    const int n_w = n_win + n_wbr + n_wo + n_wg + n_wq + n_sk;
    const int n_all = n_w + NP / 4;
    for (int it = bid; it < n_all; it += G) {
      if (it < n_w) {
        int t = it;
        if (t < n_win) { transpose_tile(IN(6) + (size_t)L * DM * NIN, DM, NIN, WinT, t, fsm); continue; }
        t -= n_win;
        if (t < n_wbr) { const int kb = t / 128; transpose_tile(IN(26) + ((size_t)L * 4 + kb) * 512 * DM, 512, DM, (u16*)(ws + OFF_WBR) + (size_t)kb * DM * 512, t % 128, fsm); continue; }
        t -= n_wbr;
        if (t < n_wo) { transpose_tile(IN(27) + (size_t)L * DM * DM, DM, DM, (u16*)(ws + OFF_WO), t, fsm); continue; }
        t -= n_wo;
        if (t < n_wg) { transpose_tile<true>(IN(20) + (size_t)L * 512 * DM, 512, DM, (u16*)(ws + OFF_WGLU), t, fsm); continue; }
        t -= n_wg;
        if (t < n_wq) { transpose_tile(IN(32) + (size_t)L * DM * 2048, DM, 2048, (u16*)(ws + OFF_WQ), t, fsm); continue; }
        t -= n_wq;
        convert_chunk(IN(33) + (size_t)L * 32768, (u16*)(ws + OFF_SK), t);
      } else {
        const int pos = (it - n_w) * 4 + wave;
        const float* md = mod_ptr(p, L, pos);
        ln_mod_wave(h_in_ptr(p, L, pos), md, md + 1024, XM + (size_t)pos * DM, lane);
      }
    }
    return;
  }
  if (k == 1) {
    const int n_all = 264 * 39;
    for (int it = bid; it < n_all; it += G) {
      const int mt = it / 39, j = it % 39;
      f32x16 acc[2][2]; acc_zero(acc);
      if (j < 30) {
        int src; u16* dst; int ldd = 512, dcol;
        if (j < 4) { src = j * 128; dst = (u16*)(ws + OFF_QD); dcol = j * 128; }
        else if (j < 8) { src = 512 + (j - 4) * 128; dst = (u16*)(ws + OFF_KD); dcol = (j - 4) * 128; }
        else if (j < 12) { src = 1536 + (j - 8) * 128; dst = (u16*)(ws + OFF_S5U); dcol = (j - 8) * 128; }
        else if (j < 16) { src = 2048 + (j - 12) * 128; dst = (u16*)(ws + OFF_MQ); dcol = (j - 12) * 128; }
        else if (j < 20) { src = 2560 + (j - 16) * 128; dst = (u16*)(ws + OFF_MK); dcol = (j - 16) * 128; }
        else if (j < 24) { src = 3584 + (j - 20) * 128; dst = (u16*)(ws + OFF_MO); dcol = (j - 20) * 128; }
        else if (j < 28) { src = 4112 + (j - 24) * 128; dst = (u16*)(ws + OFF_QG); dcol = (j - 24) * 128; }
        else if (j == 28) { src = 4624; dst = (u16*)(ws + OFF_KG); dcol = 0; ldd = 128; }
        else { src = 4096; dst = nullptr; dcol = 0; }
        gemm_core(XM + (size_t)mt * 128 * DM, DM, WinT + (size_t)src * DM, DM, DM, acc, usm);
        if (j < 29) {
          EPI_LOOP(acc, { dst[(size_t)(mt * 128 + row) * ldd + dcol + col] = f2bf(val); })
        } else {
          float* mg = (float*)(ws + OFF_MGATE);
          EPI_LOOP(acc, { if (col < 16) mg[(size_t)(mt * 128 + row) * 16 + col] = val; })
        }
      } else {
        const int jj = j - 30;
        int src; u16* dst; int drow;
        if (jj < 4) { src = 1024 + jj * 128; dst = (u16*)(ws + OFF_VDT); drow = jj * 128; }
        else if (jj < 8) { src = 3072 + (jj - 4) * 128; dst = (u16*)(ws + OFF_MVT); drow = (jj - 4) * 128; }
        else { src = 4752; dst = (u16*)(ws + OFF_VGT); drow = 0; }
        gemm_core(WinT + (size_t)src * DM, DM, XM + (size_t)mt * 128 * DM, DM, DM, acc, usm);
        EPI_LOOP(acc, { dst[(size_t)(drow + row) * NP + mt * 128 + col] = f2bf(val); })
      }
    }
    return;
  }
  if (k == 2) {
    const int n_s5 = NB * 2 * 32 * 132 / 4;
    const int n_pp = NP / 4;
    const int n_all = n_pp + n_s5;
    for (int it = bid; it < n_all; it += G) {
      if (it < n_pp) {
        const int pos = it * 4 + wave, b = pos / SB, s = pos - b * SB;
        const bool lat = s < SL;
        const int rrow = s >> 6, rcol = 128 + (s & 63);
        if (lat) {
          const int vec = lane >> 2, half = (lane >> 1) & 1, i0 = (lane & 1) * 8;
          u16* base = (u16*)(ws + (vec < 8 ? OFF_QD : OFF_KD)) + (size_t)pos * 512 + (vec & 7) * 64 + half * 32 + i0;
          const u32x4 a = *(const u32x4*)base, b = *(const u32x4*)(base + 16);
          const float4* tb = (const float4*)((const float2*)(ws + OFF_ROPE) + (half ? rcol : rrow) * 16 + i0);
          const float4 t0 = tb[0], t1 = tb[1], t2 = tb[2], t3 = tb[3];
          const float x1[8] = {bflo(a.x), bfhi(a.x), bflo(a.y), bfhi(a.y), bflo(a.z), bfhi(a.z), bflo(a.w), bfhi(a.w)};
          const float x2[8] = {bflo(b.x), bfhi(b.x), bflo(b.y), bfhi(b.y), bflo(b.z), bfhi(b.z), bflo(b.w), bfhi(b.w)};
          const float cs[8] = {t0.x, t0.z, t1.x, t1.z, t2.x, t2.z, t3.x, t3.z};
          const float sn[8] = {t0.y, t0.w, t1.y, t1.w, t2.y, t2.w, t3.y, t3.w};
          float o1[8], o2[8];
#pragma unroll
          for (int e = 0; e < 8; ++e) { o1[e] = x1[e] * cs[e] - x2[e] * sn[e]; o2[e] = x2[e] * cs[e] + x1[e] * sn[e]; }
          u32x4 w1, w2;
          w1.x = cvtpk(o1[0], o1[1]); w1.y = cvtpk(o1[2], o1[3]); w1.z = cvtpk(o1[4], o1[5]); w1.w = cvtpk(o1[6], o1[7]);
          w2.x = cvtpk(o2[0], o2[1]); w2.y = cvtpk(o2[2], o2[3]); w2.z = cvtpk(o2[4], o2[5]); w2.w = cvtpk(o2[6], o2[7]);
          *(u32x4*)base = w1; *(u32x4*)(base + 16) = w2;
        }
        {
          const int c = lane & 7, hh = c >> 2, ie = (c & 1) * 8;
          const float4* tb = (const float4*)((const float2*)(ws + OFF_ROPE) + (hh ? rcol : rrow) * 16 + ie);
          const float4 t0 = tb[0], t1 = tb[1], t2 = tb[2], t3 = tb[3];
          const float cs[8] = {t0.x, t0.z, t1.x, t1.z, t2.x, t2.z, t3.x, t3.z};
          const float sn[8] = {t0.y, t0.w, t1.y, t1.w, t2.y, t2.w, t3.y, t3.w};
#pragma unroll
          for (int rnd = 0; rnd < 2; ++rnd) {
            const bool act = rnd == 0 || lane < 16;
            const int vec = lane >> 3;
            u16* ptr = rnd == 0 ? (u16*)(ws + OFF_QG) + (size_t)pos * 512 + vec * 64 + c * 8 : (u16*)(ws + OFF_KG) + (size_t)pos * 128 + (vec & 1) * 64 + c * 8;
            const float* gp = (rnd == 0 ? IN(10) : IN(11)) + L * 64 + c * 8;
            const u32x4 a = *(const u32x4*)ptr;
            const float4 g0 = *(const float4*)gp, g1 = *(const float4*)(gp + 4);
            float x[8] = {bflo(a.x), bfhi(a.x), bflo(a.y), bfhi(a.y), bflo(a.z), bfhi(a.z), bflo(a.w), bfhi(a.w)};
            float ss = 0.f;
#pragma unroll
            for (int e = 0; e < 8; ++e) ss += x[e] * x[e];
            ss += SHX(ss, 1); ss += SHX(ss, 2); ss += SHX(ss, 4);
            const float rs = rsqrtf(ss * (1.f / 64.f) + LN_EPS);
            const float gg[8] = {g0.x, g0.y, g0.z, g0.w, g1.x, g1.y, g1.z, g1.w};
            float y[8];
#pragma unroll
            for (int e = 0; e < 8; ++e) y[e] = x[e] * rs * gg[e];
            if (lat) {
#pragma unroll
              for (int e = 0; e < 8; ++e) {
                const float yp = SHX(y[e], 2);
                x[e] = (c & 2) ? (y[e] * cs[e] + yp * sn[e]) : (y[e] * cs[e] - yp * sn[e]);
              }
#pragma unroll
              for (int e = 0; e < 8; ++e) y[e] = x[e];
            }
            if (act) { u32x4 w; w.x = cvtpk(y[0], y[1]); w.y = cvtpk(y[2], y[3]); w.z = cvtpk(y[4], y[5]); w.w = cvtpk(y[6], y[7]); *(u32x4*)ptr = w; }
          }
        }
        {
          const int seg_lo = lat ? 0 : SL, seg_hi = lat ? SL - 1 : SB - 1;
#pragma unroll
          for (int q = 0; q < 4; ++q) {
            const int ch = (lane + 64 * q) * 4;
            const u16* raw = (const u16*)(ws + (ch < 512 ? OFF_MQ : OFF_MK)) + (ch & 511);
            const uint2 xc = *(const uint2*)(raw + (size_t)pos * 512);
            uint2 xm = make_uint2(0, 0), xp = make_uint2(0, 0);
            if (s > seg_lo) xm = *(const uint2*)(raw + (size_t)(pos - 1) * 512);
            if (s < seg_hi) xp = *(const uint2*)(raw + (size_t)(pos + 1) * 512);
            const float* cw = IN(22) + (size_t)L * 3 * 1024 + ch; const float* cb = IN(23) + (size_t)L * 1024 + ch;
            const float4 w0 = *(const float4*)cw, w1 = *(const float4*)(cw + 1024), w2 = *(const float4*)(cw + 2048), bb = *(const float4*)cb;
            float o0 = bb.x + w0.x * bflo(xm.x) + w1.x * bflo(xc.x) + w2.x * bflo(xp.x);
            float o1 = bb.y + w0.y * bfhi(xm.x) + w1.y * bfhi(xc.x) + w2.y * bfhi(xp.x);
            float o2 = bb.z + w0.z * bflo(xm.y) + w1.z * bflo(xc.y) + w2.z * bflo(xp.y);
            float o3 = bb.w + w0.w * bfhi(xm.y) + w1.w * bfhi(xc.y) + w2.w * bfhi(xp.y);
            const float ksc = ch < 512 ? 1.f : 0.08838834764831845f;
            o0 = silu_(o0) * ksc; o1 = silu_(o1) * ksc; o2 = silu_(o2) * ksc; o3 = silu_(o3) * ksc;
            u16* dstc = (u16*)(ws + OFF_A) + (ch < 512 ? (size_t)0 : (size_t)NP * 512) + (size_t)pos * 512 + (ch & 511);
            *(uint2*)dstc = make_uint2(cvtpk(o0, o1), cvtpk(o2, o3));
          }
        }
        if (lane < 16) {
          const float g = ((const float*)(ws + OFF_MGATE))[(size_t)pos * 16 + lane] + IN(24)[L * 16 + lane];
          const int type = lane >> 2, head = lane & 3, dir = type >> 1;
          const int chain = dir * 16 + b * 4 + head;
          if (type & 1) ((float*)(ws + OFF_GF))[(size_t)chain * SB + s] = fminf(g, 0.f) - log1pf(expf(-fabsf(g)));
          else ((float*)(ws + OFF_GI))[(size_t)chain * SB + s] = g;
        }
      } else {
        const int item = (it - n_pp) * 4 + wave;
        const int kk = item % 132, g = (item / 132) & 31, dir = (item / (132 * 32)) & 1, b = item / (132 * 64);
        const int lo = dir == 0 ? (kk < 4 ? SL + 64 * kk : 64 * (kk - 4)) : (kk < 4 ? SL + 192 - 64 * kk : 8128 - 64 * (kk - 4));
        const int r32 = lane & 31, h = lane >> 5;
        const int ldg = (L * 2 + dir) * 32 + g;
        u16* W = usm + wave * 4352;
        __syncthreads();
        const float2 lam = ((const float2*)(ws + OFF_LAMB))[ldg * 64 + lane];
        bf16x8 bfr[4];
#pragma unroll
        for (int j = 0; j < 4; ++j) bfr[j] = *(const bf16x8*)((const u16*)(ws + OFF_BBT) + ((size_t)ldg * 128 + 32 * j + r32) * 16 + 8 * h);
        const int recol = lane < 32 ? lane : lane + 32;
        float hr = 0.f, hi = 0.f;
#pragma unroll 1
        for (int hq = 0; hq < 2; ++hq) {
          const int hh = dir ? 1 - hq : hq;
          s5_bu_half((const u16*)(ws + OFF_S5U) + ((size_t)b * SB + lo + 32 * hh + r32) * 512 + g * 16 + 8 * h, bfr, W, r32, h);
          s5_scan_half<false>(W, dir, recol, lam, hr, hi);
        }
        ((float2*)(ws + OFF_HEND))[(size_t)item * 64 + lane] = make_float2(hr, hi);
      }
    }
    return;
  }
  if (k == 3) {
    const int n_all = 32 + 64 + 1056;
    for (int it = bid; it < n_all; it += G) {
      if (it >= 96) {
        const int i2 = it - 96, chain = i2 / 33, j = i2 % 33, dir = chain >> 4, b = (chain >> 2) & 3, head = chain & 3;
        const int p0 = j == 0 ? SL : (dir == 0 ? 256 * (j - 1) : SL - 256 * j);
        const int r32 = lane & 31, h = lane >> 5;
        u16* Ks = usm;
        float* wS = fsm + 4352;
        float* red = fsm + 4352 + 256;
        __syncthreads();
        {
          const int so = dir == 0 ? tid : 255 - tid;
          const float lf = ((const float*)(ws + OFF_GF))[(size_t)chain * SB + p0 + so];
          const float ig = ((const float*)(ws + OFF_GI))[(size_t)chain * SB + p0 + so];
          float x = lf;
#pragma unroll
          for (int d = 1; d < 64; d <<= 1) { const float y = __int_as_float(__builtin_amdgcn_ds_bpermute(((lane - d) & 63) << 2, __float_as_int(x))); if (lane >= d) x += y; }
          if (lane == 63) red[wave] = x;
          __syncthreads();
          float off = 0.f;
          for (int w = 0; w < wave; ++w) off += red[w];
          const float aloc = ig - (x + off);
          const float mx = wave_max(aloc);
          if (lane == 0) red[4 + wave] = mx;
          __syncthreads();
          const float am = fmaxf(fmaxf(red[4], red[5]), fmaxf(red[6], red[7]));
          wS[so] = __expf(aloc - am);
          if (tid == 0) ((float*)(ws + OFF_ALOC))[i2] = am;
        }
        f32x16 acc[4];
#pragma unroll
        for (int vb = 0; vb < 4; ++vb)
#pragma unroll
          for (int i = 0; i < 16; ++i) acc[vb][i] = 0.f;
        float nacc = 0.f;
        const u16* Kg = (const u16*)(ws + OFF_A) + (size_t)NP * 512 + ((size_t)b * SB + p0) * 512 + head * 128;
        const u16* Vg = (const u16*)(ws + OFF_MVT) + (size_t)(head * 128) * NP + (size_t)b * SB + p0;
#pragma unroll 1
        for (int sub = 0; sub < 4; ++sub) {
          __syncthreads();
          {
            const int kr = tid >> 4, kc = (tid & 15) * 8;
#pragma unroll
            for (int i = 0; i < 4; ++i) *(u32x4*)(Ks + (kr + 16 * i) * 136 + kc) = *(const u32x4*)(Kg + (size_t)(sub * 64 + kr + 16 * i) * 512 + kc);
          }
          __syncthreads();
#pragma unroll
          for (int s16 = 0; s16 < 4; ++s16) {
            float kv[8];
#pragma unroll
            for (int jj = 0; jj < 8; ++jj) {
              const int sl = 16 * s16 + 8 * h + jj;
              kv[jj] = bf2f(Ks[sl * 136 + 32 * wave + r32]) * wS[sub * 64 + sl];
              nacc += kv[jj];
            }
            u32x4 aw; aw.x = cvtpk(kv[0], kv[1]); aw.y = cvtpk(kv[2], kv[3]); aw.z = cvtpk(kv[4], kv[5]); aw.w = cvtpk(kv[6], kv[7]);
            const bf16x8 af = __builtin_bit_cast(bf16x8, aw);
#pragma unroll
            for (int vb = 0; vb < 4; ++vb) {
              const bf16x8 vf = *(const bf16x8*)(Vg + (size_t)(32 * vb + r32) * NP + sub * 64 + 16 * s16 + 8 * h);
              acc[vb] = MFMA32(af, vf, acc[vb]);
            }
          }
        }
        u16* Gd = (u16*)(ws + OFF_GST) + (size_t)i2 * 16384;
#pragma unroll
        for (int vb = 0; vb < 4; ++vb)
#pragma unroll
          for (int g = 0; g < 4; ++g)
            *(uint2*)(Gd + (size_t)(32 * vb + r32) * 128 + 32 * wave + 8 * g + 4 * h) = make_uint2(cvtpk(acc[vb][4 * g], acc[vb][4 * g + 1]), cvtpk(acc[vb][4 * g + 2], acc[vb][4 * g + 3]));
        nacc += SHX(nacc, 32);
        if (h == 0) ((float*)(ws + OFF_NST))[(size_t)i2 * 128 + 32 * wave + r32] = nacc;
      } else if (it < 32) {
        const int chain = it, dir = chain >> 4;
        const float* gi = (const float*)(ws + OFF_GI) + (size_t)chain * SB;
        const float* gf = (const float*)(ws + OFF_GF) + (size_t)chain * SB;
        auto spos = [&](int c) { return dir == 0 ? (c < SC ? SL + c : c - SC) : (SB - 1 - c); };
        float tot = 0.f;
        for (int j = 0; j < 33; ++j) tot += gf[spos(tid * 33 + j)];
        __syncthreads();
        fsm[tid] = tot;
        __syncthreads();
        float pre = 0.f;
        for (int i = 0; i < tid; ++i) pre += fsm[i];
        float F = pre, lm = -INFINITY;
        for (int j = 0; j < 33; ++j) { const int sp = spos(tid * 33 + j); F += gf[sp]; lm = fmaxf(lm, gi[sp] - F); }
        __syncthreads();
        fsm[256 + tid] = lm;
        __syncthreads();
        float pm = 0.f;
        for (int i = 0; i < tid; ++i) pm = fmaxf(pm, fsm[256 + i]);
        F = pre;
        for (int j = 0; j < 33; ++j) {
          const int sp = spos(tid * 33 + j);
          F += gf[sp];
          const float a = gi[sp] - F;
          pm = fmaxf(pm, a);
          ((float*)(ws + OFF_AA))[(size_t)chain * SB + sp] = a;
          ((float*)(ws + OFF_MXA))[(size_t)chain * SB + sp] = pm;
          ((float*)(ws + OFF_MTA))[(size_t)chain * SB + sp] = F + pm;
        }
        __threadfence_block();
        __syncthreads();
        if (tid < 132) {
          const float* aa = (const float*)(ws + OFF_AA) + (size_t)chain * SB + tid * 64;
          float mxv = aa[0];
          for (int j = 1; j < 64; ++j) mxv = fmaxf(mxv, aa[j]);
          ((float*)(ws + OFF_TMAX))[chain * 132 + tid] = mxv;
        }
      } else {
        const int item = (it - 32) * 4 + wave;
        const int g = item & 31, dir = (item >> 5) & 1;
        float2 lam = ((const float2*)(ws + OFF_LAMB))[((L * 2 + dir) * 32 + g) * 64 + lane];
#pragma unroll
        for (int q = 0; q < 6; ++q) lam = make_float2(lam.x * lam.x - lam.y * lam.y, 2.f * lam.x * lam.y);
        float cr = 0.f, ci = 0.f;
        const float2* he = (const float2*)(ws + OFF_HEND) + (size_t)item * 132 * 64 + lane;
        float2* ca = (float2*)(ws + OFF_CARRY) + (size_t)item * 132 * 64 + lane;
#pragma unroll 1
        for (int kk0 = 0; kk0 < 132; kk0 += 12) {
          float2 e[12];
#pragma unroll
          for (int j = 0; j < 12; ++j) e[j] = he[(kk0 + j) * 64];
#pragma unroll
          for (int j = 0; j < 12; ++j) {
            ca[(kk0 + j) * 64] = make_float2(cr, ci);
            const float nr = lam.x * cr - lam.y * ci + e[j].x, ni = lam.x * ci + lam.y * cr + e[j].y;
            cr = nr; ci = ni;
          }
        }
      }
    }
    return;
  }
  if (k == 13) {
    const int n_all = 32 * 9;
    for (int it = bid; it < n_all; it += G) {
      const int chain = it / 9, e = it % 9, dir = chain >> 4;
      const float* gi = (const float*)(ws + OFF_GI) + (size_t)chain * SB;
      const float* aa = (const float*)(ws + OFF_AA) + (size_t)chain * SB;
      float st[8];
#pragma unroll
      for (int i = 0; i < 8; ++i) st[i] = 0.f;
      float B = -INFINITY;
      const bool isn = e == 8;
      if (isn && tid >= 16) continue;
      const size_t eo = isn ? (size_t)tid * 8 : (size_t)e * 2048 + tid * 8;
#pragma unroll 1
      for (int kk0 = 0; kk0 < 33; kk0 += 11) {
        uint4 gm[11]; float4 gn0[11], gn1[11]; float Av[11];
#pragma unroll
        for (int j = 0; j < 11; ++j) {
          const int kk = kk0 + j, ci = chain * 33 + kk;
          if (isn) { const float* g = (const float*)(ws + OFF_NST) + (size_t)ci * 128 + eo; gn0[j] = *(const float4*)g; gn1[j] = *(const float4*)(g + 4); }
          else gm[j] = *(const uint4*)((const u16*)(ws + OFF_GST) + (size_t)ci * 16384 + eo);
          float fst = 0.f;
          if (kk > 0) { const int c = 256 * kk - 1; const int sp = dir == 0 ? (c < SC ? SL + c : c - SC) : (SB - 1 - c); fst = gi[sp] - aa[sp]; }
          Av[j] = ((const float*)(ws + OFF_ALOC))[ci] - fst;
        }
#pragma unroll
        for (int j = 0; j < 11; ++j) {
          const int ci = chain * 33 + kk0 + j;
          if (isn) {
            *(uint4*)((u16*)(ws + OFF_NPST) + (size_t)ci * 128 + eo) = make_uint4(cvtpk(st[0], st[1]), cvtpk(st[2], st[3]), cvtpk(st[4], st[5]), cvtpk(st[6], st[7]));
            if (tid == 0) ((float*)(ws + OFF_BKA))[ci] = B;
          } else {
            *(uint4*)((u16*)(ws + OFF_PST) + (size_t)ci * 16384 + eo) = make_uint4(cvtpk(st[0], st[1]), cvtpk(st[2], st[3]), cvtpk(st[4], st[5]), cvtpk(st[6], st[7]));
          }
          const float A = Av[j];
          const float Bn = fmaxf(B, A);
          const float f1 = __expf(B - Bn), f2 = __expf(A - Bn);
          B = Bn;
          if (isn) {
            const float4 g0 = gn0[j], g1 = gn1[j];
            st[0] = f1 * st[0] + f2 * g0.x; st[1] = f1 * st[1] + f2 * g0.y; st[2] = f1 * st[2] + f2 * g0.z; st[3] = f1 * st[3] + f2 * g0.w;
            st[4] = f1 * st[4] + f2 * g1.x; st[5] = f1 * st[5] + f2 * g1.y; st[6] = f1 * st[6] + f2 * g1.z; st[7] = f1 * st[7] + f2 * g1.w;
          } else {
            const uint4 g = gm[j];
            st[0] = f1 * st[0] + f2 * bflo(g.x); st[1] = f1 * st[1] + f2 * bfhi(g.x); st[2] = f1 * st[2] + f2 * bflo(g.y); st[3] = f1 * st[3] + f2 * bfhi(g.y);
            st[4] = f1 * st[4] + f2 * bflo(g.z); st[5] = f1 * st[5] + f2 * bfhi(g.z); st[6] = f1 * st[6] + f2 * bflo(g.w); st[7] = f1 * st[7] + f2 * bfhi(g.w);
          }
        }
      }
    }
    return;
  }
  if (k == 4) {
    const int n_diff = NB * 4 * 66, n_ml = NB * 4 * 66, n_gqa = NB * 4 * 66, n_s5 = NB * 32 * 132 / 4;
    const int n_all = n_diff + n_ml + n_gqa + n_s5;
    const int r32 = lane & 31, h = lane >> 5;
    int* ctr = (int*)(ws + OFF_CTR) + L;
    int it = FETCH_ITEM();
    for (; it < n_diff; it = FETCH_ITEM()) {
      {
        const int qt = it % 66, head = (it / 66) & 3, b = it / (66 * 4);
        const int s = qt * 128 + wave * 32 + r32, pos = b * SB + s;
        const int kbeg = qt < 64 ? 0 : SL, nkeys = qt < 64 ? SB : SC;
        u16* qd = (u16*)(ws + OFF_QD) + (size_t)pos * 512 + head * 128;
        const float lam = ((const float*)(ws + OFF_LAMV))[L];
        const float lam_init = 0.8f - 0.6f * expf(-0.3f * (float)L);
        f32x16 R[4], O[4]; float lsum;
        attn_pass<128>(qd, (const u16*)(ws + OFF_KD) + ((size_t)b * SB + kbeg) * 512 + head * 128, 512,
                       (const u16*)(ws + OFF_VDT) + (size_t)(head * 128) * NP + (size_t)b * SB + kbeg, nkeys, R, lsum, usm);
        float* stash = (float*)(ws + OFF_STASH) + ((size_t)bid * 256 + otid()) * 64;
        {
          const float il = 1.f / lsum;
#pragma unroll
          for (int vb = 0; vb < 4; ++vb)
#pragma unroll
            for (int i = 0; i < 16; ++i) stash[vb * 16 + i] = R[vb][i] * il;
        }
        attn_pass<128>(qd + 64, (const u16*)(ws + OFF_KD) + ((size_t)b * SB + kbeg) * 512 + head * 128 + 64, 512,
                       (const u16*)(ws + OFF_VDT) + (size_t)(head * 128) * NP + (size_t)b * SB + kbeg, nkeys, O, lsum, usm);
        float ss = 0.f;
        {
          const float il = lam / lsum;
#pragma unroll
          for (int vb = 0; vb < 4; ++vb)
#pragma unroll
            for (int i = 0; i < 16; ++i) { R[vb][i] = stash[vb * 16 + i] - O[vb][i] * il; ss += R[vb][i] * R[vb][i]; }
        }
        ss += SHX(ss, 32);
        const float rn = rsqrtf(ss * (1.f / 128.f) + LN_EPS) * (1.f - lam_init);
        const float* ng = IN(9) + L * 128;
#pragma unroll
        for (int vb = 0; vb < 4; ++vb)
#pragma unroll
          for (int g = 0; g < 4; ++g) {
            const int v0 = vb * 32 + 8 * g + 4 * h;
            const float4 gg = *(const float4*)(ng + v0);
            *(uint2*)(qd + v0) = make_uint2(cvtpk(R[vb][4 * g] * rn * gg.x, R[vb][4 * g + 1] * rn * gg.y), cvtpk(R[vb][4 * g + 2] * rn * gg.z, R[vb][4 * g + 3] * rn * gg.w));
          }
      }
    }
    for (; it < n_diff + n_ml; it = FETCH_ITEM()) {
      {
        const int i2 = it - n_diff;
        const int qt = i2 % 66, head = (i2 / 66) & 3, b = i2 / (66 * 4);
        const int tidm = otid(), lane = tidm & 63, wave = tidm >> 6, r32 = lane & 31, h = lane >> 5;
        const int s = qt * 128 + wave * 32 + r32, pos = b * SB + s;
        bf16x8 qf[8];
        {
          const u16* qrow = (const u16*)(ws + OFF_A) + (size_t)pos * 512 + head * 128;
#pragma unroll
          for (int q = 0; q < 8; ++q) qf[q] = *(const bf16x8*)(qrow + q * 16 + h * 8);
        }
        const u16* Kb = (const u16*)(ws + OFF_A) + (size_t)NP * 512 + (size_t)b * SB * 512 + head * 128;
        const u16* Vt = (const u16*)(ws + OFF_MVT) + (size_t)(head * 128) * NP + (size_t)b * SB;
        f32x16 num[4];
        float* stash = (float*)(ws + OFF_STASH) + ((size_t)bid * 256 + otid()) * 64;
#pragma unroll 1
        for (int dir = 0; dir < 2; ++dir) {
          const int chain = dir * 16 + b * 4 + head;
          const float* Aarr = (const float*)(ws + OFF_AA) + (size_t)chain * SB;
          const float mxq = ((const float*)(ws + OFF_MXA))[(size_t)chain * SB + s] * LOG2E;
          const float mt = ((const float*)(ws + OFF_MTA))[(size_t)chain * SB + s];
          const int cq = chain_idx(dir, s);
          int t0a, t0b, t1a, t1b, kch = 0;
          if (qt < 64) { const int kq = qt >> 1; t0a = 0; t0b = 0; if (dir == 0) { t1a = 4 * kq; t1b = 2 * qt + 2; kch = 1 + kq; } else { t1a = 2 * qt; t1b = 4 * kq + 4; kch = 32 - kq; } }
          else { const int cqt = qt - 64; t1a = 0; t1b = 0; if (dir == 0) { t0a = 0; t0b = 2 * cqt + 2; } else { t0a = 2 * cqt; t0b = 4; } }
          float den = 0.f;
          if (kch > 0) {
            const int ci = chain * 33 + kch;
            const float et = fexp2(fminf(((const float*)(ws + OFF_BKA))[ci] * LOG2E - mxq, 0.f));
            const u16* Pp = (const u16*)(ws + OFF_PST) + (size_t)ci * 16384;
#pragma unroll
            for (int vb = 0; vb < 4; ++vb) {
#pragma unroll
              for (int i = 0; i < 16; ++i) num[vb][i] = 0.f;
#pragma unroll
              for (int q = 0; q < 8; ++q) {
                const bf16x8 pf = *(const bf16x8*)(Pp + (size_t)(32 * vb + r32) * 128 + 16 * q + 8 * h);
                num[vb] = MFMA32(pf, qf[q], num[vb]);
              }
#pragma unroll
              for (int i = 0; i < 16; ++i) num[vb][i] *= et;
              __builtin_amdgcn_sched_barrier(0);
            }
            const u16* np = (const u16*)(ws + OFF_NPST) + (size_t)ci * 128;
            float dp = 0.f;
#pragma unroll
            for (int q = 0; q < 8; ++q) {
              const bf16x8_t qv = __builtin_bit_cast(bf16x8_t, qf[q]);
              const bf16x8_t nv = *(const bf16x8_t*)(np + 16 * q + 8 * h);
              dp = __builtin_amdgcn_fdot2_f32_bf16(__builtin_shufflevector(qv, qv, 0, 1), __builtin_shufflevector(nv, nv, 0, 1), dp, false);
              dp = __builtin_amdgcn_fdot2_f32_bf16(__builtin_shufflevector(qv, qv, 2, 3), __builtin_shufflevector(nv, nv, 2, 3), dp, false);
              dp = __builtin_amdgcn_fdot2_f32_bf16(__builtin_shufflevector(qv, qv, 4, 5), __builtin_shufflevector(nv, nv, 4, 5), dp, false);
              dp = __builtin_amdgcn_fdot2_f32_bf16(__builtin_shufflevector(qv, qv, 6, 7), __builtin_shufflevector(nv, nv, 6, 7), dp, false);
            }
            dp += SHX(dp, 32);
            den = et * dp;
          } else {
#pragma unroll
            for (int vb = 0; vb < 4; ++vb)
#pragma unroll
              for (int i = 0; i < 16; ++i) num[vb][i] = 0.f;
          }
          mlstm_dir(qf, Kb, Vt, Aarr, (const float*)(ws + OFF_TMAX) + chain * 132, dir, t0a, t0b, t1a, t1b, cq, mxq, num, den, smem);
          const float dd = 1.f / fmaxf(fabsf(den), expf(-mt));
          if (dir == 0) {
#pragma unroll
            for (int vb = 0; vb < 4; ++vb)
#pragma unroll
              for (int i = 0; i < 16; ++i) stash[vb * 16 + i] = num[vb][i] * dd;
          } else {
            float ss = 0.f;
#pragma unroll
            for (int vb = 0; vb < 4; ++vb)
#pragma unroll
              for (int i = 0; i < 16; ++i) { num[vb][i] = stash[vb * 16 + i] + num[vb][i] * dd; ss += num[vb][i] * num[vb][i]; }
            ss += SHX(ss, 32);
            const float rn = rsqrtf(ss * (1.f / 128.f) + LN_EPS);
            const float* ng = IN(25) + L * 512 + head * 128;
            u16* mo = (u16*)(ws + OFF_MO) + (size_t)pos * 512 + head * 128;
#pragma unroll
            for (int vb = 0; vb < 4; ++vb)
#pragma unroll
              for (int g = 0; g < 4; ++g) {
                const int v0 = vb * 32 + 8 * g + 4 * h;
                const float4 gg = *(const float4*)(ng + v0);
                const uint2 ov = *(const uint2*)(mo + v0);
                const float y0 = num[vb][4 * g] * rn * gg.x * sigmoidf_(bflo(ov.x)), y1 = num[vb][4 * g + 1] * rn * gg.y * sigmoidf_(bfhi(ov.x));
                const float y2 = num[vb][4 * g + 2] * rn * gg.z * sigmoidf_(bflo(ov.y)), y3 = num[vb][4 * g + 3] * rn * gg.w * sigmoidf_(bfhi(ov.y));
                *(uint2*)(mo + v0) = make_uint2(cvtpk(y0, y1), cvtpk(y2, y3));
              }
          }
        }
      }
    }
    for (; it < n_diff + n_ml + n_gqa; it = FETCH_ITEM()) {
      {
        const int i2 = it - n_diff - n_ml;
        const int qt = i2 % 66, hp = (i2 / 66) & 3, b = i2 / (66 * 4);
        const int kv = hp >> 1;
        const int s = qt * 128 + wave * 32 + r32, pos = b * SB + s;
        const int kbeg = qt < 64 ? 0 : SL, nkeys = qt < 64 ? SB : SC;
        u16* qg = (u16*)(ws + OFF_QG) + (size_t)pos * 512 + hp * 128;
        f32x16 O[2][2]; float lsum[2];
        attn_pass_gqa2(qg, qg + 64, (const u16*)(ws + OFF_KG) + ((size_t)b * SB + kbeg) * 128 + kv * 64, 128,
                       (const u16*)(ws + OFF_VGT) + (size_t)(kv * 64) * NP + (size_t)b * SB + kbeg, nkeys, O, lsum, usm);
#pragma unroll
        for (int hd = 0; hd < 2; ++hd) {
          const float il = 1.f / lsum[hd];
#pragma unroll
          for (int vb = 0; vb < 2; ++vb)
#pragma unroll
            for (int g = 0; g < 4; ++g) {
              const int v0 = vb * 32 + 8 * g + 4 * h;
              *(uint2*)(qg + hd * 64 + v0) = make_uint2(cvtpk(O[hd][vb][4 * g] * il, O[hd][vb][4 * g + 1] * il), cvtpk(O[hd][vb][4 * g + 2] * il, O[hd][vb][4 * g + 3] * il));
            }
        }
      }
    }
    for (; it < n_all; it = FETCH_ITEM()) {
      {
        const int item = (it - n_diff - n_ml - n_gqa) * 4 + wave;
        const int T = item % 132, g = (item / 132) & 31, b = item / (132 * 32);
        u16* W = usm + wave * 4352;
        const int recol = lane < 32 ? lane : lane + 32;
        const size_t pos0 = (size_t)b * SB + 64 * T;
        __syncthreads();
        f32x16 ycc[2];
#pragma unroll
        for (int hh = 0; hh < 2; ++hh)
#pragma unroll
          for (int i = 0; i < 16; ++i) ycc[hh][i] = 0.f;
#pragma unroll 1
        for (int dir = 0; dir < 2; ++dir) {
          const int kk = dir == 0 ? (T < 128 ? T + 4 : T - 128) : (T < 128 ? 4 + 127 - T : 3 - (T - 128));
          const int ldg = (L * 2 + dir) * 32 + g;
          const float2 lam = ((const float2*)(ws + OFF_LAMB))[ldg * 64 + lane];
          bf16x8 bfr[4];
#pragma unroll
          for (int j = 0; j < 4; ++j) bfr[j] = *(const bf16x8*)((const u16*)(ws + OFF_BBT) + ((size_t)ldg * 128 + 32 * j + r32) * 16 + 8 * h);
          const float2 cy = ((const float2*)(ws + OFF_CARRY))[((size_t)((b * 2 + dir) * 32 + g) * 132 + kk) * 64 + lane];
          float hr = cy.x, hi = cy.y;
          const u16* cm = (const u16*)(ws + OFF_CMT) + ((size_t)ldg * 16 + (r32 & 15)) * 128 + 8 * h;
#pragma unroll 1
          for (int hq = 0; hq < 2; ++hq) {
            const int hh = dir ? 1 - hq : hq;
            s5_bu_half((const u16*)(ws + OFF_S5U) + (pos0 + 32 * hh + r32) * 512 + g * 16 + 8 * h, bfr, W, r32, h);
            s5_scan_half<true>(W, dir, recol, lam, hr, hi);
            f32x16 yy;
#pragma unroll
            for (int i = 0; i < 16; ++i) yy[i] = 0.f;
#pragma unroll
            for (int sk = 0; sk < 8; ++sk) {
              const bf16x8 af = *(const bf16x8*)(W + r32 * 136 + 16 * sk + 8 * h);
              const bf16x8 cf = *(const bf16x8*)(cm + 16 * sk);
              yy = MFMA32(af, cf, yy);
            }
            if (hh == 0) { ycc[0] += yy; } else { ycc[1] += yy; }
          }
        }
        if (r32 < 16) {
          const float dsk = IN(19)[L * 512 + g * 16 + r32];
#pragma unroll
          for (int hh = 0; hh < 2; ++hh)
#pragma unroll
            for (int i = 0; i < 16; ++i) {
              const int t = 32 * hh + (i & 3) + 8 * (i >> 2) + 4 * h;
              u16* up = (u16*)(ws + OFF_S5U) + (pos0 + t) * 512 + g * 16 + r32;
              *up = f2bf(gelu_erf(ycc[hh][i] + bf2f(*up) * dsk));
            }
        }
      }
    }
    return;
  }
  if (k == 5) {
    const int n_g = 264 * 8;
    const int n_all = n_g + NP / 4;
    for (int it = bid; it < n_all; it += G) {
      if (it < n_g) {
        const int mt = it / 8, nt = it % 8;
        f32x16 acc[2][2]; acc_zero(acc);
        gemm_core((const u16*)(ws + OFF_S5U) + (size_t)mt * 128 * 512, 512, (const u16*)(ws + OFF_WGLU) + (size_t)nt * 128 * 512, 512, 512, acc, usm);
        {
          u16* YS = (u16*)(ws + OFF_MVT);
          const int e_r = lane & 31, e_h = lane >> 5, e_wm = wave >> 1, e_wn = wave & 1;
          const int ca = nt * 64 + e_wn * 32 + e_r;
          const float ba = IN(21)[L * 1024 + ca], bgt = IN(21)[L * 1024 + 512 + ca];
#pragma unroll
          for (int mi = 0; mi < 2; ++mi)
#pragma unroll
            for (int i = 0; i < 16; ++i) {
              const int row = e_wm * 64 + mi * 32 + (i & 3) + 8 * (i >> 2) + 4 * e_h;
              YS[(size_t)(mt * 128 + row) * 512 + ca] = f2bf((acc[mi][0][i] + ba) * sigmoidf_(acc[mi][1][i] + bgt));
            }
        }
      } else {
        const int pos = (it - n_g) * 4 + wave;
        const float* md = mod_ptr(p, L, pos);
        ln_mod_wave(h_in_ptr(p, L, pos), md, md + 1024, XM + (size_t)pos * DM, lane);
      }
    }
    return;
  }
  if (k == 6) {
    const int n_all = NP * 512 / 2048;
    for (int it = bid; it < n_all; it += G) {
      const size_t e = (size_t)it * 2048 + tid * 8;
      const size_t pos = e >> 9; const int c = (int)(e & 511);
      const u16* z = (const u16*)(ws + OFF_Z) + pos * 1024 + c;
      const uint4 a = *(const uint4*)z, g = *(const uint4*)(z + 512);
      uint4 o;
      o.x = cvtpk(bflo(a.x) * sigmoidf_(bflo(g.x)), bfhi(a.x) * sigmoidf_(bfhi(g.x)));
      o.y = cvtpk(bflo(a.y) * sigmoidf_(bflo(g.y)), bfhi(a.y) * sigmoidf_(bfhi(g.y)));
      o.z = cvtpk(bflo(a.z) * sigmoidf_(bflo(g.z)), bfhi(a.z) * sigmoidf_(bfhi(g.z)));
      o.w = cvtpk(bflo(a.w) * sigmoidf_(bflo(g.w)), bfhi(a.w) * sigmoidf_(bfhi(g.w)));
      *(uint4*)((u16*)(ws + OFF_S5U) + pos * 512 + c) = o;
    }
    return;
  }
  if (k == 7) {
    const int n_g = 264 * 8, n_all = n_g + 1024;
    int* ctr = (int*)(ws + OFF_CTR) + 2 + L * 2;
    for (int it = FETCH_ITEM(); it < n_all; it = FETCH_ITEM()) {
      if (it >= n_g) {
        for (int c = 0; c < 8; ++c) convert_chunk_fp8(IN(34) + (size_t)L * 16384 * 1024, (unsigned char*)(ws + OFF_PU), (size_t)(it - n_g) * 8 + c, 64.f);
        continue;
      }
      const int mt = it / 8, nt = it % 8;
      f32x16 mg[2][2]; acc_zero(mg);
#pragma unroll 1
      for (int kb = 0; kb < 4; ++kb) {
        f32x16 a1[2][2]; acc_zero(a1);
        gemm_core(XM + (size_t)mt * 128 * DM, DM, WinT + (size_t)(4880 + kb * 1024 + nt * 128) * DM, DM, DM, a1, usm);
        const float* bg = IN(7) + L * 4096 + kb * 1024 + nt * 128;
        unsigned gp[2][2][8];
        {
          const int r32 = lane & 31, wn = wave & 1;
#pragma unroll
          for (int ni = 0; ni < 2; ++ni) {
            const float bv = bg[wn * 64 + ni * 32 + r32];
#pragma unroll
            for (int mi = 0; mi < 2; ++mi)
#pragma unroll
              for (int i = 0; i < 8; ++i) gp[mi][ni][i] = cvtpk(sigmoidf_(a1[mi][ni][2 * i] + bv), sigmoidf_(a1[mi][ni][2 * i + 1] + bv));
          }
        }
        f32x16 a2[2][2]; acc_zero(a2);
        const size_t yo = kb == 0 ? OFF_QD : (kb == 1 ? OFF_MVT : (kb == 2 ? OFF_MO : OFF_QG));
        gemm_core((const u16*)(ws + yo) + (size_t)mt * 128 * 512, 512, (const u16*)(ws + OFF_WBR) + ((size_t)kb * DM + nt * 128) * 512, 512, 512, a2, usm);
#pragma unroll
        for (int mi = 0; mi < 2; ++mi)
#pragma unroll
          for (int ni = 0; ni < 2; ++ni)
#pragma unroll
            for (int i = 0; i < 8; ++i) { mg[mi][ni][2 * i] += bflo(gp[mi][ni][i]) * a2[mi][ni][2 * i]; mg[mi][ni][2 * i + 1] += bfhi(gp[mi][ni][i]) * a2[mi][ni][2 * i + 1]; }
      }
      u16* MG = (u16*)(ws + OFF_Z);
      EPI_LOOP(mg, { MG[(size_t)(mt * 128 + row) * 1024 + nt * 128 + col] = f2bf(val); })
    }
    return;
  }
  if (k == 8) {
    const int n_g = 264 * 8, n_cv = 1024;
    const int n_all = n_g + n_cv;
    int* ctr = (int*)(ws + OFF_CTR) + 3 + L * 2;
    for (int it = FETCH_ITEM(); it < n_all; it = FETCH_ITEM()) {
      if (it < n_g) {
        const int mt = it / 8, nt = it % 8;
        f32x16 acc[2][2]; acc_zero(acc);
        gemm_core((const u16*)(ws + OFF_Z) + (size_t)mt * 128 * DM, DM, (const u16*)(ws + OFF_WO) + (size_t)nt * 128 * DM, DM, DM, acc, usm);
        const float* g1 = mod_ptr(p, L, mt * 128) + 2048 + nt * 128;
        const float* hin0 = h_in_ptr(p, L, mt * 128) + nt * 128;
        float* hout0 = h_out_ptr(p, mt * 128) + nt * 128;
        EPI_LOOP(acc, { hout0[(size_t)row * DM + col] = ALPHA * hin0[(size_t)row * DM + col] + g1[col] * val; })
      } else {
        for (int c = 0; c < 8; ++c) convert_chunk_fp8(IN(35) + (size_t)L * 16384 * 1024, (unsigned char*)(ws + OFF_PV), (size_t)(it - n_g) * 8 + c, 8.f);
      }
    }
    return;
  }
  if (k == 9) {
    for (int it = bid; it < NP / 4; it += G) {
      const int pos = it * 4 + wave;
      float* hrow = h_out_ptr(p, pos);
      float4 x[4];
#pragma unroll
      for (int i = 0; i < 4; ++i) x[i] = *(const float4*)(hrow + lane * 4 + 256 * i);
      float sm = 0.f;
#pragma unroll
      for (int i = 0; i < 4; ++i) sm += x[i].x + x[i].y + x[i].z + x[i].w;
      const float mean = wave_sum(sm) * (1.f / DM);
      float vs = 0.f;
#pragma unroll
      for (int i = 0; i < 4; ++i) { x[i].x -= mean; x[i].y -= mean; x[i].z -= mean; x[i].w -= mean; vs += x[i].x * x[i].x + x[i].y * x[i].y + x[i].z * x[i].z + x[i].w * x[i].w; }
      const float rs = rsqrtf(wave_sum(vs) * (1.f / DM) + LN_EPS);
      float sm2 = 0.f;
#pragma unroll
      for (int i = 0; i < 4; ++i) {
        const float4 g = *(const float4*)(IN(28) + L * DM + lane * 4 + 256 * i), be = *(const float4*)(IN(29) + L * DM + lane * 4 + 256 * i);
        x[i] = make_float4(x[i].x * rs * g.x + be.x, x[i].y * rs * g.y + be.y, x[i].z * rs * g.z + be.z, x[i].w * rs * g.w + be.w);
        *(float4*)(hrow + lane * 4 + 256 * i) = x[i];
        sm2 += x[i].x + x[i].y + x[i].z + x[i].w;
      }
      const float mean2 = wave_sum(sm2) * (1.f / DM);
      float vs2 = 0.f;
#pragma unroll
      for (int i = 0; i < 4; ++i) { x[i].x -= mean2; x[i].y -= mean2; x[i].z -= mean2; x[i].w -= mean2; vs2 += x[i].x * x[i].x + x[i].y * x[i].y + x[i].z * x[i].z + x[i].w * x[i].w; }
      const float rs2 = rsqrtf(wave_sum(vs2) * (1.f / DM) + LN_EPS);
      const float* md = mod_ptr(p, L, pos);
#pragma unroll
      for (int i = 0; i < 4; ++i) {
        const float4 sh = *(const float4*)(md + 3072 + lane * 4 + 256 * i), sc = *(const float4*)(md + 4096 + lane * 4 + 256 * i);
        *(uint2*)(XM + (size_t)pos * DM + lane * 4 + 256 * i) = make_uint2(cvtpk(x[i].x * rs2 * (1.f + sc.x) + sh.x, x[i].y * rs2 * (1.f + sc.y) + sh.y), cvtpk(x[i].z * rs2 * (1.f + sc.z) + sh.z, x[i].w * rs2 * (1.f + sc.w) + sh.w));
      }
    }
    return;
  }
  if (k == 10) {
    const int n_all = 264 * 16;
    for (int it = bid; it < n_all; it += G) {
      const int mt = it / 16, nt = it % 16;
      f32x16 acc[2][2]; acc_zero(acc);
      gemm_core(XM + (size_t)mt * 128 * DM, DM, (const u16*)(ws + OFF_WQ) + (size_t)nt * 128 * DM, DM, DM, acc, usm);
      u16* Q2 = (u16*)(ws + OFF_Q2);
      EPI_LOOP(acc, { Q2[(size_t)(mt * 128 + row) * 2048 + nt * 128 + col] = f2bf(val); })
    }
    return;
  }
  if (k == 11) {
    const int n_all = NP / 8;
    float* sc = fsm;
    float* T1v = fsm + 64 * 132;
    float* T2v = T1v + 1024;
    int* T1i = (int*)(T2v + 1024);
    int* T2i = T1i + 1024;
    float* Sv = (float*)(T2i + 1024) + wave * 64;
    int* Si = (int*)((float*)(T2i + 1024) + 256) + wave * 64;
    const int r32 = lane & 31, h = lane >> 5;
    for (int it = bid; it < n_all; it += G) {
      const size_t row0 = (size_t)it * 64;
#pragma unroll 1
      for (int half = 0; half < 2; ++half) {
        f32x16 a[2];
#pragma unroll
        for (int ni = 0; ni < 2; ++ni)
#pragma unroll
          for (int i = 0; i < 16; ++i) a[ni][i] = 0.f;
        const u16* qa = (const u16*)(ws + OFF_Q2) + (row0 + (wave >> 1) * 32 + r32) * 256 + half * 128;
        const u16* kbp = (const u16*)(ws + OFF_SK) + (size_t)half * 16384 + (size_t)((wave & 1) * 64 + r32) * 128;
#pragma unroll
        for (int s = 0; s < 8; ++s) {
          const bf16x8 af = *(const bf16x8*)(qa + s * 16 + h * 8);
#pragma unroll
          for (int ni = 0; ni < 2; ++ni) {
            const bf16x8 bf = *(const bf16x8*)(kbp + (size_t)ni * 32 * 128 + s * 16 + h * 8);
            a[ni] = MFMA32(af, bf, a[ni]);
          }
        }
        __syncthreads();
#pragma unroll
        for (int ni = 0; ni < 2; ++ni)
#pragma unroll
          for (int i = 0; i < 16; ++i) sc[((wave >> 1) * 32 + (i & 3) + 8 * (i >> 2) + 4 * h) * 132 + (wave & 1) * 64 + ni * 32 + r32] = a[ni][i];
        __syncthreads();
        float* Tv = half ? T2v : T1v; int* Ti = half ? T2i : T1i;
#pragma unroll 1
        for (int g = 0; g < 4; ++g) {
          float v0[4], v1[4]; unsigned k0[4], k1[4], T[4];
#pragma unroll
          for (int r = 0; r < 4; ++r) {
            const int row = wave * 16 + g * 4 + r;
            v0[r] = sc[row * 132 + lane]; v1[r] = sc[row * 132 + 64 + lane];
            unsigned u0 = __float_as_uint(v0[r]), u1 = __float_as_uint(v1[r]);
            u0 = (u0 >> 31) ? ~u0 : (u0 | 0x80000000u); u1 = (u1 >> 31) ? ~u1 : (u1 | 0x80000000u);
            k0[r] = (u0 & 0xFFFFFF80u) | (unsigned)(127 - lane); k1[r] = (u1 & 0xFFFFFF80u) | (unsigned)(63 - lane);
            T[r] = 0u;
          }
          bool dn0 = false, dn1 = false, dn2 = false, dn3 = false;
#pragma unroll 1
          for (int bit = 31; bit >= 0; --bit) {
#pragma unroll
            for (int r = 0; r < 4; ++r) {
              bool& dn = r == 0 ? dn0 : (r == 1 ? dn1 : (r == 2 ? dn2 : dn3));
              const unsigned cand = T[r] | (1u << bit);
              const int cnt = __popcll(__ballot(k0[r] >= cand)) + __popcll(__ballot(k1[r] >= cand));
              T[r] = cnt >= 16 ? cand : T[r];
              dn = dn | (cnt == 16);
            }
            if (dn0 && dn1 && dn2 && dn3) break;
          }
#pragma unroll
          for (int r = 0; r < 4; ++r) {
            const int row = wave * 16 + g * 4 + r;
            const bool s0 = k0[r] >= T[r], s1 = k1[r] >= T[r];
            const unsigned long long m0 = __ballot(s0), m1 = __ballot(s1);
            const int p0 = __builtin_amdgcn_mbcnt_hi((unsigned)(m0 >> 32), __builtin_amdgcn_mbcnt_lo((unsigned)m0, 0u));
            const int p1 = __popcll(m0) + __builtin_amdgcn_mbcnt_hi((unsigned)(m1 >> 32), __builtin_amdgcn_mbcnt_lo((unsigned)m1, 0u));
            if (s0) { Tv[row * 16 + p0] = v0[r]; Ti[row * 16 + p0] = lane; }
            if (s1) { Tv[row * 16 + p1] = v1[r]; Ti[row * 16 + p1] = lane + 64; }
          }
        }
      }
#pragma unroll 1
      for (int g = 0; g < 4; ++g) {
        {
          const int rowl = wave * 16 + g * 4 + (lane >> 4), j = lane & 15;
#pragma unroll
          for (int half = 0; half < 2; ++half) {
            float* Tv = half ? T2v : T1v; int* Ti = half ? T2i : T1i;
            const float v = Tv[rowl * 16 + j]; const int vi = Ti[rowl * 16 + j];
            int rank = 0;
#pragma unroll
            for (int i = 0; i < 16; ++i) { const float o = Tv[rowl * 16 + i]; rank += (o > v || (o == v && i < j)) ? 1 : 0; }
            Tv[rowl * 16 + rank] = v; Ti[rowl * 16 + rank] = vi;
          }
        }
        unsigned kk[4], T[4]; float cv[4];
        const int pr = PEER_PAIRS[lane], ia = pr >> 4, ib = pr & 15;
#pragma unroll
        for (int r = 0; r < 4; ++r) {
          const int row = wave * 16 + g * 4 + r;
          cv[r] = T1v[row * 16 + ia] + T2v[row * 16 + ib];
          unsigned u = __float_as_uint(cv[r]); u = (u >> 31) ? ~u : (u | 0x80000000u);
          kk[r] = lane < 50 ? ((u & 0xFFFFFFC0u) | (unsigned)(63 - lane)) : 0u;
          T[r] = 0u;
        }
        bool dn0 = false, dn1 = false, dn2 = false, dn3 = false;
#pragma unroll 1
        for (int bit = 31; bit >= 0; --bit) {
#pragma unroll
          for (int r = 0; r < 4; ++r) {
            bool& dn = r == 0 ? dn0 : (r == 1 ? dn1 : (r == 2 ? dn2 : dn3));
            const unsigned cand = T[r] | (1u << bit);
            const int cnt = __popcll(__ballot(kk[r] >= cand));
            T[r] = cnt >= 16 ? cand : T[r];
            dn = dn | (cnt == 16);
          }
          if (dn0 && dn1 && dn2 && dn3) break;
        }
#pragma unroll
        for (int r = 0; r < 4; ++r) {
          const int row = wave * 16 + g * 4 + r;
          const bool se = kk[r] >= T[r] && T[r] != 0u;
          const unsigned long long me = __ballot(se);
          const int pe = __builtin_amdgcn_mbcnt_hi((unsigned)(me >> 32), __builtin_amdgcn_mbcnt_lo((unsigned)me, 0u));
          if (se) {
            Sv[r * 16 + pe] = cv[r];
            Si[r * 16 + pe] = T1i[row * 16 + ia] * 128 + T2i[row * 16 + ib];
          }
        }
        {
          const float val = Sv[lane]; const int idx = Si[lane];
          float mx = val;
          mx = fmaxf(mx, SHX(mx, 8)); mx = fmaxf(mx, SHX(mx, 4)); mx = fmaxf(mx, SHX(mx, 2)); mx = fmaxf(mx, SHX(mx, 1));
          const float ev = __expf(val - mx);
          float sm = ev;
          sm += SHX(sm, 8); sm += SHX(sm, 4); sm += SHX(sm, 2); sm += SHX(sm, 1);
          const size_t o = (row0 + wave * 16 + g * 4) * 16 + lane;
          ((int*)(ws + OFF_IDX))[o] = idx;
          ((float*)(ws + OFF_GATE))[o] = ev / sm;
        }
      }
      __syncthreads();
    }
    return;
  }
  if (k == 12) {
    const unsigned char* PU = (const unsigned char*)(ws + OFF_PU); const unsigned char* PV = (const unsigned char*)(ws + OFF_PV);
    float* wl = fsm + 8 + wave * 32;
    float* fs = fsm + 8 + 128;
    for (int it = bid; it < NP; it += G) {
      const int pos = it;
      float tf[16];
      {
        const u16* xr = XM + (size_t)pos * DM + lane * 16;
        const u32x4 a = *(const u32x4*)xr, b = *(const u32x4*)(xr + 8);
        tf[0] = bflo(a.x); tf[1] = bfhi(a.x); tf[2] = bflo(a.y); tf[3] = bfhi(a.y); tf[4] = bflo(a.z); tf[5] = bfhi(a.z); tf[6] = bflo(a.w); tf[7] = bfhi(a.w);
        tf[8] = bflo(b.x); tf[9] = bfhi(b.x); tf[10] = bflo(b.y); tf[11] = bfhi(b.y); tf[12] = bflo(b.z); tf[13] = bfhi(b.z); tf[14] = bflo(b.w); tf[15] = bfhi(b.w);
      }
      const size_t r0 = (size_t)pos * 8 + wave * 2;
      const int myidx = lane < 32 ? ((const int*)(ws + OFF_IDX))[r0 * 16 + lane] : 0;
      const float myg = lane < 32 ? ((const float*)(ws + OFF_GATE))[r0 * 16 + lane] : 0.f;
      u32x4 A[8], B[8], C[8];
      const bool b5 = lane & 32, b4 = lane & 16, b3 = lane & 8;
#define LOADROWS(X, TAB, E0)                                                             \
      _Pragma("unroll") for (int j = 0; j < 8; ++j) {                                    \
        const int idx = __builtin_amdgcn_readlane(myidx, (E0) + j);                      \
        X[j] = *(const u32x4*)((TAB) + (size_t)idx * DM + lane * 16);                    \
      }
#define UNPK(X, j, q) const f32x2 q##0 = __builtin_amdgcn_cvt_pk_f32_fp8((int)X[j].x, false), q##1 = __builtin_amdgcn_cvt_pk_f32_fp8((int)X[j].x, true), \
                                  q##2 = __builtin_amdgcn_cvt_pk_f32_fp8((int)X[j].y, false), q##3 = __builtin_amdgcn_cvt_pk_f32_fp8((int)X[j].y, true), \
                                  q##4 = __builtin_amdgcn_cvt_pk_f32_fp8((int)X[j].z, false), q##5 = __builtin_amdgcn_cvt_pk_f32_fp8((int)X[j].z, true), \
                                  q##6 = __builtin_amdgcn_cvt_pk_f32_fp8((int)X[j].w, false), q##7 = __builtin_amdgcn_cvt_pk_f32_fp8((int)X[j].w, true);
#define DOTS(X, E0)                                                                  \
      {                                                                                  \
        float d[8];                                                                      \
        _Pragma("unroll") for (int j = 0; j < 8; ++j) {                                  \
          UNPK(X, j, q)                                                                  \
          d[j] = tf[0] * q0.x + tf[1] * q0.y + tf[2] * q1.x + tf[3] * q1.y + tf[4] * q2.x + tf[5] * q2.y + tf[6] * q3.x + tf[7] * q3.y \
               + tf[8] * q4.x + tf[9] * q4.y + tf[10] * q5.x + tf[11] * q5.y + tf[12] * q6.x + tf[13] * q6.y + tf[14] * q7.x + tf[15] * q7.y; \
          asm volatile("" : "+v"(d[j]));                                                 \
        }                                                                                \
        float d4[4], d2[2], d1;                                                          \
        _Pragma("unroll") for (int i = 0; i < 4; ++i) { const float keep = b5 ? d[i + 4] : d[i], send = b5 ? d[i] : d[i + 4]; d4[i] = keep + SHX(send, 32); } \
        _Pragma("unroll") for (int i = 0; i < 2; ++i) { const float keep = b4 ? d4[i + 2] : d4[i], send = b4 ? d4[i] : d4[i + 2]; d2[i] = keep + SHX(send, 16); } \
        { const float keep = b3 ? d2[1] : d2[0], send = b3 ? d2[0] : d2[1]; d1 = keep + SHX(send, 8); } \
        d1 += SHX(d1, 4); d1 += SHX(d1, 2); d1 += SHX(d1, 1);                            \
        const float gt = __int_as_float(__builtin_amdgcn_ds_bpermute(((E0) + (lane >> 3)) << 2, __float_as_int(myg))); \
        if ((lane & 7) == 0) wl[(E0) + (lane >> 3)] = gt * gelu_erf(d1 * (1.f / 64.f)) * 0.125f; \
        __builtin_amdgcn_sched_barrier(0);                                               \
      }
#define ACCV(X, E0)                                                                      \
      _Pragma("unroll") for (int j = 0; j < 8; ++j) {                                    \
        const float w = wl[(E0) + j];                                                    \
        UNPK(X, j, q)                                                                    \
        ov[0] += w * q0.x; ov[1] += w * q0.y; ov[2] += w * q1.x; ov[3] += w * q1.y; ov[4] += w * q2.x; ov[5] += w * q2.y; ov[6] += w * q3.x; ov[7] += w * q3.y; \
        ov[8] += w * q4.x; ov[9] += w * q4.y; ov[10] += w * q5.x; ov[11] += w * q5.y; ov[12] += w * q6.x; ov[13] += w * q6.y; ov[14] += w * q7.x; ov[15] += w * q7.y; \
        _Pragma("unroll") for (int i = 0; i < 16; ++i) asm volatile("" : "+v"(ov[i]));   \
      }
      __syncthreads();
      LOADROWS(A, PU, 0)
      LOADROWS(B, PU, 8)
      LOADROWS(C, PU, 16)
      DOTS(A, 0)
      LOADROWS(A, PU, 24)
      DOTS(B, 8)
      LOADROWS(B, PV, 0)
      DOTS(C, 16)
      LOADROWS(C, PV, 8)
      DOTS(A, 24)
      LOADROWS(A, PV, 16)
      float ov[16];
#pragma unroll
      for (int i = 0; i < 16; ++i) ov[i] = 0.f;
      ACCV(B, 0)
      __builtin_amdgcn_sched_barrier(0);
      LOADROWS(B, PV, 24)
      ACCV(C, 8)
      __builtin_amdgcn_sched_barrier(0);
      ACCV(A, 16)
      __builtin_amdgcn_sched_barrier(0);
      ACCV(B, 24)
#undef LOADROWS
#undef UNPK
#undef DOTS
#undef ACCV
#pragma unroll
      for (int i = 0; i < 16; ++i) fs[wave * 1024 + lane * 16 + i] = ov[i];
      __syncthreads();
      const int tid2 = otid();
      float f[4];
#pragma unroll
      for (int i = 0; i < 4; ++i) f[i] = fs[tid2 * 4 + i] + fs[1024 + tid2 * 4 + i] + fs[2048 + tid2 * 4 + i] + fs[3072 + tid2 * 4 + i];
      float* hrow = h_out_ptr(p, pos);
      const float4 hm = *(const float4*)(hrow + tid2 * 4);
      const float4 g2 = *(const float4*)(mod_ptr(p, L, pos) + 5120 + tid2 * 4);
      const float x0 = ALPHA * hm.x + g2.x * f[0], x1 = ALPHA * hm.y + g2.y * f[1], x2 = ALPHA * hm.z + g2.z * f[2], x3 = ALPHA * hm.w + g2.w * f[3];
      const float mean = block_sum(x0 + x1 + x2 + x3, fsm) * (1.f / DM);
      const float a = x0 - mean, b = x1 - mean, c = x2 - mean, d = x3 - mean;
      const float var = block_sum(a * a + b * b + c * c + d * d, fsm) * (1.f / DM);
      const float rs = rsqrtf(var + LN_EPS);
      const float4 g = *(const float4*)(IN(30) + L * DM + tid2 * 4), be = *(const float4*)(IN(31) + L * DM + tid2 * 4);
      *(float4*)(hrow + tid2 * 4) = make_float4(a * rs * g.x + be.x, b * rs * g.y + be.y, c * rs * g.z + be.z, d * rs * g.w + be.w);
    }
    return;
  }
}

#if MULTI_LAUNCH
__global__ void __launch_bounds__(256, 2) k_phase(P p, int ph) {
  __shared__ __attribute__((aligned(16))) char smem[57344];
  run_phase(p, ph, smem);
}
#endif

#if !MULTI_LAUNCH
#define XB_TMO      128
#define XB_XCNT(j)  (256  + 64 * (j))
#define XB_XSUB(j)  (1280 + 64 * (j))
#define XB_XGEN(j)  (2304 + 64 * (j))
#define XB_TOP      3328
#define XB_TOPGEN   3392
#define XCD_BAR_WORDS 3456
#define XB_SPIN_CAP (1u << 18)
#define LAS __attribute__((address_space(3)))

__device__ __forceinline__ unsigned xb_ld(unsigned* p)              { return __hip_atomic_load(p, __ATOMIC_RELAXED, __HIP_MEMORY_SCOPE_AGENT); }
__device__ __forceinline__ unsigned xb_add(unsigned* p, unsigned v) { return __hip_atomic_fetch_add(p, v, __ATOMIC_RELAXED, __HIP_MEMORY_SCOPE_AGENT); }
__device__ __forceinline__ unsigned xb_xcc_id() { return (unsigned)__builtin_amdgcn_s_getreg((3 << 11) | 20) & 0xFu; }
#define XB_SPIN(cond, bar) do { unsigned _sp = 0; while (cond) { __builtin_amdgcn_s_sleep(1); \
    if ((++_sp & 255u) == 0u) { if (xb_ld(&(bar)[XB_TMO])) break; if (_sp > XB_SPIN_CAP) { atomicAdd(&(bar)[XB_TMO], 1u); break; } } } } while (0)

struct XcdBarrier {
    unsigned* bar; unsigned x;
    volatile LAS unsigned* st;
};

__device__ __forceinline__ XcdBarrier xcd_barrier_post(unsigned* bar, volatile LAS unsigned* st) {
    XcdBarrier b; b.bar = bar; b.x = xb_xcc_id(); b.st = st;
    if (threadIdx.x == 0) (void)xb_add(&bar[XB_XCNT(b.x)], 1u);
    return b;
}
__device__ __forceinline__ void xcd_barrier_complete(unsigned* bar, unsigned x, unsigned& nloc, unsigned& nx) {
    const unsigned G = gridDim.x * gridDim.y * gridDim.z;
    unsigned sum, cnt, mine, sp = 0u;
    for (;;) {
        sum = 0u; cnt = 0u; mine = 0u;
#pragma unroll
        for (unsigned j = 0; j < 16; ++j) { const unsigned c = xb_ld(&bar[XB_XCNT(j)]); sum += c; cnt += (c > 0u) ? 1u : 0u; mine = (j == x) ? c : mine; }
        if (sum == G) break;
        __builtin_amdgcn_s_sleep(1);
        if ((++sp & 255u) == 0u) { if (xb_ld(&bar[XB_TMO])) break; if (sp > XB_SPIN_CAP) { atomicAdd(&bar[XB_TMO], 1u); break; } }
    }
    nloc = mine > 0u ? mine : 1u; nx = cnt > 0u ? cnt : 1u;
}

__device__ __forceinline__ void xcd_barrier(const XcdBarrier& b) {
    asm volatile("s_waitcnt vmcnt(0)" ::: "memory");
    __syncthreads();
    if (threadIdx.x == 0) {
        unsigned* bar = b.bar;
        __builtin_amdgcn_s_waitcnt(0);
        unsigned nloc = b.st[0], nx = b.st[1];
        if (nloc == 0u) { xcd_barrier_complete(bar, b.x, nloc, nx); b.st[0] = nloc; b.st[1] = nx; }
        const unsigned old = xb_add(&bar[XB_XSUB(b.x)], 1u);
        const unsigned gen = old / nloc;
        if (old + 1u == (gen + 1u) * nloc) {
            __builtin_amdgcn_fence(__ATOMIC_RELEASE, "agent");
            asm volatile("s_waitcnt vmcnt(0)" ::: "memory");
            const unsigned og = xb_add(&bar[XB_TOP], 1u);
            const unsigned tg = og / nx;
            if (og + 1u == (tg + 1u) * nx) xb_add(&bar[XB_TOPGEN], 1u);
            else XB_SPIN(xb_ld(&bar[XB_TOPGEN]) == tg, bar);
            __builtin_amdgcn_fence(__ATOMIC_ACQUIRE, "agent");
            xb_add(&bar[XB_XGEN(b.x)], 1u);
            asm volatile("s_waitcnt vmcnt(0)" ::: "memory");
        } else {
            XB_SPIN(xb_ld(&bar[XB_XGEN(b.x)]) == gen, bar);
            __builtin_amdgcn_fence(__ATOMIC_ACQUIRE, "agent");
            asm volatile("s_waitcnt vmcnt(0)" ::: "memory");
        }
    }
    __syncthreads();
}


__global__ void __launch_bounds__(256, 2) k_mega(P p) {
  __shared__ __attribute__((aligned(16))) char smem[57344];
  cg::grid_group grid = cg::this_grid();
  __shared__ uint4 xb_words;
  if (threadIdx.x == 0) xb_words = make_uint4(0u, 0u, 0u, 0u);
  __syncthreads();
  (void)xcd_barrier_post((unsigned*)(WSP + OFF_BAR), (volatile LAS unsigned*)&xb_words);
#define XBAR() { XcdBarrier xb_; xb_.bar = (unsigned*)(WSP + OFF_BAR); xb_.x = xb_xcc_id(); xb_.st = (volatile LAS unsigned*)&xb_words; xcd_barrier(xb_); }
  run_phase(p, 0, smem); grid.sync();
  run_phase(p, 1, smem); XBAR()
  run_phase(p, 2, smem); XBAR()
  run_phase(p, 3, smem); XBAR()
  run_phase(p, 4, smem); XBAR()
  run_phase(p, 5, smem); XBAR()
  run_phase(p, 15, smem); XBAR()
  run_phase(p, 6, smem); XBAR()
  run_phase(p, 7, smem); XBAR()
  run_phase(p, 9, smem); XBAR()
  run_phase(p, 10, smem); XBAR()
  run_phase(p, 11, smem); XBAR()
  run_phase(p, 12, smem); XBAR()
  run_phase(p, 13, smem); XBAR()
  run_phase(p, 14, smem); XBAR()
  run_phase(p, 16, smem); XBAR()
  run_phase(p, 17, smem); XBAR()
  run_phase(p, 18, smem); XBAR()
  run_phase(p, 19, smem); XBAR()
  run_phase(p, 29, smem); XBAR()
  run_phase(p, 20, smem); XBAR()
  run_phase(p, 21, smem); XBAR()
  run_phase(p, 23, smem); XBAR()
  run_phase(p, 24, smem); XBAR()
  run_phase(p, 25, smem); XBAR()
  run_phase(p, 26, smem); XBAR()
  run_phase(p, 27, smem); XBAR()
  run_phase(p, 28, smem);
#undef XBAR
}
#endif

extern "C" void kernel_launch(void* const* d_in, const int* in_sizes, int n_in, void* d_out, int out_size, void* d_ws, size_t ws_size, hipStream_t stream) {
  if (n_in != 36 || ws_size < WS_END) { fprintf(stderr, "kernel_launch: need 36 inputs and %zu bytes of workspace (got %d, %zu)\n", (size_t)WS_END, n_in, ws_size); return; }
  P p{};
  for (int i = 0; i < 36; ++i) p.in[i] = (const float*)d_in[i];
  p.out = (float*)d_out; p.ws = (char*)d_ws;
#if MULTI_LAUNCH
  for (int ph = 0; ph < NPHASES; ++ph) hipLaunchKernelGGL(k_phase, dim3(512), dim3(256), 0, stream, p, ph);
#else
  static int grid_blocks = 0;
  if (!grid_blocks) {
    int dev = 0, cus = 0, per_cu = 0;
    hipGetDevice(&dev);
    hipDeviceGetAttribute(&cus, hipDeviceAttributeMultiprocessorCount, dev);
    hipOccupancyMaxActiveBlocksPerMultiprocessor(&per_cu, k_mega, 256, 0);
    if (per_cu < 1) per_cu = 1;
    grid_blocks = cus * per_cu;
    if (grid_blocks > 512) grid_blocks = 512;
  }
  hipMemsetAsync((char*)d_ws + OFF_BAR, 0, 16384, stream);
  void* args[] = {&p};
  hipError_t e = hipLaunchCooperativeKernel((void*)k_mega, dim3(grid_blocks), dim3(256), args, 0, stream);
  if (e != hipSuccess) fprintf(stderr, "cooperative launch failed: %s (grid %d)\n", hipGetErrorString(e), grid_blocks);
#endif
}
```

```cpp
#include <hip/hip_runtime.h>
#include <hip/hip_cooperative_groups.h>
#include <cstdio>
namespace cg = cooperative_groups;

#ifndef MULTI_LAUNCH
#define MULTI_LAUNCH 0
#endif

#define DI __device__ __forceinline__
typedef unsigned short u16;
typedef short bf16x8 __attribute__((ext_vector_type(8)));
typedef short s16x4 __attribute__((ext_vector_type(4)));
typedef float f32x16 __attribute__((ext_vector_type(16)));
typedef float f32x2 __attribute__((ext_vector_type(2)));
typedef __bf16 bf16x2_t __attribute__((ext_vector_type(2)));
typedef unsigned u32x4 __attribute__((ext_vector_type(4)));
typedef __bf16 bf16x8_t __attribute__((ext_vector_type(8)));
#define MFMA32(a, b, c) __builtin_amdgcn_mfma_f32_32x32x16_bf16((a), (b), (c), 0, 0, 0)

constexpr int NB = 4, SL = 8192, SC = 256, SB = 8448, NP = NB * SB, DM = 1024, NIN = 8976;
constexpr float LN_EPS = 1e-6f;
constexpr float ALPHA = 1.41421356237f;
constexpr float LOG2E = 1.44269504089f;

constexpr size_t SZ512 = (size_t)NP * 512 * 2;
constexpr size_t OFF_A = 0;
constexpr size_t OFF_QD = OFF_A + 2 * SZ512;
constexpr size_t OFF_KD = OFF_QD + SZ512;
constexpr size_t OFF_VDT = OFF_KD + SZ512;
constexpr size_t OFF_S5U = OFF_VDT + SZ512;
constexpr size_t OFF_MQ = OFF_S5U + SZ512;
constexpr size_t OFF_MK = OFF_MQ + SZ512;
constexpr size_t OFF_MVT = OFF_MK + SZ512;
constexpr size_t OFF_MO = OFF_MVT + SZ512;
constexpr size_t OFF_QG = OFF_MO + SZ512;
constexpr size_t OFF_KG = OFF_QG + SZ512;
constexpr size_t OFF_VGT = OFF_KG + SZ512 / 4;
constexpr size_t OFF_MGATE = OFF_VGT + SZ512 / 4;
constexpr size_t OFF_WIN = OFF_MGATE + (size_t)NP * 16 * 4;
constexpr size_t OFF_WBR = OFF_WIN + (size_t)9088 * 1024 * 2;
constexpr size_t OFF_WO = OFF_WBR + (size_t)4 * 1024 * 512 * 2;
constexpr size_t OFF_WGLU = OFF_WO + (size_t)1024 * 1024 * 2;
constexpr size_t OFF_WQ = OFF_WGLU + (size_t)1024 * 512 * 2;
constexpr size_t OFF_SK = OFF_WQ + (size_t)2048 * 1024 * 2;
constexpr size_t OFF_MODP = OFF_SK + 65536;
constexpr size_t OFF_MOD = OFF_MODP + (size_t)2 * 8 * 5 * 6144 * 4;
constexpr size_t OFF_LAMB = OFF_MOD + (size_t)2 * 5 * 6144 * 4;
constexpr size_t OFF_BBAR = OFF_LAMB + 65536;
constexpr size_t OFF_LAMV = OFF_BBAR + 1048576;
constexpr size_t SZCH = (size_t)32 * SB * 4;
constexpr size_t OFF_GI = OFF_LAMV + 256;
constexpr size_t OFF_GF = OFF_GI + SZCH;
constexpr size_t OFF_AA = OFF_GF + SZCH;
constexpr size_t OFF_MXA = OFF_AA + SZCH;
constexpr size_t OFF_MTA = OFF_MXA + SZCH;
constexpr size_t SZHE = (size_t)NB * 2 * 32 * 132 * 64 * 8;
constexpr size_t OFF_HEND = OFF_MTA + SZCH;
constexpr size_t OFF_CARRY = OFF_HEND + SZHE;
constexpr size_t OFF_HC = OFF_CARRY + SZHE;
constexpr size_t OFF_STASH = OFF_HC + (size_t)1024 * 1024 * 4;
constexpr size_t OFF_PU = OFF_STASH;
constexpr size_t OFF_PV = OFF_STASH + (size_t)16384 * 1024;
constexpr size_t OFF_ROPE = OFF_STASH + (size_t)512 * 64 * 256 * 4;
constexpr size_t OFF_TMAX = OFF_ROPE + 32768;
constexpr size_t OFF_BBT = OFF_TMAX + 32768;
constexpr size_t OFF_CMT = OFF_BBT + 524288;
constexpr size_t OFF_NST = OFF_CMT + 524288;
constexpr size_t OFF_NPST = OFF_NST + (size_t)1056 * 128 * 4;
constexpr size_t OFF_ALOC = OFF_NPST + (size_t)1056 * 128 * 4;
constexpr size_t OFF_BKA = OFF_ALOC + 8192;
constexpr size_t OFF_CTR = OFF_BKA + 8192;
constexpr size_t OFF_BAR = OFF_CTR + 256;
constexpr size_t WS_END = OFF_BAR + 16384;
constexpr size_t OFF_GST = OFF_MQ;
constexpr size_t OFF_PST = OFF_MK;
constexpr size_t OFF_Z = OFF_MQ;

constexpr size_t OFF_Q2 = OFF_S5U;
constexpr size_t OFF_IDX = OFF_MO;
constexpr size_t OFF_GATE = OFF_MO + (size_t)NP * 8 * 16 * 4;

struct P {
  const float* in[36];
  float* out;
  char* ws;
};

typedef const float* const __attribute__((address_space(4)))* kargp_t;
DI kargp_t karg() { kargp_t k = (kargp_t)__builtin_amdgcn_kernarg_segment_ptr(); asm volatile("" : "+s"(k)); return k; }
#define IN(i) (karg()[i])
#define OUTP ((float*)karg()[36])
#define WSP ((char*)karg()[37])
DI int otid() { int t = threadIdx.x; asm volatile("" : "+v"(t)); return t; }
template <int M> DI int shx_i(int v) {
  if constexpr (M < 32) return __builtin_amdgcn_ds_swizzle(v, 0x1f | (M << 10));
  else return __builtin_amdgcn_ds_bpermute(((otid() & 63) ^ M) << 2, v);
}
#define SHX(v, M) __int_as_float(shx_i<M>(__float_as_int(v)))
#define SHXI(v, M) shx_i<M>(v)
DI unsigned cvtpk(float lo, float hi) { f32x2 v = {lo, hi}; bf16x2_t b = __builtin_convertvector(v, bf16x2_t); return __builtin_bit_cast(unsigned, b); }
DI u16 f2bf(float x) { return (u16)(cvtpk(x, 0.f) & 0xffffu); }
DI float bf2f(u16 x) { return __uint_as_float(((unsigned)x) << 16); }
DI float bflo(unsigned u) { return __uint_as_float(u << 16); }
DI float bfhi(unsigned u) { return __uint_as_float(u & 0xffff0000u); }
DI float wave_sum(float v) { v += SHX(v, 32); v += SHX(v, 16); v += SHX(v, 8); v += SHX(v, 4); v += SHX(v, 2); v += SHX(v, 1); return v; }
DI float wave_max(float v) { v = fmaxf(v, SHX(v, 32)); v = fmaxf(v, SHX(v, 16)); v = fmaxf(v, SHX(v, 8)); v = fmaxf(v, SHX(v, 4)); v = fmaxf(v, SHX(v, 2)); v = fmaxf(v, SHX(v, 1)); return v; }
DI float block_sum(float v, float* red) {
  v = wave_sum(v);
  __syncthreads();
  if ((otid() & 63) == 0) red[otid() >> 6] = v;
  __syncthreads();
  return red[0] + red[1] + red[2] + red[3];
}
DI float sigmoidf_(float x) { return __builtin_amdgcn_rcpf(1.f + __expf(-x)); }
DI float gelu_erf(float x) {
  const float z = fabsf(x) * 0.70710678118f;
  const float t = __builtin_amdgcn_rcpf(1.f + 0.3275911f * z);
  const float poly = t * (0.254829592f + t * (-0.284496736f + t * (1.421413741f + t * (-1.453152027f + t * 1.061405429f))));
  const float e = 1.f - poly * __expf(-z * z);
  return 0.5f * x * (1.f + copysignf(e, x));
}
DI float silu_(float x) { return x * __builtin_amdgcn_rcpf(1.f + __expf(-x)); }
DI float fexp2(float x) { return __builtin_amdgcn_exp2f(x); }

DI const float* h_in_ptr(const P& p, int L, int pos) {
  int b = pos / SB, s = pos - b * SB;
  if (L == 0) return s < SL ? IN(0) + ((size_t)b * SL + s) * DM : IN(2) + ((size_t)b * SC + (s - SL)) * DM;
  return s < SL ? OUTP + ((size_t)b * SL + s) * DM : (const float*)(WSP + OFF_HC) + ((size_t)b * SC + (s - SL)) * DM;
}
DI float* h_out_ptr(const P& p, int pos) {
  int b = pos / SB, s = pos - b * SB;
  return s < SL ? OUTP + ((size_t)b * SL + s) * DM : (float*)(WSP + OFF_HC) + ((size_t)b * SC + (s - SL)) * DM;
}
DI const float* mod_ptr(const P& p, int L, int pos) {
  int b = pos / SB, s = pos - b * SB;
  int v = s < SL ? b : 4;
  return (const float*)(WSP + OFF_MOD) + ((size_t)L * 5 + v) * 6144;
}

DI void gemm_core(const u16* __restrict__ A, int lda, const u16* __restrict__ B, int ldb, int K, f32x16 (&acc)[2][2], u16* lds) {
  const int tid = otid(), lane = tid & 63, wave = tid >> 6;
  const int wm = wave >> 1, wn = wave & 1, r32 = lane & 31, h = lane >> 5;
  u16* As = lds; u16* Bs = lds + 128 * 72;
  const int lr = tid >> 3, lc = (tid & 7) * 8;
  u32x4 ra[4], rb[4];
  const int nk = K >> 6;
#pragma unroll
  for (int i = 0; i < 4; ++i) {
    ra[i] = *(const u32x4*)(A + (size_t)(lr + 32 * i) * lda + lc);
    rb[i] = *(const u32x4*)(B + (size_t)(lr + 32 * i) * ldb + lc);
  }
#pragma unroll 1
  for (int kt = 0; kt < nk; ++kt) {
    __syncthreads();
#pragma unroll
    for (int i = 0; i < 4; ++i) {
      *(u32x4*)(As + (lr + 32 * i) * 72 + lc) = ra[i];
      *(u32x4*)(Bs + (lr + 32 * i) * 72 + lc) = rb[i];
    }
    __syncthreads();
    if (kt + 1 < nk) {
#pragma unroll
      for (int i = 0; i < 4; ++i) {
        ra[i] = *(const u32x4*)(A + (size_t)(lr + 32 * i) * lda + (kt + 1) * 64 + lc);
        rb[i] = *(const u32x4*)(B + (size_t)(lr + 32 * i) * ldb + (kt + 1) * 64 + lc);
      }
    }
#pragma unroll
    for (int s = 0; s < 4; ++s) {
      bf16x8 af[2], bfr[2];
#pragma unroll
      for (int mi = 0; mi < 2; ++mi) af[mi] = *(const bf16x8*)(As + (wm * 64 + mi * 32 + r32) * 72 + s * 16 + h * 8);
#pragma unroll
      for (int ni = 0; ni < 2; ++ni) bfr[ni] = *(const bf16x8*)(Bs + (wn * 64 + ni * 32 + r32) * 72 + s * 16 + h * 8);
#pragma unroll
      for (int mi = 0; mi < 2; ++mi)
#pragma unroll
        for (int ni = 0; ni < 2; ++ni) acc[mi][ni] = MFMA32(af[mi], bfr[ni], acc[mi][ni]);
    }
  }
}
DI void acc_zero(f32x16 (&acc)[2][2]) {
#pragma unroll
  for (int mi = 0; mi < 2; ++mi)
#pragma unroll
    for (int ni = 0; ni < 2; ++ni)
#pragma unroll
      for (int i = 0; i < 16; ++i) acc[mi][ni][i] = 0.f;
}
#define EPI_LOOP(acc, BODY)                                                                   \
  {                                                                                           \
    const int e_lane = otid() & 63, e_wave = otid() >> 6;                           \
    const int e_wm = e_wave >> 1, e_wn = e_wave & 1, e_r = e_lane & 31, e_h = e_lane >> 5;    \
    _Pragma("unroll") for (int mi = 0; mi < 2; ++mi) _Pragma("unroll") for (int ni = 0; ni < 2; ++ni) \
    _Pragma("unroll") for (int i = 0; i < 16; ++i) {                                         \
      const int row = e_wm * 64 + mi * 32 + (i & 3) + 8 * (i >> 2) + 4 * e_h;                 \
      const int col = e_wn * 64 + ni * 32 + e_r;                                              \
      const float val = acc[mi][ni][i];                                                       \
      BODY                                                                                    \
    }                                                                                         \
  }

template <bool GLUPERM = false>
DI void transpose_tile(const float* __restrict__ src, int K, int N, u16* __restrict__ dst, int tile, float* lds) {
  const int ntn = (N + 63) >> 6;
  const int k0 = (tile / ntn) * 64, n0 = (tile % ntn) * 64;
  const int tid = otid();
  __syncthreads();
  {
    const int r = tid >> 4, c4 = (tid & 15) * 4;
#pragma unroll
    for (int i = 0; i < 4; ++i) {
      const int kk = r + 16 * i;
      float4 v = make_float4(0.f, 0.f, 0.f, 0.f);
      if (n0 + c4 < N) v = *(const float4*)(src + (size_t)(k0 + kk) * N + n0 + c4);
      lds[kk * 65 + c4 + 0] = v.x; lds[kk * 65 + c4 + 1] = v.y; lds[kk * 65 + c4 + 2] = v.z; lds[kk * 65 + c4 + 3] = v.w;
    }
  }
  __syncthreads();
  {
    const int n = tid >> 2, kc = (tid & 3) * 16;
    if (n0 + n < N) {
      unsigned w[8];
#pragma unroll
      for (int j = 0; j < 8; ++j) w[j] = cvtpk(lds[(kc + 2 * j) * 65 + n], lds[(kc + 2 * j + 1) * 65 + n]);
      int nd = n0 + n;
      if (GLUPERM) { const int ca = nd & 511; nd = (ca >> 6) * 128 + ((ca >> 5) & 1) * 64 + (nd >= 512 ? 32 : 0) + (ca & 31); }
      uint4* d = (uint4*)(dst + (size_t)nd * K + k0 + kc);
      d[0] = make_uint4(w[0], w[1], w[2], w[3]);
      d[1] = make_uint4(w[4], w[5], w[6], w[7]);
    }
  }
}
DI void convert_chunk(const float* __restrict__ src, u16* __restrict__ dst, size_t chunk) {
  const size_t o = chunk * 2048 + (size_t)otid() * 8;
  const float4 a = *(const float4*)(src + o), b = *(const float4*)(src + o + 4);
  *(uint4*)(dst + o) = make_uint4(cvtpk(a.x, a.y), cvtpk(a.z, a.w), cvtpk(b.x, b.y), cvtpk(b.z, b.w));
}

DI void convert_chunk_fp8(const float* __restrict__ src, unsigned char* __restrict__ dst, size_t chunk, float scale) {
  const size_t o = chunk * 2048 + (size_t)otid() * 8;
  const float4 a = *(const float4*)(src + o), b = *(const float4*)(src + o + 4);
  int w0 = 0, w1 = 0;
  w0 = __builtin_amdgcn_cvt_pk_fp8_f32(a.x * scale, a.y * scale, w0, false); w0 = __builtin_amdgcn_cvt_pk_fp8_f32(a.z * scale, a.w * scale, w0, true);
  w1 = __builtin_amdgcn_cvt_pk_fp8_f32(b.x * scale, b.y * scale, w1, false); w1 = __builtin_amdgcn_cvt_pk_fp8_f32(b.z * scale, b.w * scale, w1, true);
  *(uint2*)(dst + o) = make_uint2((unsigned)w0, (unsigned)w1);
}

DI void ln_mod_row(const float* __restrict__ hrow, const float* __restrict__ shift, const float* __restrict__ scale, u16* __restrict__ dst, float* red) {
  const int tid = otid();
  const float4 x = *(const float4*)(hrow + tid * 4);
  const float mean = block_sum(x.x + x.y + x.z + x.w, red) * (1.f / DM);
  const float a = x.x - mean, b = x.y - mean, c = x.z - mean, d = x.w - mean;
  const float var = block_sum(a * a + b * b + c * c + d * d, red) * (1.f / DM);
  const float rs = rsqrtf(var + LN_EPS);
  const float4 sh = *(const float4*)(shift + tid * 4), sc = *(const float4*)(scale + tid * 4);
  const float y0 = a * rs * (1.f + sc.x) + sh.x, y1 = b * rs * (1.f + sc.y) + sh.y, y2 = c * rs * (1.f + sc.z) + sh.z, y3 = d * rs * (1.f + sc.w) + sh.w;
  *(uint2*)(dst + tid * 4) = make_uint2(cvtpk(y0, y1), cvtpk(y2, y3));
}

DI void ln_mod_wave(const float* __restrict__ hrow, const float* __restrict__ shift, const float* __restrict__ scale, u16* __restrict__ dst, int lane) {
  float4 x[4];
#pragma unroll
  for (int i = 0; i < 4; ++i) x[i] = *(const float4*)(hrow + lane * 4 + 256 * i);
  float sm = 0.f;
#pragma unroll
  for (int i = 0; i < 4; ++i) sm += x[i].x + x[i].y + x[i].z + x[i].w;
  const float mean = wave_sum(sm) * (1.f / DM);
  float vs = 0.f;
#pragma unroll
  for (int i = 0; i < 4; ++i) { x[i].x -= mean; x[i].y -= mean; x[i].z -= mean; x[i].w -= mean; vs += x[i].x * x[i].x + x[i].y * x[i].y + x[i].z * x[i].z + x[i].w * x[i].w; }
  const float rs = rsqrtf(wave_sum(vs) * (1.f / DM) + LN_EPS);
#pragma unroll
  for (int i = 0; i < 4; ++i) {
    const float4 sh = *(const float4*)(shift + lane * 4 + 256 * i), sc = *(const float4*)(scale + lane * 4 + 256 * i);
    *(uint2*)(dst + lane * 4 + 256 * i) = make_uint2(cvtpk(x[i].x * rs * (1.f + sc.x) + sh.x, x[i].y * rs * (1.f + sc.y) + sh.y), cvtpk(x[i].z * rs * (1.f + sc.z) + sh.z, x[i].w * rs * (1.f + sc.w) + sh.w));
  }
}

template <int VD>
DI void attn_pass(const u16* __restrict__ qrow, const u16* __restrict__ Kb, int ldk, const u16* __restrict__ Vt, int nkeys, f32x16 (&O)[VD / 32], float& lsum, u16* lds) {
  constexpr int NV = VD / 32;
  const int tid = otid(), lane = tid & 63, r32 = lane & 31, h = lane >> 5;
  u16* Ks = lds; u16* Vs = lds + 64 * 72;
  bf16x8 qf[4];
#pragma unroll
  for (int s = 0; s < 4; ++s) qf[s] = *(const bf16x8*)(qrow + s * 16 + h * 8);
#pragma unroll
  for (int vb = 0; vb < NV; ++vb)
#pragma unroll
    for (int i = 0; i < 16; ++i) O[vb][i] = 0.f;
  float m = -INFINITY, l = 0.f;
  const float c = 0.125f * LOG2E;
  const int lr = tid >> 3, lc = (tid & 7) * 8;
  u32x4 rk[2], rv[NV];
#pragma unroll
  for (int i = 0; i < 2; ++i) rk[i] = *(const u32x4*)(Kb + (size_t)(lr + 32 * i) * ldk + lc);
#pragma unroll
  for (int i = 0; i < NV; ++i) rv[i] = *(const u32x4*)(Vt + (size_t)(lr + 32 * i) * NP + lc);
  for (int k0 = 0; k0 < nkeys; k0 += 64) {
    __syncthreads();
#pragma unroll
    for (int i = 0; i < 2; ++i) *(u32x4*)(Ks + (lr + 32 * i) * 72 + lc) = rk[i];
#pragma unroll
    for (int i = 0; i < NV; ++i) *(u32x4*)(Vs + (lr + 32 * i) * 72 + lc) = rv[i];
    __syncthreads();
    if (k0 + 64 < nkeys) {
#pragma unroll
      for (int i = 0; i < 2; ++i) rk[i] = *(const u32x4*)(Kb + (size_t)(k0 + 64 + lr + 32 * i) * ldk + lc);
#pragma unroll
      for (int i = 0; i < NV; ++i) rv[i] = *(const u32x4*)(Vt + (size_t)(lr + 32 * i) * NP + k0 + 64 + lc);
    }
    f32x16 S[2];
#pragma unroll
    for (int kb = 0; kb < 2; ++kb)
#pragma unroll
      for (int i = 0; i < 16; ++i) S[kb][i] = 0.f;
#pragma unroll
    for (int s = 0; s < 4; ++s)
#pragma unroll
      for (int kb = 0; kb < 2; ++kb) {
        const bf16x8 kf = *(const bf16x8*)(Ks + (kb * 32 + r32) * 72 + s * 16 + h * 8);
        S[kb] = MFMA32(kf, qf[s], S[kb]);
      }
    float mx = S[0][0];
#pragma unroll
    for (int kb = 0; kb < 2; ++kb)
#pragma unroll
      for (int i = 0; i < 16; ++i) mx = fmaxf(mx, S[kb][i]);
    mx = fmaxf(mx, SHX(mx, 32));
    if (__ballot(mx > m + 40.f) != 0ull) {
      const float mn = fmaxf(m, mx);
      const float alpha = fexp2((m - mn) * c);
      m = mn;
      l *= alpha;
#pragma unroll
      for (int vb = 0; vb < NV; ++vb)
#pragma unroll
        for (int i = 0; i < 16; ++i) O[vb][i] *= alpha;
    }
    const float mc = m * c;
    float rs = 0.f;
#pragma unroll
    for (int kb = 0; kb < 2; ++kb)
#pragma unroll
      for (int i = 0; i < 16; ++i) { const float pv = fexp2(S[kb][i] * c - mc); S[kb][i] = pv; rs += pv; }
    l += rs;
#pragma unroll
    for (int kb = 0; kb < 2; ++kb)
#pragma unroll
      for (int s2 = 0; s2 < 2; ++s2) {
        uint4 pw;
        pw.x = cvtpk(S[kb][8 * s2 + 0], S[kb][8 * s2 + 1]); pw.y = cvtpk(S[kb][8 * s2 + 2], S[kb][8 * s2 + 3]);
        pw.z = cvtpk(S[kb][8 * s2 + 4], S[kb][8 * s2 + 5]); pw.w = cvtpk(S[kb][8 * s2 + 6], S[kb][8 * s2 + 7]);
        const bf16x8 pf = __builtin_bit_cast(bf16x8, pw);
#pragma unroll
        for (int vb = 0; vb < NV; ++vb) {
          const u16* vp = Vs + (vb * 32 + r32) * 72 + kb * 32 + s2 * 16 + 4 * h;
          const s16x4 lo = *(const s16x4*)vp, hi = *(const s16x4*)(vp + 8);
          const bf16x8 vf = __builtin_shufflevector(lo, hi, 0, 1, 2, 3, 4, 5, 6, 7);
          O[vb] = MFMA32(vf, pf, O[vb]);
        }
      }
  }
  lsum = l + SHX(l, 32);
}

DI void attn_pass_gqa2(const u16* __restrict__ qrow0, const u16* __restrict__ qrow1, const u16* __restrict__ Kb, int ldk, const u16* __restrict__ Vt, int nkeys,
                       f32x16 (&O)[2][2], float (&lsum)[2], u16* lds) {
  const int tid = otid(), lane = tid & 63, r32 = lane & 31, h = lane >> 5;
  u16* Ks = lds; u16* Vs = lds + 64 * 72;
  bf16x8 qf[2][4];
#pragma unroll
  for (int s = 0; s < 4; ++s) { qf[0][s] = *(const bf16x8*)(qrow0 + s * 16 + h * 8); qf[1][s] = *(const bf16x8*)(qrow1 + s * 16 + h * 8); }
#pragma unroll
  for (int hd = 0; hd < 2; ++hd)
#pragma unroll
    for (int vb = 0; vb < 2; ++vb)
#pragma unroll
      for (int i = 0; i < 16; ++i) O[hd][vb][i] = 0.f;
  float m[2] = {-INFINITY, -INFINITY}, l[2] = {0.f, 0.f};
  const float c = 0.125f * LOG2E;
  const int lr = tid >> 3, lc = (tid & 7) * 8;
  u32x4 rk[2], rv[2];
#pragma unroll
  for (int i = 0; i < 2; ++i) rk[i] = *(const u32x4*)(Kb + (size_t)(lr + 32 * i) * ldk + lc);
#pragma unroll
  for (int i = 0; i < 2; ++i) rv[i] = *(const u32x4*)(Vt + (size_t)(lr + 32 * i) * NP + lc);
  for (int k0 = 0; k0 < nkeys; k0 += 64) {
    __syncthreads();
#pragma unroll
    for (int i = 0; i < 2; ++i) *(u32x4*)(Ks + (lr + 32 * i) * 72 + lc) = rk[i];
#pragma unroll
    for (int i = 0; i < 2; ++i) *(u32x4*)(Vs + (lr + 32 * i) * 72 + lc) = rv[i];
    __syncthreads();
    if (k0 + 64 < nkeys) {
#pragma unroll
      for (int i = 0; i < 2; ++i) rk[i] = *(const u32x4*)(Kb + (size_t)(k0 + 64 + lr + 32 * i) * ldk + lc);
#pragma unroll
      for (int i = 0; i < 2; ++i) rv[i] = *(const u32x4*)(Vt + (size_t)(lr + 32 * i) * NP + k0 + 64 + lc);
    }
#pragma unroll
    for (int hd = 0; hd < 2; ++hd) {
      f32x16 S[2];
#pragma unroll
      for (int kb = 0; kb < 2; ++kb)
#pragma unroll
        for (int i = 0; i < 16; ++i) S[kb][i] = 0.f;
#pragma unroll
      for (int s = 0; s < 4; ++s)
#pragma unroll
        for (int kb = 0; kb < 2; ++kb) {
          const bf16x8 kf = *(const bf16x8*)(Ks + (kb * 32 + r32) * 72 + s * 16 + h * 8);
          S[kb] = MFMA32(kf, qf[hd][s], S[kb]);
        }
      float mx = S[0][0];
#pragma unroll
      for (int kb = 0; kb < 2; ++kb)
#pragma unroll
        for (int i = 0; i < 16; ++i) mx = fmaxf(mx, S[kb][i]);
      mx = fmaxf(mx, SHX(mx, 32));
      if (__ballot(mx > m[hd] + 40.f) != 0ull) {
        const float mn = fmaxf(m[hd], mx);
        const float alpha = fexp2((m[hd] - mn) * c);
        m[hd] = mn;
        l[hd] *= alpha;
#pragma unroll
        for (int vb = 0; vb < 2; ++vb)
#pragma unroll
          for (int i = 0; i < 16; ++i) O[hd][vb][i] *= alpha;
      }
      const float mc = m[hd] * c;
      float rs = 0.f;
#pragma unroll
      for (int kb = 0; kb < 2; ++kb)
#pragma unroll
        for (int i = 0; i < 16; ++i) { const float pv = fexp2(S[kb][i] * c - mc); S[kb][i] = pv; rs += pv; }
      l[hd] += rs;
#pragma unroll
      for (int kb = 0; kb < 2; ++kb)
#pragma unroll
        for (int s2 = 0; s2 < 2; ++s2) {
          uint4 pw;
          pw.x = cvtpk(S[kb][8 * s2 + 0], S[kb][8 * s2 + 1]); pw.y = cvtpk(S[kb][8 * s2 + 2], S[kb][8 * s2 + 3]);
          pw.z = cvtpk(S[kb][8 * s2 + 4], S[kb][8 * s2 + 5]); pw.w = cvtpk(S[kb][8 * s2 + 6], S[kb][8 * s2 + 7]);
          const bf16x8 pf = __builtin_bit_cast(bf16x8, pw);
#pragma unroll
          for (int vb = 0; vb < 2; ++vb) {
            const u16* vp = Vs + (vb * 32 + r32) * 72 + kb * 32 + s2 * 16 + 4 * h;
            const s16x4 lo = *(const s16x4*)vp, hi = *(const s16x4*)(vp + 8);
            const bf16x8 vf = __builtin_shufflevector(lo, hi, 0, 1, 2, 3, 4, 5, 6, 7);
            O[hd][vb] = MFMA32(vf, pf, O[hd][vb]);
          }
        }
    }
  }
  lsum[0] = l[0] + SHX(l[0], 32);
  lsum[1] = l[1] + SHX(l[1], 32);
}

DI int chain_idx(int dir, int s) { return dir == 0 ? (s < SL ? s + SC : s - SL) : (SB - 1 - s); }
DI void mlstm_dir(const bf16x8 (&qf)[8], const u16* __restrict__ Kb, const u16* __restrict__ Vt, const float* __restrict__ Aarr, const float* __restrict__ tmax, int dir,
                  int t0a, int t0b, int t1a, int t1b, int cq, float mxq, f32x16 (&num)[4], float& den_out, char* smem) {
  const int tid = otid(), lane = tid & 63, r32 = lane & 31, h = lane >> 5;
  u16* Ks = (u16*)smem; u16* Vs = (u16*)(smem + 17408); float* As = (float*)(smem + 17408 + 18432);
  float den = 0.f;
  const int n0 = t0b - t0a, nall = n0 + (t1b - t1a);
  const int kr = tid >> 4, kc = (tid & 15) * 8, vr = tid >> 3, vc = (tid & 7) * 8;
  u32x4 rk[4], rv[4]; float ra = 0.f;
  int* tlist = (int*)(smem + 17408 + 18432 + 256);
  float* tred = (float*)(smem + 17408 + 18432 + 256 + 544);
  {
    float mn = fminf(mxq, SHX(mxq, 32));
    mn = fminf(mn, SHX(mn, 16)); mn = fminf(mn, SHX(mn, 8)); mn = fminf(mn, SHX(mn, 4)); mn = fminf(mn, SHX(mn, 2)); mn = fminf(mn, SHX(mn, 1));
    __syncthreads();
    if (lane == 0) tred[tid >> 6] = mn;
    __syncthreads();
    if (tid == 0) {
      const float bmin = fminf(fminf(tred[0], tred[1]), fminf(tred[2], tred[3]));
      int cnt = 0;
      for (int u = 0; u < nall; ++u) {
        const int k0 = u < n0 ? SL + 64 * (t0a + u) : 64 * (t1a + u - n0);
        if (tmax[k0 >> 6] * LOG2E - bmin > -64.f) tlist[1 + cnt++] = k0;
      }
      tlist[0] = cnt;
    }
    __syncthreads();
  }
  const int ntile = tlist[0];
  auto tile_k0 = [&](int u) { return tlist[1 + u]; };
  for (int u = 0; u < ntile; ++u) {
    const int k0 = tile_k0(u);
    __syncthreads();
    {
#pragma unroll
      for (int i = 0; i < 4; ++i) rk[i] = *(const u32x4*)(Kb + (size_t)(k0 + kr + 16 * i) * 512 + kc);
#pragma unroll
      for (int i = 0; i < 4; ++i) rv[i] = *(const u32x4*)(Vt + (size_t)(vr + 32 * i) * NP + k0 + vc);
      if (tid < 64) ra = Aarr[k0 + tid] * LOG2E;
#pragma unroll
      for (int i = 0; i < 4; ++i) *(u32x4*)(Ks + (kr + 16 * i) * 136 + kc) = rk[i];
#pragma unroll
      for (int i = 0; i < 4; ++i) *(u32x4*)(Vs + (vr + 32 * i) * 72 + vc) = rv[i];
      if (tid < 64) As[tid] = ra;
    }
    __syncthreads();
    f32x16 S[2];
#pragma unroll
    for (int kb = 0; kb < 2; ++kb)
#pragma unroll
      for (int i = 0; i < 16; ++i) S[kb][i] = 0.f;
#pragma unroll
    for (int s = 0; s < 8; ++s)
#pragma unroll
      for (int kb = 0; kb < 2; ++kb) {
        const bf16x8 kf = *(const bf16x8*)(Ks + (kb * 32 + r32) * 136 + s * 16 + h * 8);
        S[kb] = MFMA32(kf, qf[s], S[kb]);
      }
#pragma unroll
    for (int kb = 0; kb < 2; ++kb)
#pragma unroll
      for (int g = 0; g < 4; ++g) {
        const float4 a4 = *(const float4*)(As + kb * 32 + 8 * g + 4 * h);
        const float av[4] = {a4.x, a4.y, a4.z, a4.w};
#pragma unroll
        for (int e = 0; e < 4; ++e) {
          const int sk = k0 + kb * 32 + 8 * g + 4 * h + e;
          const int ck = chain_idx(dir, sk);
          const float w = (ck <= cq) ? fexp2(fminf(av[e] - mxq, 0.f)) : 0.f;
          const float pv = S[kb][4 * g + e] * w;
          S[kb][4 * g + e] = pv; den += pv;
        }
      }
#pragma unroll
    for (int kb = 0; kb < 2; ++kb)
#pragma unroll
      for (int s2 = 0; s2 < 2; ++s2) {
        uint4 pw;
        pw.x = cvtpk(S[kb][8 * s2 + 0], S[kb][8 * s2 + 1]); pw.y = cvtpk(S[kb][8 * s2 + 2], S[kb][8 * s2 + 3]);
        pw.z = cvtpk(S[kb][8 * s2 + 4], S[kb][8 * s2 + 5]); pw.w = cvtpk(S[kb][8 * s2 + 6], S[kb][8 * s2 + 7]);
        const bf16x8 pf = __builtin_bit_cast(bf16x8, pw);
#pragma unroll
        for (int vb = 0; vb < 4; ++vb) {
          const u16* vp = Vs + (vb * 32 + r32) * 72 + kb * 32 + s2 * 16 + 4 * h;
          const s16x4 lo = *(const s16x4*)vp, hi = *(const s16x4*)(vp + 8);
          const bf16x8 vf = __builtin_shufflevector(lo, hi, 0, 1, 2, 3, 4, 5, 6, 7);
          num[vb] = MFMA32(vf, pf, num[vb]);
        }
      }
  }
  den_out += den + SHX(den, 32);
}

DI void s5_load_u(const u16* __restrict__ S5U, int b, int lo, int g, float* lu, int lane) {
  const u16* src = S5U + ((size_t)b * SB + lo + lane) * 512 + g * 16;
  const uint4 a = *(const uint4*)src, c = *(const uint4*)(src + 8);
  float* d = lu + lane * 16;
  d[0] = bflo(a.x); d[1] = bfhi(a.x); d[2] = bflo(a.y); d[3] = bfhi(a.y); d[4] = bflo(a.z); d[5] = bfhi(a.z); d[6] = bflo(a.w); d[7] = bfhi(a.w);
  d[8] = bflo(c.x); d[9] = bfhi(c.x); d[10] = bflo(c.y); d[11] = bfhi(c.y); d[12] = bflo(c.z); d[13] = bfhi(c.z); d[14] = bflo(c.w); d[15] = bfhi(c.w);
}

DI void s5_bu_half(const u16* __restrict__ urow, const bf16x8 (&bfr)[4], u16* W, int r32, int h) {
  const bf16x8 af = *(const bf16x8*)urow;
#pragma unroll
  for (int j = 0; j < 4; ++j) {
    f32x16 z;
#pragma unroll
    for (int i = 0; i < 16; ++i) z[i] = 0.f;
    const f32x16 acc = MFMA32(af, bfr[j], z);
#pragma unroll
    for (int i = 0; i < 16; ++i) W[((i & 3) + 8 * (i >> 2) + 4 * h) * 136 + 32 * j + r32] = f2bf(acc[i]);
  }
}
template <bool WB>
DI void s5_scan_half(u16* W, int dir, int recol, float2 lam, float& hr, float& hi) {
#pragma unroll 4
  for (int q = 0; q < 32; ++q) {
    const int t = dir ? 31 - q : q;
    const float br = bf2f(W[t * 136 + recol]), bi = bf2f(W[t * 136 + recol + 32]);
    const float nr = lam.x * hr - lam.y * hi + br, ni = lam.x * hi + lam.y * hr + bi;
    hr = nr; hi = ni;
    if (WB) { W[t * 136 + recol] = f2bf(hr); W[t * 136 + recol + 32] = f2bf(hi); }
  }
}

__device__ const unsigned char PEER_PAIRS[64] = {0, 1, 2, 3, 4, 5, 6, 7, 8, 9, 10, 11, 12, 13, 14, 15, 16, 17, 18, 19, 20, 21, 22, 23, 32, 33, 34, 35, 36, 48, 49, 50, 51, 64, 65, 66, 80, 81, 96, 97, 112, 113, 128, 144, 160, 176, 192, 208, 224, 240, 0, 0, 0, 0, 0, 0, 0, 0, 0, 0, 0, 0, 0, 0};

constexpr int NPH_LAYER = 14;
constexpr int NPHASES = 2 + 2 * NPH_LAYER;

__device__ __forceinline__ void run_phase(const P& p, int ph, char* smem) {
  const int tid = otid(), lane = tid & 63, wave = tid >> 6;
  const int G = gridDim.x, bid = blockIdx.x;
  char* ws = WSP;
  float* fsm = (float*)smem;
  u16* usm = (u16*)smem;

  if (ph == 0) {
    const int n_mod = 2 * 8 * 24, n_s5 = 32, n_all = n_mod + n_s5 + 2;
    for (int it = bid; it < n_all; it += G) {
      if (it < n_mod) {
        const int L = it / 192, ic = (it / 24) % 8, jc = it % 24;
        __syncthreads();
        for (int e = tid; e < 5 * 128; e += 256) {
          const int v = e / 128, i = ic * 128 + (e % 128);
          const float cv = v < 4 ? IN(1)[v * DM + i] : IN(3)[i];
          fsm[e] = silu_(cv);
        }
        __syncthreads();
        const int j = jc * 256 + tid;
        const float* w = IN(4) + ((size_t)L * DM + ic * 128) * 6144 + j;
        float a0 = 0, a1 = 0, a2 = 0, a3 = 0, a4 = 0;
#pragma unroll 8
        for (int i = 0; i < 128; ++i) {
          const float wv = w[(size_t)i * 6144];
          a0 += fsm[i] * wv; a1 += fsm[128 + i] * wv; a2 += fsm[256 + i] * wv; a3 += fsm[384 + i] * wv; a4 += fsm[512 + i] * wv;
        }
        float* o = (float*)(ws + OFF_MODP) + ((size_t)(L * 8 + ic) * 5) * 6144 + j;
        o[0] = a0; o[6144] = a1; o[2 * 6144] = a2; o[3 * 6144] = a3; o[4 * 6144] = a4;
      } else if (it < n_mod + n_s5) {
        const int e = (it - n_mod) * 256 + tid;
        const int n = e & 63, g = (e >> 6) & 31, ld = e >> 11;
        const float dt = expf(IN(14)[ld * 32 + g]);
        const float ar = IN(12)[e], ai = IN(13)[e];
        const float mag = expf(ar * dt);
        float sn, cs; sincosf(ai * dt, &sn, &cs);
        const float lr = mag * cs, li = mag * sn;
        const float dn = ar * ar + ai * ai;
        const float cr = ((lr - 1.f) * ar + li * ai) / dn, ci = (li * ar - (lr - 1.f) * ai) / dn;
        ((float2*)(ws + OFF_LAMB))[e] = make_float2(lr, li);
        float2* bb = (float2*)(ws + OFF_BBAR) + (size_t)e * 16;
        const float* br = IN(15) + (size_t)e * 16; const float* bi = IN(16) + (size_t)e * 16;
        const int colre = n < 32 ? n : n + 32, colim = colre + 32;
        u16* bbt = (u16*)(ws + OFF_BBT) + (size_t)(e >> 6) * 2048;
        u16* cmt = (u16*)(ws + OFF_CMT) + (size_t)(e >> 6) * 2048;
        for (int c = 0; c < 16; ++c) {
          const float2 v = make_float2(cr * br[c] - ci * bi[c], cr * bi[c] + ci * br[c]);
          bb[c] = v;
          bbt[colre * 16 + c] = f2bf(v.x); bbt[colim * 16 + c] = f2bf(v.y);
          cmt[c * 128 + colre] = f2bf(IN(17)[((size_t)(e >> 6) * 16 + c) * 64 + n]);
          cmt[c * 128 + colim] = f2bf(-IN(18)[((size_t)(e >> 6) * 16 + c) * 64 + n]);
        }
      } else if (it == n_mod + n_s5 + 1) {
        for (int e = tid; e < 192 * 16; e += 256) {
          const int r = e >> 4, i = e & 15;
          const float inv = exp2f(-(float)i * (13.287712379549449f / 16.f));
          float sn, cs; sincosf((float)(r < 128 ? r : r - 128) * inv, &sn, &cs);
          ((float2*)(ws + OFF_ROPE))[e] = make_float2(cs, sn);
        }
      } else {
        if (tid >= 64 && tid < 72) ((int*)(ws + OFF_CTR))[tid - 64] = 0;
        if (tid < 2) {
          const float* lv = IN(8) + tid * 256;
          float s01 = 0.f, s23 = 0.f;
          for (int i = 0; i < 64; ++i) { s01 += lv[i] * lv[64 + i]; s23 += lv[128 + i] * lv[192 + i]; }
          const float lam_init = 0.8f - 0.6f * expf(-0.3f * (float)tid);
          ((float*)(ws + OFF_LAMV))[tid] = expf(s01) - expf(s23) + lam_init;
        }
      }
    }
    return;
  }
  if (ph == 1) {
    const int n_all = 2 * 5 * 6144 / 256;
    for (int it = bid; it < n_all; it += G) {
      const int e = it * 256 + tid;
      const int L = e / (5 * 6144), v = (e / 6144) % 5, j = e % 6144;
      float a = IN(5)[L * 6144 + j];
      for (int ic = 0; ic < 8; ++ic) a += ((const float*)(ws + OFF_MODP))[((size_t)(L * 8 + ic) * 5 + v) * 6144 + j];
      ((float*)(ws + OFF_MOD))[e] = a;
    }
    return;
  }
  const int L = (ph - 2) / NPH_LAYER, k = (ph - 2) % NPH_LAYER;
  u16* XM = (u16*)(ws + OFF_A);
  u16* WinT = (u16*)(ws + OFF_WIN);

  int* s_next = (int*)(smem + 57336);
#define FETCH_ITEM() ([&]() { __syncthreads(); if (otid() == 0) *s_next = atomicAdd(ctr, 1); __syncthreads(); return *s_next; }())
  if (k == 0) {
    const int n_win = 16 * 141, n_wbr = 4 * 8 * 16, n_wo = 256, n_wg = 128, n_wq = 512, n_sk = 16;
    const int n_w = n_win + n_wbr + n_wo + n_wg + n_wq + n_sk;
    const int n_all = n_w + NP / 4;
    for (int it = bid; it < n_all; it += G) {
      if (it < n_w) {
        int t = it;
        if (t < n_win) { transpose_tile(IN(6) + (size_t)L * DM * NIN, DM, NIN, WinT, t, fsm); continue; }
        t -= n_win;
        if (t < n_wbr) { const int kb = t / 128; transpose_tile(IN(26) + ((size_t)L * 4 + kb) * 512 * DM, 512, DM, (u16*)(ws + OFF_WBR) + (size_t)kb * DM * 512, t % 128, fsm); continue; }
        t -= n_wbr;
        if (t < n_wo) { transpose_tile(IN(27) + (size_t)L * DM * DM, DM, DM, (u16*)(ws + OFF_WO), t, fsm); continue; }
        t -= n_wo;
        if (t < n_wg) { transpose_tile<true>(IN(20) + (size_t)L * 512 * DM, 512, DM, (u16*)(ws + OFF_WGLU), t, fsm); continue; }
        t -= n_wg;
        if (t < n_wq) { transpose_tile(IN(32) + (size_t)L * DM * 2048, DM, 2048, (u16*)(ws + OFF_WQ), t, fsm); continue; }
        t -= n_wq;
        convert_chunk(IN(33) + (size_t)L * 32768, (u16*)(ws + OFF_SK), t);
      } else {
        const int pos = (it - n_w) * 4 + wave;
        const float* md = mod_ptr(p, L, pos);
        ln_mod_wave(h_in_ptr(p, L, pos), md, md + 1024, XM + (size_t)pos * DM, lane);
      }
    }
    return;
  }
  if (k == 1) {
    const int n_all = 264 * 39;
    for (int it = bid; it < n_all; it += G) {
      const int mt = it / 39, j = it % 39;
      f32x16 acc[2][2]; acc_zero(acc);
      if (j < 30) {
        int src; u16* dst; int ldd = 512, dcol;
        if (j < 4) { src = j * 128; dst = (u16*)(ws + OFF_QD); dcol = j * 128; }
        else if (j < 8) { src = 512 + (j - 4) * 128; dst = (u16*)(ws + OFF_KD); dcol = (j - 4) * 128; }
        else if (j < 12) { src = 1536 + (j - 8) * 128; dst = (u16*)(ws + OFF_S5U); dcol = (j - 8) * 128; }
        else if (j < 16) { src = 2048 + (j - 12) * 128; dst = (u16*)(ws + OFF_MQ); dcol = (j - 12) * 128; }
        else if (j < 20) { src = 2560 + (j - 16) * 128; dst = (u16*)(ws + OFF_MK); dcol = (j - 16) * 128; }
        else if (j < 24) { src = 3584 + (j - 20) * 128; dst = (u16*)(ws + OFF_MO); dcol = (j - 20) * 128; }
        else if (j < 28) { src = 4112 + (j - 24) * 128; dst = (u16*)(ws + OFF_QG); dcol = (j - 24) * 128; }
        else if (j == 28) { src = 4624; dst = (u16*)(ws + OFF_KG); dcol = 0; ldd = 128; }
        else { src = 4096; dst = nullptr; dcol = 0; }
        gemm_core(XM + (size_t)mt * 128 * DM, DM, WinT + (size_t)src * DM, DM, DM, acc, usm);
        if (j < 29) {
          EPI_LOOP(acc, { dst[(size_t)(mt * 128 + row) * ldd + dcol + col] = f2bf(val); })
        } else {
          float* mg = (float*)(ws + OFF_MGATE);
          EPI_LOOP(acc, { if (col < 16) mg[(size_t)(mt * 128 + row) * 16 + col] = val; })
        }
      } else {
        const int jj = j - 30;
        int src; u16* dst; int drow;
        if (jj < 4) { src = 1024 + jj * 128; dst = (u16*)(ws + OFF_VDT); drow = jj * 128; }
        else if (jj < 8) { src = 3072 + (jj - 4) * 128; dst = (u16*)(ws + OFF_MVT); drow = (jj - 4) * 128; }
        else { src = 4752; dst = (u16*)(ws + OFF_VGT); drow = 0; }
        gemm_core(WinT + (size_t)src * DM, DM, XM + (size_t)mt * 128 * DM, DM, DM, acc, usm);
        EPI_LOOP(acc, { dst[(size_t)(drow + row) * NP + mt * 128 + col] = f2bf(val); })
      }
    }
    return;
  }
  if (k == 2) {
    const int n_s5 = NB * 2 * 32 * 132 / 4;
    const int n_pp = NP / 4;
    const int n_all = n_pp + n_s5;
    for (int it = bid; it < n_all; it += G) {
      if (it < n_pp) {
        const int pos = it * 4 + wave, b = pos / SB, s = pos - b * SB;
        const bool lat = s < SL;
        const int rrow = s >> 6, rcol = 128 + (s & 63);
        if (lat) {
          const int vec = lane >> 2, half = (lane >> 1) & 1, i0 = (lane & 1) * 8;
          u16* base = (u16*)(ws + (vec < 8 ? OFF_QD : OFF_KD)) + (size_t)pos * 512 + (vec & 7) * 64 + half * 32 + i0;
          const u32x4 a = *(const u32x4*)base, b = *(const u32x4*)(base + 16);
          const float4* tb = (const float4*)((const float2*)(ws + OFF_ROPE) + (half ? rcol : rrow) * 16 + i0);
          const float4 t0 = tb[0], t1 = tb[1], t2 = tb[2], t3 = tb[3];
          const float x1[8] = {bflo(a.x), bfhi(a.x), bflo(a.y), bfhi(a.y), bflo(a.z), bfhi(a.z), bflo(a.w), bfhi(a.w)};
          const float x2[8] = {bflo(b.x), bfhi(b.x), bflo(b.y), bfhi(b.y), bflo(b.z), bfhi(b.z), bflo(b.w), bfhi(b.w)};
          const float cs[8] = {t0.x, t0.z, t1.x, t1.z, t2.x, t2.z, t3.x, t3.z};
          const float sn[8] = {t0.y, t0.w, t1.y, t1.w, t2.y, t2.w, t3.y, t3.w};
          float o1[8], o2[8];
#pragma unroll
          for (int e = 0; e < 8; ++e) { o1[e] = x1[e] * cs[e] - x2[e] * sn[e]; o2[e] = x2[e] * cs[e] + x1[e] * sn[e]; }
          u32x4 w1, w2;
          w1.x = cvtpk(o1[0], o1[1]); w1.y = cvtpk(o1[2], o1[3]); w1.z = cvtpk(o1[4], o1[5]); w1.w = cvtpk(o1[6], o1[7]);
          w2.x = cvtpk(o2[0], o2[1]); w2.y = cvtpk(o2[2], o2[3]); w2.z = cvtpk(o2[4], o2[5]); w2.w = cvtpk(o2[6], o2[7]);
          *(u32x4*)base = w1; *(u32x4*)(base + 16) = w2;
        }
        {
          const int c = lane & 7, hh = c >> 2, ie = (c & 1) * 8;
          const float4* tb = (const float4*)((const float2*)(ws + OFF_ROPE) + (hh ? rcol : rrow) * 16 + ie);
          const float4 t0 = tb[0], t1 = tb[1], t2 = tb[2], t3 = tb[3];
          const float cs[8] = {t0.x, t0.z, t1.x, t1.z, t2.x, t2.z, t3.x, t3.z};
          const float sn[8] = {t0.y, t0.w, t1.y, t1.w, t2.y, t2.w, t3.y, t3.w};
#pragma unroll
          for (int rnd = 0; rnd < 2; ++rnd) {
            const bool act = rnd == 0 || lane < 16;
            const int vec = lane >> 3;
            u16* ptr = rnd == 0 ? (u16*)(ws + OFF_QG) + (size_t)pos * 512 + vec * 64 + c * 8 : (u16*)(ws + OFF_KG) + (size_t)pos * 128 + (vec & 1) * 64 + c * 8;
            const float* gp = (rnd == 0 ? IN(10) : IN(11)) + L * 64 + c * 8;
            const u32x4 a = *(const u32x4*)ptr;
            const float4 g0 = *(const float4*)gp, g1 = *(const float4*)(gp + 4);
            float x[8] = {bflo(a.x), bfhi(a.x), bflo(a.y), bfhi(a.y), bflo(a.z), bfhi(a.z), bflo(a.w), bfhi(a.w)};
            float ss = 0.f;
#pragma unroll
            for (int e = 0; e < 8; ++e) ss += x[e] * x[e];
            ss += SHX(ss, 1); ss += SHX(ss, 2); ss += SHX(ss, 4);
            const float rs = rsqrtf(ss * (1.f / 64.f) + LN_EPS);
            const float gg[8] = {g0.x, g0.y, g0.z, g0.w, g1.x, g1.y, g1.z, g1.w};
            float y[8];
#pragma unroll
            for (int e = 0; e < 8; ++e) y[e] = x[e] * rs * gg[e];
            if (lat) {
#pragma unroll
              for (int e = 0; e < 8; ++e) {
                const float yp = SHX(y[e], 2);
                x[e] = (c & 2) ? (y[e] * cs[e] + yp * sn[e]) : (y[e] * cs[e] - yp * sn[e]);
              }
#pragma unroll
              for (int e = 0; e < 8; ++e) y[e] = x[e];
            }
            if (act) { u32x4 w; w.x = cvtpk(y[0], y[1]); w.y = cvtpk(y[2], y[3]); w.z = cvtpk(y[4], y[5]); w.w = cvtpk(y[6], y[7]); *(u32x4*)ptr = w; }
          }
        }
        {
          const int seg_lo = lat ? 0 : SL, seg_hi = lat ? SL - 1 : SB - 1;
#pragma unroll
          for (int q = 0; q < 4; ++q) {
            const int ch = (lane + 64 * q) * 4;
            const u16* raw = (const u16*)(ws + (ch < 512 ? OFF_MQ : OFF_MK)) + (ch & 511);
            const uint2 xc = *(const uint2*)(raw + (size_t)pos * 512);
            uint2 xm = make_uint2(0, 0), xp = make_uint2(0, 0);
            if (s > seg_lo) xm = *(const uint2*)(raw + (size_t)(pos - 1) * 512);
            if (s < seg_hi) xp = *(const uint2*)(raw + (size_t)(pos + 1) * 512);
            const float* cw = IN(22) + (size_t)L * 3 * 1024 + ch; const float* cb = IN(23) + (size_t)L * 1024 + ch;
            const float4 w0 = *(const float4*)cw, w1 = *(const float4*)(cw + 1024), w2 = *(const float4*)(cw + 2048), bb = *(const float4*)cb;
            float o0 = bb.x + w0.x * bflo(xm.x) + w1.x * bflo(xc.x) + w2.x * bflo(xp.x);
            float o1 = bb.y + w0.y * bfhi(xm.x) + w1.y * bfhi(xc.x) + w2.y * bfhi(xp.x);
            float o2 = bb.z + w0.z * bflo(xm.y) + w1.z * bflo(xc.y) + w2.z * bflo(xp.y);
            float o3 = bb.w + w0.w * bfhi(xm.y) + w1.w * bfhi(xc.y) + w2.w * bfhi(xp.y);
            const float ksc = ch < 512 ? 1.f : 0.08838834764831845f;
            o0 = silu_(o0) * ksc; o1 = silu_(o1) * ksc; o2 = silu_(o2) * ksc; o3 = silu_(o3) * ksc;
            u16* dstc = (u16*)(ws + OFF_A) + (ch < 512 ? (size_t)0 : (size_t)NP * 512) + (size_t)pos * 512 + (ch & 511);
            *(uint2*)dstc = make_uint2(cvtpk(o0, o1), cvtpk(o2, o3));
          }
        }
        if (lane < 16) {
          const float g = ((const float*)(ws + OFF_MGATE))[(size_t)pos * 16 + lane] + IN(24)[L * 16 + lane];
          const int type = lane >> 2, head = lane & 3, dir = type >> 1;
          const int chain = dir * 16 + b * 4 + head;
          if (type & 1) ((float*)(ws + OFF_GF))[(size_t)chain * SB + s] = fminf(g, 0.f) - log1pf(expf(-fabsf(g)));
          else ((float*)(ws + OFF_GI))[(size_t)chain * SB + s] = g;
        }
      } else {
        const int item = (it - n_pp) * 4 + wave;
        const int kk = item % 132, g = (item / 132) & 31, dir = (item / (132 * 32)) & 1, b = item / (132 * 64);
        const int lo = dir == 0 ? (kk < 4 ? SL + 64 * kk : 64 * (kk - 4)) : (kk < 4 ? SL + 192 - 64 * kk : 8128 - 64 * (kk - 4));
        const int r32 = lane & 31, h = lane >> 5;
        const int ldg = (L * 2 + dir) * 32 + g;
        u16* W = usm + wave * 4352;
        __syncthreads();
        const float2 lam = ((const float2*)(ws + OFF_LAMB))[ldg * 64 + lane];
        bf16x8 bfr[4];
#pragma unroll
        for (int j = 0; j < 4; ++j) bfr[j] = *(const bf16x8*)((const u16*)(ws + OFF_BBT) + ((size_t)ldg * 128 + 32 * j + r32) * 16 + 8 * h);
        const int recol = lane < 32 ? lane : lane + 32;
        float hr = 0.f, hi = 0.f;
#pragma unroll 1
        for (int hq = 0; hq < 2; ++hq) {
          const int hh = dir ? 1 - hq : hq;
          s5_bu_half((const u16*)(ws + OFF_S5U) + ((size_t)b * SB + lo + 32 * hh + r32) * 512 + g * 16 + 8 * h, bfr, W, r32, h);
          s5_scan_half<false>(W, dir, recol, lam, hr, hi);
        }
        ((float2*)(ws + OFF_HEND))[(size_t)item * 64 + lane] = make_float2(hr, hi);
      }
    }
    return;
  }
  if (k == 3) {
    const int n_all = 32 + 64 + 1056;
    for (int it = bid; it < n_all; it += G) {
      if (it >= 96) {
        const int i2 = it - 96, chain = i2 / 33, j = i2 % 33, dir = chain >> 4, b = (chain >> 2) & 3, head = chain & 3;
        const int p0 = j == 0 ? SL : (dir == 0 ? 256 * (j - 1) : SL - 256 * j);
        const int r32 = lane & 31, h = lane >> 5;
        u16* Ks = usm;
        float* wS = fsm + 4352;
        float* red = fsm + 4352 + 256;
        __syncthreads();
        {
          const int so = dir == 0 ? tid : 255 - tid;
          const float lf = ((const float*)(ws + OFF_GF))[(size_t)chain * SB + p0 + so];
          const float ig = ((const float*)(ws + OFF_GI))[(size_t)chain * SB + p0 + so];
          float x = lf;
#pragma unroll
          for (int d = 1; d < 64; d <<= 1) { const float y = __int_as_float(__builtin_amdgcn_ds_bpermute(((lane - d) & 63) << 2, __float_as_int(x))); if (lane >= d) x += y; }
          if (lane == 63) red[wave] = x;
          __syncthreads();
          float off = 0.f;
          for (int w = 0; w < wave; ++w) off += red[w];
          const float aloc = ig - (x + off);
          const float mx = wave_max(aloc);
          if (lane == 0) red[4 + wave] = mx;
          __syncthreads();
          const float am = fmaxf(fmaxf(red[4], red[5]), fmaxf(red[6], red[7]));
          wS[so] = __expf(aloc - am);
          if (tid == 0) ((float*)(ws + OFF_ALOC))[i2] = am;
        }
        f32x16 acc[4];
#pragma unroll
        for (int vb = 0; vb < 4; ++vb)
#pragma unroll
          for (int i = 0; i < 16; ++i) acc[vb][i] = 0.f;
        float nacc = 0.f;
        const u16* Kg = (const u16*)(ws + OFF_A) + (size_t)NP * 512 + ((size_t)b * SB + p0) * 512 + head * 128;
        const u16* Vg = (const u16*)(ws + OFF_MVT) + (size_t)(head * 128) * NP + (size_t)b * SB + p0;
#pragma unroll 1
        for (int sub = 0; sub < 4; ++sub) {
          __syncthreads();
          {
            const int kr = tid >> 4, kc = (tid & 15) * 8;
#pragma unroll
            for (int i = 0; i < 4; ++i) *(u32x4*)(Ks + (kr + 16 * i) * 136 + kc) = *(const u32x4*)(Kg + (size_t)(sub * 64 + kr + 16 * i) * 512 + kc);
          }
          __syncthreads();
#pragma unroll
          for (int s16 = 0; s16 < 4; ++s16) {
            float kv[8];
#pragma unroll
            for (int jj = 0; jj < 8; ++jj) {
              const int sl = 16 * s16 + 8 * h + jj;
              kv[jj] = bf2f(Ks[sl * 136 + 32 * wave + r32]) * wS[sub * 64 + sl];
              nacc += kv[jj];
            }
            u32x4 aw; aw.x = cvtpk(kv[0], kv[1]); aw.y = cvtpk(kv[2], kv[3]); aw.z = cvtpk(kv[4], kv[5]); aw.w = cvtpk(kv[6], kv[7]);
            const bf16x8 af = __builtin_bit_cast(bf16x8, aw);
#pragma unroll
            for (int vb = 0; vb < 4; ++vb) {
              const bf16x8 vf = *(const bf16x8*)(Vg + (size_t)(32 * vb + r32) * NP + sub * 64 + 16 * s16 + 8 * h);
              acc[vb] = MFMA32(af, vf, acc[vb]);
            }
          }
        }
        u16* Gd = (u16*)(ws + OFF_GST) + (size_t)i2 * 16384;
#pragma unroll
        for (int vb = 0; vb < 4; ++vb)
#pragma unroll
          for (int g = 0; g < 4; ++g)
            *(uint2*)(Gd + (size_t)(32 * vb + r32) * 128 + 32 * wave + 8 * g + 4 * h) = make_uint2(cvtpk(acc[vb][4 * g], acc[vb][4 * g + 1]), cvtpk(acc[vb][4 * g + 2], acc[vb][4 * g + 3]));
        nacc += SHX(nacc, 32);
        if (h == 0) ((float*)(ws + OFF_NST))[(size_t)i2 * 128 + 32 * wave + r32] = nacc;
      } else if (it < 32) {
        const int chain = it, dir = chain >> 4;
        const float* gi = (const float*)(ws + OFF_GI) + (size_t)chain * SB;
        const float* gf = (const float*)(ws + OFF_GF) + (size_t)chain * SB;
        auto spos = [&](int c) { return dir == 0 ? (c < SC ? SL + c : c - SC) : (SB - 1 - c); };
        float tot = 0.f;
        for (int j = 0; j < 33; ++j) tot += gf[spos(tid * 33 + j)];
        __syncthreads();
        fsm[tid] = tot;
        __syncthreads();
        float pre = 0.f;
        for (int i = 0; i < tid; ++i) pre += fsm[i];
        float F = pre, lm = -INFINITY;
        for (int j = 0; j < 33; ++j) { const int sp = spos(tid * 33 + j); F += gf[sp]; lm = fmaxf(lm, gi[sp] - F); }
        __syncthreads();
        fsm[256 + tid] = lm;
        __syncthreads();
        float pm = 0.f;
        for (int i = 0; i < tid; ++i) pm = fmaxf(pm, fsm[256 + i]);
        F = pre;
        for (int j = 0; j < 33; ++j) {
          const int sp = spos(tid * 33 + j);
          F += gf[sp];
          const float a = gi[sp] - F;
          pm = fmaxf(pm, a);
          ((float*)(ws + OFF_AA))[(size_t)chain * SB + sp] = a;
          ((float*)(ws + OFF_MXA))[(size_t)chain * SB + sp] = pm;
          ((float*)(ws + OFF_MTA))[(size_t)chain * SB + sp] = F + pm;
        }
        __threadfence_block();
        __syncthreads();
        if (tid < 132) {
          const float* aa = (const float*)(ws + OFF_AA) + (size_t)chain * SB + tid * 64;
          float mxv = aa[0];
          for (int j = 1; j < 64; ++j) mxv = fmaxf(mxv, aa[j]);
          ((float*)(ws + OFF_TMAX))[chain * 132 + tid] = mxv;
        }
      } else {
        const int item = (it - 32) * 4 + wave;
        const int g = item & 31, dir = (item >> 5) & 1;
        float2 lam = ((const float2*)(ws + OFF_LAMB))[((L * 2 + dir) * 32 + g) * 64 + lane];
#pragma unroll
        for (int q = 0; q < 6; ++q) lam = make_float2(lam.x * lam.x - lam.y * lam.y, 2.f * lam.x * lam.y);
        float cr = 0.f, ci = 0.f;
        const float2* he = (const float2*)(ws + OFF_HEND) + (size_t)item * 132 * 64 + lane;
        float2* ca = (float2*)(ws + OFF_CARRY) + (size_t)item * 132 * 64 + lane;
#pragma unroll 1
        for (int kk0 = 0; kk0 < 132; kk0 += 12) {
          float2 e[12];
#pragma unroll
          for (int j = 0; j < 12; ++j) e[j] = he[(kk0 + j) * 64];
#pragma unroll
          for (int j = 0; j < 12; ++j) {
            ca[(kk0 + j) * 64] = make_float2(cr, ci);
            const float nr = lam.x * cr - lam.y * ci + e[j].x, ni = lam.x * ci + lam.y * cr + e[j].y;
            cr = nr; ci = ni;
          }
        }
      }
    }
    return;
  }
  if (k == 13) {
    const int n_all = 32 * 9;
    for (int it = bid; it < n_all; it += G) {
      const int chain = it / 9, e = it % 9, dir = chain >> 4;
      const float* gi = (const float*)(ws + OFF_GI) + (size_t)chain * SB;
      const float* aa = (const float*)(ws + OFF_AA) + (size_t)chain * SB;
      float st[8];
#pragma unroll
      for (int i = 0; i < 8; ++i) st[i] = 0.f;
      float B = -INFINITY;
      const bool isn = e == 8;
      if (isn && tid >= 16) continue;
      const size_t eo = isn ? (size_t)tid * 8 : (size_t)e * 2048 + tid * 8;
#pragma unroll 1
      for (int kk0 = 0; kk0 < 33; kk0 += 11) {
        uint4 gm[11]; float4 gn0[11], gn1[11]; float Av[11];
#pragma unroll
        for (int j = 0; j < 11; ++j) {
          const int kk = kk0 + j, ci = chain * 33 + kk;
          if (isn) { const float* g = (const float*)(ws + OFF_NST) + (size_t)ci * 128 + eo; gn0[j] = *(const float4*)g; gn1[j] = *(const float4*)(g + 4); }
          else gm[j] = *(const uint4*)((const u16*)(ws + OFF_GST) + (size_t)ci * 16384 + eo);
          float fst = 0.f;
          if (kk > 0) { const int c = 256 * kk - 1; const int sp = dir == 0 ? (c < SC ? SL + c : c - SC) : (SB - 1 - c); fst = gi[sp] - aa[sp]; }
          Av[j] = ((const float*)(ws + OFF_ALOC))[ci] - fst;
        }
#pragma unroll
        for (int j = 0; j < 11; ++j) {
          const int ci = chain * 33 + kk0 + j;
          if (isn) {
            *(uint4*)((u16*)(ws + OFF_NPST) + (size_t)ci * 128 + eo) = make_uint4(cvtpk(st[0], st[1]), cvtpk(st[2], st[3]), cvtpk(st[4], st[5]), cvtpk(st[6], st[7]));
            if (tid == 0) ((float*)(ws + OFF_BKA))[ci] = B;
          } else {
            *(uint4*)((u16*)(ws + OFF_PST) + (size_t)ci * 16384 + eo) = make_uint4(cvtpk(st[0], st[1]), cvtpk(st[2], st[3]), cvtpk(st[4], st[5]), cvtpk(st[6], st[7]));
          }
          const float A = Av[j];
          const float Bn = fmaxf(B, A);
          const float f1 = __expf(B - Bn), f2 = __expf(A - Bn);
          B = Bn;
          if (isn) {
            const float4 g0 = gn0[j], g1 = gn1[j];
            st[0] = f1 * st[0] + f2 * g0.x; st[1] = f1 * st[1] + f2 * g0.y; st[2] = f1 * st[2] + f2 * g0.z; st[3] = f1 * st[3] + f2 * g0.w;
            st[4] = f1 * st[4] + f2 * g1.x; st[5] = f1 * st[5] + f2 * g1.y; st[6] = f1 * st[6] + f2 * g1.z; st[7] = f1 * st[7] + f2 * g1.w;
          } else {
            const uint4 g = gm[j];
            st[0] = f1 * st[0] + f2 * bflo(g.x); st[1] = f1 * st[1] + f2 * bfhi(g.x); st[2] = f1 * st[2] + f2 * bflo(g.y); st[3] = f1 * st[3] + f2 * bfhi(g.y);
            st[4] = f1 * st[4] + f2 * bflo(g.z); st[5] = f1 * st[5] + f2 * bfhi(g.z); st[6] = f1 * st[6] + f2 * bflo(g.w); st[7] = f1 * st[7] + f2 * bfhi(g.w);
          }
        }
      }
    }
    return;
  }
  if (k == 4) {
    const int n_diff = NB * 4 * 66, n_ml = NB * 4 * 66, n_gqa = NB * 4 * 66, n_s5 = NB * 32 * 132 / 4;
    const int n_all = n_diff + n_ml + n_gqa + n_s5;
    const int r32 = lane & 31, h = lane >> 5;
    int* ctr = (int*)(ws + OFF_CTR) + L;
    int it = FETCH_ITEM();
    for (; it < n_diff; it = FETCH_ITEM()) {
      {
        const int qt = it % 66, head = (it / 66) & 3, b = it / (66 * 4);
        const int s = qt * 128 + wave * 32 + r32, pos = b * SB + s;
        const int kbeg = qt < 64 ? 0 : SL, nkeys = qt < 64 ? SB : SC;
        u16* qd = (u16*)(ws + OFF_QD) + (size_t)pos * 512 + head * 128;
        const float lam = ((const float*)(ws + OFF_LAMV))[L];
        const float lam_init = 0.8f - 0.6f * expf(-0.3f * (float)L);
        f32x16 R[4], O[4]; float lsum;
        attn_pass<128>(qd, (const u16*)(ws + OFF_KD) + ((size_t)b * SB + kbeg) * 512 + head * 128, 512,
                       (const u16*)(ws + OFF_VDT) + (size_t)(head * 128) * NP + (size_t)b * SB + kbeg, nkeys, R, lsum, usm);
        float* stash = (float*)(ws + OFF_STASH) + ((size_t)bid * 256 + otid()) * 64;
        {
          const float il = 1.f / lsum;
#pragma unroll
          for (int vb = 0; vb < 4; ++vb)
#pragma unroll
            for (int i = 0; i < 16; ++i) stash[vb * 16 + i] = R[vb][i] * il;
        }
        attn_pass<128>(qd + 64, (const u16*)(ws + OFF_KD) + ((size_t)b * SB + kbeg) * 512 + head * 128 + 64, 512,
                       (const u16*)(ws + OFF_VDT) + (size_t)(head * 128) * NP + (size_t)b * SB + kbeg, nkeys, O, lsum, usm);
        float ss = 0.f;
        {
          const float il = lam / lsum;
#pragma unroll
          for (int vb = 0; vb < 4; ++vb)
#pragma unroll
            for (int i = 0; i < 16; ++i) { R[vb][i] = stash[vb * 16 + i] - O[vb][i] * il; ss += R[vb][i] * R[vb][i]; }
        }
        ss += SHX(ss, 32);
        const float rn = rsqrtf(ss * (1.f / 128.f) + LN_EPS) * (1.f - lam_init);
        const float* ng = IN(9) + L * 128;
#pragma unroll
        for (int vb = 0; vb < 4; ++vb)
#pragma unroll
          for (int g = 0; g < 4; ++g) {
            const int v0 = vb * 32 + 8 * g + 4 * h;
            const float4 gg = *(const float4*)(ng + v0);
            *(uint2*)(qd + v0) = make_uint2(cvtpk(R[vb][4 * g] * rn * gg.x, R[vb][4 * g + 1] * rn * gg.y), cvtpk(R[vb][4 * g + 2] * rn * gg.z, R[vb][4 * g + 3] * rn * gg.w));
          }
      }
    }
    for (; it < n_diff + n_ml; it = FETCH_ITEM()) {
      {
        const int i2 = it - n_diff;
        const int qt = i2 % 66, head = (i2 / 66) & 3, b = i2 / (66 * 4);
        const int tidm = otid(), lane = tidm & 63, wave = tidm >> 6, r32 = lane & 31, h = lane >> 5;
        const int s = qt * 128 + wave * 32 + r32, pos = b * SB + s;
        bf16x8 qf[8];
        {
          const u16* qrow = (const u16*)(ws + OFF_A) + (size_t)pos * 512 + head * 128;
#pragma unroll
          for (int q = 0; q < 8; ++q) qf[q] = *(const bf16x8*)(qrow + q * 16 + h * 8);
        }
        const u16* Kb = (const u16*)(ws + OFF_A) + (size_t)NP * 512 + (size_t)b * SB * 512 + head * 128;
        const u16* Vt = (const u16*)(ws + OFF_MVT) + (size_t)(head * 128) * NP + (size_t)b * SB;
        f32x16 num[4];
        float* stash = (float*)(ws + OFF_STASH) + ((size_t)bid * 256 + otid()) * 64;
#pragma unroll 1
        for (int dir = 0; dir < 2; ++dir) {
          const int chain = dir * 16 + b * 4 + head;
          const float* Aarr = (const float*)(ws + OFF_AA) + (size_t)chain * SB;
          const float mxq = ((const float*)(ws + OFF_MXA))[(size_t)chain * SB + s] * LOG2E;
          const float mt = ((const float*)(ws + OFF_MTA))[(size_t)chain * SB + s];
          const int cq = chain_idx(dir, s);
          int t0a, t0b, t1a, t1b, kch = 0;
          if (qt < 64) { const int kq = qt >> 1; t0a = 0; t0b = 0; if (dir == 0) { t1a = 4 * kq; t1b = 2 * qt + 2; kch = 1 + kq; } else { t1a = 2 * qt; t1b = 4 * kq + 4; kch = 32 - kq; } }
          else { const int cqt = qt - 64; t1a = 0; t1b = 0; if (dir == 0) { t0a = 0; t0b = 2 * cqt + 2; } else { t0a = 2 * cqt; t0b = 4; } }
          float den = 0.f;
          if (kch > 0) {
            const int ci = chain * 33 + kch;
            const float et = fexp2(fminf(((const float*)(ws + OFF_BKA))[ci] * LOG2E - mxq, 0.f));
            const u16* Pp = (const u16*)(ws + OFF_PST) + (size_t)ci * 16384;
#pragma unroll
            for (int vb = 0; vb < 4; ++vb) {
#pragma unroll
              for (int i = 0; i < 16; ++i) num[vb][i] = 0.f;
#pragma unroll
              for (int q = 0; q < 8; ++q) {
                const bf16x8 pf = *(const bf16x8*)(Pp + (size_t)(32 * vb + r32) * 128 + 16 * q + 8 * h);
                num[vb] = MFMA32(pf, qf[q], num[vb]);
              }
#pragma unroll
              for (int i = 0; i < 16; ++i) num[vb][i] *= et;
              __builtin_amdgcn_sched_barrier(0);
            }
            const u16* np = (const u16*)(ws + OFF_NPST) + (size_t)ci * 128;
            float dp = 0.f;
#pragma unroll
            for (int q = 0; q < 8; ++q) {
              const bf16x8_t qv = __builtin_bit_cast(bf16x8_t, qf[q]);
              const bf16x8_t nv = *(const bf16x8_t*)(np + 16 * q + 8 * h);
              dp = __builtin_amdgcn_fdot2_f32_bf16(__builtin_shufflevector(qv, qv, 0, 1), __builtin_shufflevector(nv, nv, 0, 1), dp, false);
              dp = __builtin_amdgcn_fdot2_f32_bf16(__builtin_shufflevector(qv, qv, 2, 3), __builtin_shufflevector(nv, nv, 2, 3), dp, false);
              dp = __builtin_amdgcn_fdot2_f32_bf16(__builtin_shufflevector(qv, qv, 4, 5), __builtin_shufflevector(nv, nv, 4, 5), dp, false);
              dp = __builtin_amdgcn_fdot2_f32_bf16(__builtin_shufflevector(qv, qv, 6, 7), __builtin_shufflevector(nv, nv, 6, 7), dp, false);
            }
            dp += SHX(dp, 32);
            den = et * dp;
          } else {
#pragma unroll
            for (int vb = 0; vb < 4; ++vb)
#pragma unroll
              for (int i = 0; i < 16; ++i) num[vb][i] = 0.f;
          }
          mlstm_dir(qf, Kb, Vt, Aarr, (const float*)(ws + OFF_TMAX) + chain * 132, dir, t0a, t0b, t1a, t1b, cq, mxq, num, den, smem);
          const float dd = 1.f / fmaxf(fabsf(den), expf(-mt));
          if (dir == 0) {
#pragma unroll
            for (int vb = 0; vb < 4; ++vb)
#pragma unroll
              for (int i = 0; i < 16; ++i) stash[vb * 16 + i] = num[vb][i] * dd;
          } else {
            float ss = 0.f;
#pragma unroll
            for (int vb = 0; vb < 4; ++vb)
#pragma unroll
              for (int i = 0; i < 16; ++i) { num[vb][i] = stash[vb * 16 + i] + num[vb][i] * dd; ss += num[vb][i] * num[vb][i]; }
            ss += SHX(ss, 32);
            const float rn = rsqrtf(ss * (1.f / 128.f) + LN_EPS);
            const float* ng = IN(25) + L * 512 + head * 128;
            u16* mo = (u16*)(ws + OFF_MO) + (size_t)pos * 512 + head * 128;
#pragma unroll
            for (int vb = 0; vb < 4; ++vb)
#pragma unroll
              for (int g = 0; g < 4; ++g) {
                const int v0 = vb * 32 + 8 * g + 4 * h;
                const float4 gg = *(const float4*)(ng + v0);
                const uint2 ov = *(const uint2*)(mo + v0);
                const float y0 = num[vb][4 * g] * rn * gg.x * sigmoidf_(bflo(ov.x)), y1 = num[vb][4 * g + 1] * rn * gg.y * sigmoidf_(bfhi(ov.x));
                const float y2 = num[vb][4 * g + 2] * rn * gg.z * sigmoidf_(bflo(ov.y)), y3 = num[vb][4 * g + 3] * rn * gg.w * sigmoidf_(bfhi(ov.y));
                *(uint2*)(mo + v0) = make_uint2(cvtpk(y0, y1), cvtpk(y2, y3));
              }
          }
        }
      }
    }
    for (; it < n_diff + n_ml + n_gqa; it = FETCH_ITEM()) {
      {
        const int i2 = it - n_diff - n_ml;
        const int qt = i2 % 66, hp = (i2 / 66) & 3, b = i2 / (66 * 4);
        const int kv = hp >> 1;
        const int s = qt * 128 + wave * 32 + r32, pos = b * SB + s;
        const int kbeg = qt < 64 ? 0 : SL, nkeys = qt < 64 ? SB : SC;
        u16* qg = (u16*)(ws + OFF_QG) + (size_t)pos * 512 + hp * 128;
        f32x16 O[2][2]; float lsum[2];
        attn_pass_gqa2(qg, qg + 64, (const u16*)(ws + OFF_KG) + ((size_t)b * SB + kbeg) * 128 + kv * 64, 128,
                       (const u16*)(ws + OFF_VGT) + (size_t)(kv * 64) * NP + (size_t)b * SB + kbeg, nkeys, O, lsum, usm);
#pragma unroll
        for (int hd = 0; hd < 2; ++hd) {
          const float il = 1.f / lsum[hd];
#pragma unroll
          for (int vb = 0; vb < 2; ++vb)
#pragma unroll
            for (int g = 0; g < 4; ++g) {
              const int v0 = vb * 32 + 8 * g + 4 * h;
              *(uint2*)(qg + hd * 64 + v0) = make_uint2(cvtpk(O[hd][vb][4 * g] * il, O[hd][vb][4 * g + 1] * il), cvtpk(O[hd][vb][4 * g + 2] * il, O[hd][vb][4 * g + 3] * il));
            }
        }
      }
    }
    for (; it < n_all; it = FETCH_ITEM()) {
      {
        const int item = (it - n_diff - n_ml - n_gqa) * 4 + wave;
        const int T = item % 132, g = (item / 132) & 31, b = item / (132 * 32);
        u16* W = usm + wave * 4352;
        const int recol = lane < 32 ? lane : lane + 32;
        const size_t pos0 = (size_t)b * SB + 64 * T;
        __syncthreads();
        f32x16 ycc[2];
#pragma unroll
        for (int hh = 0; hh < 2; ++hh)
#pragma unroll
          for (int i = 0; i < 16; ++i) ycc[hh][i] = 0.f;
#pragma unroll 1
        for (int dir = 0; dir < 2; ++dir) {
          const int kk = dir == 0 ? (T < 128 ? T + 4 : T - 128) : (T < 128 ? 4 + 127 - T : 3 - (T - 128));
          const int ldg = (L * 2 + dir) * 32 + g;
          const float2 lam = ((const float2*)(ws + OFF_LAMB))[ldg * 64 + lane];
          bf16x8 bfr[4];
#pragma unroll
          for (int j = 0; j < 4; ++j) bfr[j] = *(const bf16x8*)((const u16*)(ws + OFF_BBT) + ((size_t)ldg * 128 + 32 * j + r32) * 16 + 8 * h);
          const float2 cy = ((const float2*)(ws + OFF_CARRY))[((size_t)((b * 2 + dir) * 32 + g) * 132 + kk) * 64 + lane];
          float hr = cy.x, hi = cy.y;
          const u16* cm = (const u16*)(ws + OFF_CMT) + ((size_t)ldg * 16 + (r32 & 15)) * 128 + 8 * h;
#pragma unroll 1
          for (int hq = 0; hq < 2; ++hq) {
            const int hh = dir ? 1 - hq : hq;
            s5_bu_half((const u16*)(ws + OFF_S5U) + (pos0 + 32 * hh + r32) * 512 + g * 16 + 8 * h, bfr, W, r32, h);
            s5_scan_half<true>(W, dir, recol, lam, hr, hi);
            f32x16 yy;
#pragma unroll
            for (int i = 0; i < 16; ++i) yy[i] = 0.f;
#pragma unroll
            for (int sk = 0; sk < 8; ++sk) {
              const bf16x8 af = *(const bf16x8*)(W + r32 * 136 + 16 * sk + 8 * h);
              const bf16x8 cf = *(const bf16x8*)(cm + 16 * sk);
              yy = MFMA32(af, cf, yy);
            }
            if (hh == 0) { ycc[0] += yy; } else { ycc[1] += yy; }
          }
        }
        if (r32 < 16) {
          const float dsk = IN(19)[L * 512 + g * 16 + r32];
#pragma unroll
          for (int hh = 0; hh < 2; ++hh)
#pragma unroll
            for (int i = 0; i < 16; ++i) {
              const int t = 32 * hh + (i & 3) + 8 * (i >> 2) + 4 * h;
              u16* up = (u16*)(ws + OFF_S5U) + (pos0 + t) * 512 + g * 16 + r32;
              *up = f2bf(gelu_erf(ycc[hh][i] + bf2f(*up) * dsk));
            }
        }
      }
    }
    return;
  }
  if (k == 5) {
    const int n_g = 264 * 8;
    const int n_all = n_g + NP / 4;
    for (int it = bid; it < n_all; it += G) {
      if (it < n_g) {
        const int mt = it / 8, nt = it % 8;
        f32x16 acc[2][2]; acc_zero(acc);
        gemm_core((const u16*)(ws + OFF_S5U) + (size_t)mt * 128 * 512, 512, (const u16*)(ws + OFF_WGLU) + (size_t)nt * 128 * 512, 512, 512, acc, usm);
        {
          u16* YS = (u16*)(ws + OFF_MVT);
          const int e_r = lane & 31, e_h = lane >> 5, e_wm = wave >> 1, e_wn = wave & 1;
          const int ca = nt * 64 + e_wn * 32 + e_r;
          const float ba = IN(21)[L * 1024 + ca], bgt = IN(21)[L * 1024 + 512 + ca];
#pragma unroll
          for (int mi = 0; mi < 2; ++mi)
#pragma unroll
            for (int i = 0; i < 16; ++i) {
              const int row = e_wm * 64 + mi * 32 + (i & 3) + 8 * (i >> 2) + 4 * e_h;
              YS[(size_t)(mt * 128 + row) * 512 + ca] = f2bf((acc[mi][0][i] + ba) * sigmoidf_(acc[mi][1][i] + bgt));
            }
        }
      } else {
        const int pos = (it - n_g) * 4 + wave;
        const float* md = mod_ptr(p, L, pos);
        ln_mod_wave(h_in_ptr(p, L, pos), md, md + 1024, XM + (size_t)pos * DM, lane);
      }
    }
    return;
  }
  if (k == 6) {
    const int n_all = NP * 512 / 2048;
    for (int it = bid; it < n_all; it += G) {
      const size_t e = (size_t)it * 2048 + tid * 8;
      const size_t pos = e >> 9; const int c = (int)(e & 511);
      const u16* z = (const u16*)(ws + OFF_Z) + pos * 1024 + c;
      const uint4 a = *(const uint4*)z, g = *(const uint4*)(z + 512);
      uint4 o;
      o.x = cvtpk(bflo(a.x) * sigmoidf_(bflo(g.x)), bfhi(a.x) * sigmoidf_(bfhi(g.x)));
      o.y = cvtpk(bflo(a.y) * sigmoidf_(bflo(g.y)), bfhi(a.y) * sigmoidf_(bfhi(g.y)));
      o.z = cvtpk(bflo(a.z) * sigmoidf_(bflo(g.z)), bfhi(a.z) * sigmoidf_(bfhi(g.z)));
      o.w = cvtpk(bflo(a.w) * sigmoidf_(bflo(g.w)), bfhi(a.w) * sigmoidf_(bfhi(g.w)));
      *(uint4*)((u16*)(ws + OFF_S5U) + pos * 512 + c) = o;
    }
    return;
  }
  if (k == 7) {
    const int n_g = 264 * 8, n_all = n_g + 1024;
    int* ctr = (int*)(ws + OFF_CTR) + 2 + L * 2;
    for (int it = FETCH_ITEM(); it < n_all; it = FETCH_ITEM()) {
      if (it >= n_g) {
        for (int c = 0; c < 8; ++c) convert_chunk_fp8(IN(34) + (size_t)L * 16384 * 1024, (unsigned char*)(ws + OFF_PU), (size_t)(it - n_g) * 8 + c, 64.f);
        continue;
      }
      const int mt = it / 8, nt = it % 8;
      f32x16 mg[2][2]; acc_zero(mg);
#pragma unroll 1
      for (int kb = 0; kb < 4; ++kb) {
        f32x16 a1[2][2]; acc_zero(a1);
        gemm_core(XM + (size_t)mt * 128 * DM, DM, WinT + (size_t)(4880 + kb * 1024 + nt * 128) * DM, DM, DM, a1, usm);
        const float* bg = IN(7) + L * 4096 + kb * 1024 + nt * 128;
        unsigned gp[2][2][8];
        {
          const int r32 = lane & 31, wn = wave & 1;
#pragma unroll
          for (int ni = 0; ni < 2; ++ni) {
            const float bv = bg[wn * 64 + ni * 32 + r32];
#pragma unroll
            for (int mi = 0; mi < 2; ++mi)
#pragma unroll
              for (int i = 0; i < 8; ++i) gp[mi][ni][i] = cvtpk(sigmoidf_(a1[mi][ni][2 * i] + bv), sigmoidf_(a1[mi][ni][2 * i + 1] + bv));
          }
        }
        f32x16 a2[2][2]; acc_zero(a2);
        const size_t yo = kb == 0 ? OFF_QD : (kb == 1 ? OFF_MVT : (kb == 2 ? OFF_MO : OFF_QG));
        gemm_core((const u16*)(ws + yo) + (size_t)mt * 128 * 512, 512, (const u16*)(ws + OFF_WBR) + ((size_t)kb * DM + nt * 128) * 512, 512, 512, a2, usm);
#pragma unroll
        for (int mi = 0; mi < 2; ++mi)
#pragma unroll
          for (int ni = 0; ni < 2; ++ni)
#pragma unroll
            for (int i = 0; i < 8; ++i) { mg[mi][ni][2 * i] += bflo(gp[mi][ni][i]) * a2[mi][ni][2 * i]; mg[mi][ni][2 * i + 1] += bfhi(gp[mi][ni][i]) * a2[mi][ni][2 * i + 1]; }
      }
      u16* MG = (u16*)(ws + OFF_Z);
      EPI_LOOP(mg, { MG[(size_t)(mt * 128 + row) * 1024 + nt * 128 + col] = f2bf(val); })
    }
    return;
  }
  if (k == 8) {
    const int n_g = 264 * 8, n_cv = 1024;
    const int n_all = n_g + n_cv;
    int* ctr = (int*)(ws + OFF_CTR) + 3 + L * 2;
    for (int it = FETCH_ITEM(); it < n_all; it = FETCH_ITEM()) {
      if (it < n_g) {
        const int mt = it / 8, nt = it % 8;
        f32x16 acc[2][2]; acc_zero(acc);
        gemm_core((const u16*)(ws + OFF_Z) + (size_t)mt * 128 * DM, DM, (const u16*)(ws + OFF_WO) + (size_t)nt * 128 * DM, DM, DM, acc, usm);
        const float* g1 = mod_ptr(p, L, mt * 128) + 2048 + nt * 128;
        const float* hin0 = h_in_ptr(p, L, mt * 128) + nt * 128;
        float* hout0 = h_out_ptr(p, mt * 128) + nt * 128;
        EPI_LOOP(acc, { hout0[(size_t)row * DM + col] = ALPHA * hin0[(size_t)row * DM + col] + g1[col] * val; })
      } else {
        for (int c = 0; c < 8; ++c) convert_chunk_fp8(IN(35) + (size_t)L * 16384 * 1024, (unsigned char*)(ws + OFF_PV), (size_t)(it - n_g) * 8 + c, 8.f);
      }
    }
    return;
  }
  if (k == 9) {
    for (int it = bid; it < NP / 4; it += G) {
      const int pos = it * 4 + wave;
      float* hrow = h_out_ptr(p, pos);
      float4 x[4];
#pragma unroll
      for (int i = 0; i < 4; ++i) x[i] = *(const float4*)(hrow + lane * 4 + 256 * i);
      float sm = 0.f;
#pragma unroll
      for (int i = 0; i < 4; ++i) sm += x[i].x + x[i].y + x[i].z + x[i].w;
      const float mean = wave_sum(sm) * (1.f / DM);
      float vs = 0.f;
#pragma unroll
      for (int i = 0; i < 4; ++i) { x[i].x -= mean; x[i].y -= mean; x[i].z -= mean; x[i].w -= mean; vs += x[i].x * x[i].x + x[i].y * x[i].y + x[i].z * x[i].z + x[i].w * x[i].w; }
      const float rs = rsqrtf(wave_sum(vs) * (1.f / DM) + LN_EPS);
      float sm2 = 0.f;
#pragma unroll
      for (int i = 0; i < 4; ++i) {
        const float4 g = *(const float4*)(IN(28) + L * DM + lane * 4 + 256 * i), be = *(const float4*)(IN(29) + L * DM + lane * 4 + 256 * i);
        x[i] = make_float4(x[i].x * rs * g.x + be.x, x[i].y * rs * g.y + be.y, x[i].z * rs * g.z + be.z, x[i].w * rs * g.w + be.w);
        *(float4*)(hrow + lane * 4 + 256 * i) = x[i];
        sm2 += x[i].x + x[i].y + x[i].z + x[i].w;
      }
      const float mean2 = wave_sum(sm2) * (1.f / DM);
      float vs2 = 0.f;
#pragma unroll
      for (int i = 0; i < 4; ++i) { x[i].x -= mean2; x[i].y -= mean2; x[i].z -= mean2; x[i].w -= mean2; vs2 += x[i].x * x[i].x + x[i].y * x[i].y + x[i].z * x[i].z + x[i].w * x[i].w; }
      const float rs2 = rsqrtf(wave_sum(vs2) * (1.f / DM) + LN_EPS);
      const float* md = mod_ptr(p, L, pos);
#pragma unroll
      for (int i = 0; i < 4; ++i) {
        const float4 sh = *(const float4*)(md + 3072 + lane * 4 + 256 * i), sc = *(const float4*)(md + 4096 + lane * 4 + 256 * i);
        *(uint2*)(XM + (size_t)pos * DM + lane * 4 + 256 * i) = make_uint2(cvtpk(x[i].x * rs2 * (1.f + sc.x) + sh.x, x[i].y * rs2 * (1.f + sc.y) + sh.y), cvtpk(x[i].z * rs2 * (1.f + sc.z) + sh.z, x[i].w * rs2 * (1.f + sc.w) + sh.w));
      }
    }
    return;
  }
  if (k == 10) {
    const int n_all = 264 * 16;
    for (int it = bid; it < n_all; it += G) {
      const int mt = it / 16, nt = it % 16;
      f32x16 acc[2][2]; acc_zero(acc);
      gemm_core(XM + (size_t)mt * 128 * DM, DM, (const u16*)(ws + OFF_WQ) + (size_t)nt * 128 * DM, DM, DM, acc, usm);
      u16* Q2 = (u16*)(ws + OFF_Q2);
      EPI_LOOP(acc, { Q2[(size_t)(mt * 128 + row) * 2048 + nt * 128 + col] = f2bf(val); })
    }
    return;
  }
  if (k == 11) {
    const int n_all = NP / 8;
    float* sc = fsm;
    float* T1v = fsm + 64 * 132;
    float* T2v = T1v + 1024;
    int* T1i = (int*)(T2v + 1024);
    int* T2i = T1i + 1024;
    float* Sv = (float*)(T2i + 1024) + wave * 64;
    int* Si = (int*)((float*)(T2i + 1024) + 256) + wave * 64;
    const int r32 = lane & 31, h = lane >> 5;
    for (int it = bid; it < n_all; it += G) {
      const size_t row0 = (size_t)it * 64;
#pragma unroll 1
      for (int half = 0; half < 2; ++half) {
        f32x16 a[2];
#pragma unroll
        for (int ni = 0; ni < 2; ++ni)
#pragma unroll
          for (int i = 0; i < 16; ++i) a[ni][i] = 0.f;
        const u16* qa = (const u16*)(ws + OFF_Q2) + (row0 + (wave >> 1) * 32 + r32) * 256 + half * 128;
        const u16* kbp = (const u16*)(ws + OFF_SK) + (size_t)half * 16384 + (size_t)((wave & 1) * 64 + r32) * 128;
#pragma unroll
        for (int s = 0; s < 8; ++s) {
          const bf16x8 af = *(const bf16x8*)(qa + s * 16 + h * 8);
#pragma unroll
          for (int ni = 0; ni < 2; ++ni) {
            const bf16x8 bf = *(const bf16x8*)(kbp + (size_t)ni * 32 * 128 + s * 16 + h * 8);
            a[ni] = MFMA32(af, bf, a[ni]);
          }
        }
        __syncthreads();
#pragma unroll
        for (int ni = 0; ni < 2; ++ni)
#pragma unroll
          for (int i = 0; i < 16; ++i) sc[((wave >> 1) * 32 + (i & 3) + 8 * (i >> 2) + 4 * h) * 132 + (wave & 1) * 64 + ni * 32 + r32] = a[ni][i];
        __syncthreads();
        float* Tv = half ? T2v : T1v; int* Ti = half ? T2i : T1i;
#pragma unroll 1
        for (int g = 0; g < 4; ++g) {
          float v0[4], v1[4]; unsigned k0[4], k1[4], T[4];
#pragma unroll
          for (int r = 0; r < 4; ++r) {
            const int row = wave * 16 + g * 4 + r;
            v0[r] = sc[row * 132 + lane]; v1[r] = sc[row * 132 + 64 + lane];
            unsigned u0 = __float_as_uint(v0[r]), u1 = __float_as_uint(v1[r]);
            u0 = (u0 >> 31) ? ~u0 : (u0 | 0x80000000u); u1 = (u1 >> 31) ? ~u1 : (u1 | 0x80000000u);
            k0[r] = (u0 & 0xFFFFFF80u) | (unsigned)(127 - lane); k1[r] = (u1 & 0xFFFFFF80u) | (unsigned)(63 - lane);
            T[r] = 0u;
          }
          bool dn0 = false, dn1 = false, dn2 = false, dn3 = false;
#pragma unroll 1
          for (int bit = 31; bit >= 0; --bit) {
#pragma unroll
            for (int r = 0; r < 4; ++r) {
              bool& dn = r == 0 ? dn0 : (r == 1 ? dn1 : (r == 2 ? dn2 : dn3));
              const unsigned cand = T[r] | (1u << bit);
              const int cnt = __popcll(__ballot(k0[r] >= cand)) + __popcll(__ballot(k1[r] >= cand));
              T[r] = cnt >= 16 ? cand : T[r];
              dn = dn | (cnt == 16);
            }
            if (dn0 && dn1 && dn2 && dn3) break;
          }
#pragma unroll
          for (int r = 0; r < 4; ++r) {
            const int row = wave * 16 + g * 4 + r;
            const bool s0 = k0[r] >= T[r], s1 = k1[r] >= T[r];
            const unsigned long long m0 = __ballot(s0), m1 = __ballot(s1);
            const int p0 = __builtin_amdgcn_mbcnt_hi((unsigned)(m0 >> 32), __builtin_amdgcn_mbcnt_lo((unsigned)m0, 0u));
            const int p1 = __popcll(m0) + __builtin_amdgcn_mbcnt_hi((unsigned)(m1 >> 32), __builtin_amdgcn_mbcnt_lo((unsigned)m1, 0u));
            if (s0) { Tv[row * 16 + p0] = v0[r]; Ti[row * 16 + p0] = lane; }
            if (s1) { Tv[row * 16 + p1] = v1[r]; Ti[row * 16 + p1] = lane + 64; }
          }
        }
      }
#pragma unroll 1
      for (int g = 0; g < 4; ++g) {
        {
          const int rowl = wave * 16 + g * 4 + (lane >> 4), j = lane & 15;
#pragma unroll
          for (int half = 0; half < 2; ++half) {
            float* Tv = half ? T2v : T1v; int* Ti = half ? T2i : T1i;
            const float v = Tv[rowl * 16 + j]; const int vi = Ti[rowl * 16 + j];
            int rank = 0;
#pragma unroll
            for (int i = 0; i < 16; ++i) { const float o = Tv[rowl * 16 + i]; rank += (o > v || (o == v && i < j)) ? 1 : 0; }
            Tv[rowl * 16 + rank] = v; Ti[rowl * 16 + rank] = vi;
          }
        }
        unsigned kk[4], T[4]; float cv[4];
        const int pr = PEER_PAIRS[lane], ia = pr >> 4, ib = pr & 15;
#pragma unroll
        for (int r = 0; r < 4; ++r) {
          const int row = wave * 16 + g * 4 + r;
          cv[r] = T1v[row * 16 + ia] + T2v[row * 16 + ib];
          unsigned u = __float_as_uint(cv[r]); u = (u >> 31) ? ~u : (u | 0x80000000u);
          kk[r] = lane < 50 ? ((u & 0xFFFFFFC0u) | (unsigned)(63 - lane)) : 0u;
          T[r] = 0u;
        }
        bool dn0 = false, dn1 = false, dn2 = false, dn3 = false;
#pragma unroll 1
        for (int bit = 31; bit >= 0; --bit) {
#pragma unroll
          for (int r = 0; r < 4; ++r) {
            bool& dn = r == 0 ? dn0 : (r == 1 ? dn1 : (r == 2 ? dn2 : dn3));
            const unsigned cand = T[r] | (1u << bit);
            const int cnt = __popcll(__ballot(kk[r] >= cand));
            T[r] = cnt >= 16 ? cand : T[r];
            dn = dn | (cnt == 16);
          }
          if (dn0 && dn1 && dn2 && dn3) break;
        }
#pragma unroll
        for (int r = 0; r < 4; ++r) {
          const int row = wave * 16 + g * 4 + r;
          const bool se = kk[r] >= T[r] && T[r] != 0u;
          const unsigned long long me = __ballot(se);
          const int pe = __builtin_amdgcn_mbcnt_hi((unsigned)(me >> 32), __builtin_amdgcn_mbcnt_lo((unsigned)me, 0u));
          if (se) {
            Sv[r * 16 + pe] = cv[r];
            Si[r * 16 + pe] = T1i[row * 16 + ia] * 128 + T2i[row * 16 + ib];
          }
        }
        {
          const float val = Sv[lane]; const int idx = Si[lane];
          float mx = val;
          mx = fmaxf(mx, SHX(mx, 8)); mx = fmaxf(mx, SHX(mx, 4)); mx = fmaxf(mx, SHX(mx, 2)); mx = fmaxf(mx, SHX(mx, 1));
          const float ev = __expf(val - mx);
          float sm = ev;
          sm += SHX(sm, 8); sm += SHX(sm, 4); sm += SHX(sm, 2); sm += SHX(sm, 1);
          const size_t o = (row0 + wave * 16 + g * 4) * 16 + lane;
          ((int*)(ws + OFF_IDX))[o] = idx;
          ((float*)(ws + OFF_GATE))[o] = ev / sm;
        }
      }
      __syncthreads();
    }
    return;
  }
  if (k == 12) {
    const unsigned char* PU = (const unsigned char*)(ws + OFF_PU); const unsigned char* PV = (const unsigned char*)(ws + OFF_PV);
    float* wl = fsm + 8 + wave * 32;
    float* fs = fsm + 8 + 128;
    for (int it = bid; it < NP; it += G) {
      const int pos = it;
      float tf[16];
      {
        const u16* xr = XM + (size_t)pos * DM + lane * 16;
        const u32x4 a = *(const u32x4*)xr, b = *(const u32x4*)(xr + 8);
        tf[0] = bflo(a.x); tf[1] = bfhi(a.x); tf[2] = bflo(a.y); tf[3] = bfhi(a.y); tf[4] = bflo(a.z); tf[5] = bfhi(a.z); tf[6] = bflo(a.w); tf[7] = bfhi(a.w);
        tf[8] = bflo(b.x); tf[9] = bfhi(b.x); tf[10] = bflo(b.y); tf[11] = bfhi(b.y); tf[12] = bflo(b.z); tf[13] = bfhi(b.z); tf[14] = bflo(b.w); tf[15] = bfhi(b.w);
      }
      const size_t r0 = (size_t)pos * 8 + wave * 2;
      const int myidx = lane < 32 ? ((const int*)(ws + OFF_IDX))[r0 * 16 + lane] : 0;
      const float myg = lane < 32 ? ((const float*)(ws + OFF_GATE))[r0 * 16 + lane] : 0.f;
      u32x4 A[8], B[8], C[8], D[8];
      const bool b5 = lane & 32, b4 = lane & 16, b3 = lane & 8;
#define LOADROWS(X, TAB, E0)                                                             \
      _Pragma("unroll") for (int j = 0; j < 8; ++j) {                                    \
        const int idx = __builtin_amdgcn_readlane(myidx, (E0) + j);                      \
        X[j] = *(const u32x4*)((TAB) + (size_t)idx * DM + lane * 16);                    \
      }
#define UNPK(X, j, q) const f32x2 q##0 = __builtin_amdgcn_cvt_pk_f32_fp8((int)X[j].x, false), q##1 = __builtin_amdgcn_cvt_pk_f32_fp8((int)X[j].x, true), \
                                  q##2 = __builtin_amdgcn_cvt_pk_f32_fp8((int)X[j].y, false), q##3 = __builtin_amdgcn_cvt_pk_f32_fp8((int)X[j].y, true), \
                                  q##4 = __builtin_amdgcn_cvt_pk_f32_fp8((int)X[j].z, false), q##5 = __builtin_amdgcn_cvt_pk_f32_fp8((int)X[j].z, true), \
                                  q##6 = __builtin_amdgcn_cvt_pk_f32_fp8((int)X[j].w, false), q##7 = __builtin_amdgcn_cvt_pk_f32_fp8((int)X[j].w, true);
#define DOTS(X, E0)                                                                  \
      {                                                                                  \
        float d[8];                                                                      \
        _Pragma("unroll") for (int j = 0; j < 8; ++j) {                                  \
          UNPK(X, j, q)                                                                  \
          d[j] = tf[0] * q0.x + tf[1] * q0.y + tf[2] * q1.x + tf[3] * q1.y + tf[4] * q2.x + tf[5] * q2.y + tf[6] * q3.x + tf[7] * q3.y \
               + tf[8] * q4.x + tf[9] * q4.y + tf[10] * q5.x + tf[11] * q5.y + tf[12] * q6.x + tf[13] * q6.y + tf[14] * q7.x + tf[15] * q7.y; \
          asm volatile("" : "+v"(d[j]));                                                 \
        }                                                                                \
        float d4[4], d2[2], d1;                                                          \
        _Pragma("unroll") for (int i = 0; i < 4; ++i) { const float keep = b5 ? d[i + 4] : d[i], send = b5 ? d[i] : d[i + 4]; d4[i] = keep + SHX(send, 32); } \
        _Pragma("unroll") for (int i = 0; i < 2; ++i) { const float keep = b4 ? d4[i + 2] : d4[i], send = b4 ? d4[i] : d4[i + 2]; d2[i] = keep + SHX(send, 16); } \
        { const float keep = b3 ? d2[1] : d2[0], send = b3 ? d2[0] : d2[1]; d1 = keep + SHX(send, 8); } \
        d1 += SHX(d1, 4); d1 += SHX(d1, 2); d1 += SHX(d1, 1);                            \
        const float gt = __int_as_float(__builtin_amdgcn_ds_bpermute(((E0) + (lane >> 3)) << 2, __float_as_int(myg))); \
        if ((lane & 7) == 0) wl[(E0) + (lane >> 3)] = gt * gelu_erf(d1 * (1.f / 64.f)) * 0.125f; \
        __builtin_amdgcn_sched_barrier(0);                                               \
      }
#define ACCV(X, E0)                                                                      \
      _Pragma("unroll") for (int j = 0; j < 8; ++j) {                                    \
        const float w = wl[(E0) + j];                                                    \
        UNPK(X, j, q)                                                                    \
        ov[0] += w * q0.x; ov[1] += w * q0.y; ov[2] += w * q1.x; ov[3] += w * q1.y; ov[4] += w * q2.x; ov[5] += w * q2.y; ov[6] += w * q3.x; ov[7] += w * q3.y; \
        ov[8] += w * q4.x; ov[9] += w * q4.y; ov[10] += w * q5.x; ov[11] += w * q5.y; ov[12] += w * q6.x; ov[13] += w * q6.y; ov[14] += w * q7.x; ov[15] += w * q7.y; \
        _Pragma("unroll") for (int i = 0; i < 16; ++i) asm volatile("" : "+v"(ov[i]));   \
      }
      __syncthreads();
      LOADROWS(A, PU, 0)
      LOADROWS(B, PU, 8)
      LOADROWS(C, PU, 16)
      LOADROWS(D, PU, 24)
      DOTS(A, 0)
      LOADROWS(A, PV, 0)
      DOTS(B, 8)
      LOADROWS(B, PV, 8)
      DOTS(C, 16)
      LOADROWS(C, PV, 16)
      DOTS(D, 24)
      LOADROWS(D, PV, 24)
      float ov[16];
#pragma unroll
      for (int i = 0; i < 16; ++i) ov[i] = 0.f;
      ACCV(A, 0)
      __builtin_amdgcn_sched_barrier(0);
      ACCV(B, 8)
      __builtin_amdgcn_sched_barrier(0);
      ACCV(C, 16)
      __builtin_amdgcn_sched_barrier(0);
      ACCV(D, 24)
#undef LOADROWS
#undef UNPK
#undef DOTS
#undef ACCV
#pragma unroll
      for (int i = 0; i < 16; ++i) fs[wave * 1024 + lane * 16 + i] = ov[i];
      __syncthreads();
      const int tid2 = otid();
      float f[4];
#pragma unroll
      for (int i = 0; i < 4; ++i) f[i] = fs[tid2 * 4 + i] + fs[1024 + tid2 * 4 + i] + fs[2048 + tid2 * 4 + i] + fs[3072 + tid2 * 4 + i];
      float* hrow = h_out_ptr(p, pos);
      const float4 hm = *(const float4*)(hrow + tid2 * 4);
      const float4 g2 = *(const float4*)(mod_ptr(p, L, pos) + 5120 + tid2 * 4);
      const float x0 = ALPHA * hm.x + g2.x * f[0], x1 = ALPHA * hm.y + g2.y * f[1], x2 = ALPHA * hm.z + g2.z * f[2], x3 = ALPHA * hm.w + g2.w * f[3];
      const float mean = block_sum(x0 + x1 + x2 + x3, fsm) * (1.f / DM);
      const float a = x0 - mean, b = x1 - mean, c = x2 - mean, d = x3 - mean;
      const float var = block_sum(a * a + b * b + c * c + d * d, fsm) * (1.f / DM);
      const float rs = rsqrtf(var + LN_EPS);
      const float4 g = *(const float4*)(IN(30) + L * DM + tid2 * 4), be = *(const float4*)(IN(31) + L * DM + tid2 * 4);
      *(float4*)(hrow + tid2 * 4) = make_float4(a * rs * g.x + be.x, b * rs * g.y + be.y, c * rs * g.z + be.z, d * rs * g.w + be.w);
    }
    return;
  }
}

#if MULTI_LAUNCH
__global__ void __launch_bounds__(256, 2) k_phase(P p, int ph) {
  __shared__ __attribute__((aligned(16))) char smem[57344];
  run_phase(p, ph, smem);
}
#endif

#if !MULTI_LAUNCH
#define XB_TMO      128
#define XB_XCNT(j)  (256  + 64 * (j))
#define XB_XSUB(j)  (1280 + 64 * (j))
#define XB_XGEN(j)  (2304 + 64 * (j))
#define XB_TOP      3328
#define XB_TOPGEN   3392
#define XCD_BAR_WORDS 3456
#define XB_SPIN_CAP (1u << 18)
#define LAS __attribute__((address_space(3)))

__device__ __forceinline__ unsigned xb_ld(unsigned* p)              { return __hip_atomic_load(p, __ATOMIC_RELAXED, __HIP_MEMORY_SCOPE_AGENT); }
__device__ __forceinline__ unsigned xb_add(unsigned* p, unsigned v) { return __hip_atomic_fetch_add(p, v, __ATOMIC_RELAXED, __HIP_MEMORY_SCOPE_AGENT); }
__device__ __forceinline__ unsigned xb_xcc_id() { return (unsigned)__builtin_amdgcn_s_getreg((3 << 11) | 20) & 0xFu; }
#define XB_SPIN(cond, bar) do { unsigned _sp = 0; while (cond) { __builtin_amdgcn_s_sleep(1); \
    if ((++_sp & 255u) == 0u) { if (xb_ld(&(bar)[XB_TMO])) break; if (_sp > XB_SPIN_CAP) { atomicAdd(&(bar)[XB_TMO], 1u); break; } } } } while (0)

struct XcdBarrier {
    unsigned* bar; unsigned x;
    volatile LAS unsigned* st;
};

__device__ __forceinline__ XcdBarrier xcd_barrier_post(unsigned* bar, volatile LAS unsigned* st) {
    XcdBarrier b; b.bar = bar; b.x = xb_xcc_id(); b.st = st;
    if (threadIdx.x == 0) (void)xb_add(&bar[XB_XCNT(b.x)], 1u);
    return b;
}
__device__ __forceinline__ void xcd_barrier_complete(unsigned* bar, unsigned x, unsigned& nloc, unsigned& nx) {
    const unsigned G = gridDim.x * gridDim.y * gridDim.z;
    unsigned sum, cnt, mine, sp = 0u;
    for (;;) {
        sum = 0u; cnt = 0u; mine = 0u;
#pragma unroll
        for (unsigned j = 0; j < 16; ++j) { const unsigned c = xb_ld(&bar[XB_XCNT(j)]); sum += c; cnt += (c > 0u) ? 1u : 0u; mine = (j == x) ? c : mine; }
        if (sum == G) break;
        __builtin_amdgcn_s_sleep(1);
        if ((++sp & 255u) == 0u) { if (xb_ld(&bar[XB_TMO])) break; if (sp > XB_SPIN_CAP) { atomicAdd(&bar[XB_TMO], 1u); break; } }
    }
    nloc = mine > 0u ? mine : 1u; nx = cnt > 0u ? cnt : 1u;
}

__device__ __forceinline__ void xcd_barrier(const XcdBarrier& b) {
    asm volatile("s_waitcnt vmcnt(0)" ::: "memory");
    __syncthreads();
    if (threadIdx.x == 0) {
        unsigned* bar = b.bar;
        __builtin_amdgcn_s_waitcnt(0);
        unsigned nloc = b.st[0], nx = b.st[1];
        if (nloc == 0u) { xcd_barrier_complete(bar, b.x, nloc, nx); b.st[0] = nloc; b.st[1] = nx; }
        const unsigned old = xb_add(&bar[XB_XSUB(b.x)], 1u);
        const unsigned gen = old / nloc;
        if (old + 1u == (gen + 1u) * nloc) {
            __builtin_amdgcn_fence(__ATOMIC_RELEASE, "agent");
            asm volatile("s_waitcnt vmcnt(0)" ::: "memory");
            const unsigned og = xb_add(&bar[XB_TOP], 1u);
            const unsigned tg = og / nx;
            if (og + 1u == (tg + 1u) * nx) xb_add(&bar[XB_TOPGEN], 1u);
            else XB_SPIN(xb_ld(&bar[XB_TOPGEN]) == tg, bar);
            __builtin_amdgcn_fence(__ATOMIC_ACQUIRE, "agent");
            xb_add(&bar[XB_XGEN(b.x)], 1u);
            asm volatile("s_waitcnt vmcnt(0)" ::: "memory");
        } else {
            XB_SPIN(xb_ld(&bar[XB_XGEN(b.x)]) == gen, bar);
            __builtin_amdgcn_fence(__ATOMIC_ACQUIRE, "agent");
            asm volatile("s_waitcnt vmcnt(0)" ::: "memory");
        }
    }
    __syncthreads();
}


__global__ void __launch_bounds__(256, 2) k_mega(P p) {
  __shared__ __attribute__((aligned(16))) char smem[57344];
  cg::grid_group grid = cg::this_grid();
  __shared__ uint4 xb_words;
  if (threadIdx.x == 0) xb_words = make_uint4(0u, 0u, 0u, 0u);
  __syncthreads();
  (void)xcd_barrier_post((unsigned*)(WSP + OFF_BAR), (volatile LAS unsigned*)&xb_words);
#define XBAR() { XcdBarrier xb_; xb_.bar = (unsigned*)(WSP + OFF_BAR); xb_.x = xb_xcc_id(); xb_.st = (volatile LAS unsigned*)&xb_words; xcd_barrier(xb_); }
  run_phase(p, 0, smem); grid.sync();
  run_phase(p, 1, smem); XBAR()
  run_phase(p, 2, smem); XBAR()
  run_phase(p, 3, smem); XBAR()
  run_phase(p, 4, smem); XBAR()
  run_phase(p, 5, smem); XBAR()
  run_phase(p, 15, smem); XBAR()
  run_phase(p, 6, smem); XBAR()
  run_phase(p, 7, smem); XBAR()
  run_phase(p, 9, smem); XBAR()
  run_phase(p, 10, smem); XBAR()
  run_phase(p, 11, smem); XBAR()
  run_phase(p, 12, smem); XBAR()
  run_phase(p, 13, smem); XBAR()
  run_phase(p, 14, smem); XBAR()
  run_phase(p, 16, smem); XBAR()
  run_phase(p, 17, smem); XBAR()
  run_phase(p, 18, smem); XBAR()
  run_phase(p, 19, smem); XBAR()
  run_phase(p, 29, smem); XBAR()
  run_phase(p, 20, smem); XBAR()
  run_phase(p, 21, smem); XBAR()
  run_phase(p, 23, smem); XBAR()
  run_phase(p, 24, smem); XBAR()
  run_phase(p, 25, smem); XBAR()
  run_phase(p, 26, smem); XBAR()
  run_phase(p, 27, smem); XBAR()
  run_phase(p, 28, smem);
#undef XBAR
}
#endif

extern "C" void kernel_launch(void* const* d_in, const int* in_sizes, int n_in, void* d_out, int out_size, void* d_ws, size_t ws_size, hipStream_t stream) {
  if (n_in != 36 || ws_size < WS_END) { fprintf(stderr, "kernel_launch: need 36 inputs and %zu bytes of workspace (got %d, %zu)\n", (size_t)WS_END, n_in, ws_size); return; }
  P p{};
  for (int i = 0; i < 36; ++i) p.in[i] = (const float*)d_in[i];
  p.out = (float*)d_out; p.ws = (char*)d_ws;
#if MULTI_LAUNCH
  for (int ph = 0; ph < NPHASES; ++ph) hipLaunchKernelGGL(k_phase, dim3(512), dim3(256), 0, stream, p, ph);
#else
  static int grid_blocks = 0;
  if (!grid_blocks) {
    int dev = 0, cus = 0, per_cu = 0;
    hipGetDevice(&dev);
    hipDeviceGetAttribute(&cus, hipDeviceAttributeMultiprocessorCount, dev);
    hipOccupancyMaxActiveBlocksPerMultiprocessor(&per_cu, k_mega, 256, 0);
    if (per_cu < 1) per_cu = 1;
    grid_blocks = cus * per_cu;
    if (grid_blocks > 512) grid_blocks = 512;
  }
  hipMemsetAsync((char*)d_ws + OFF_BAR, 0, 16384, stream);
  void* args[] = {&p};
  hipError_t e = hipLaunchCooperativeKernel((void*)k_mega, dim3(grid_blocks), dim3(256), args, 0, stream);
  if (e != hipSuccess) fprintf(stderr, "cooperative launch failed: %s (grid %d)\n", hipGetErrorString(e), grid_blocks);
#endif
}
```

```cpp
#include <hip/hip_runtime.h>
#include <hip/hip_cooperative_groups.h>
#include <cstdio>
namespace cg = cooperative_groups;

#ifndef MULTI_LAUNCH
#define MULTI_LAUNCH 0
#endif

#define DI __device__ __forceinline__
typedef unsigned short u16;
typedef short bf16x8 __attribute__((ext_vector_type(8)));
typedef short s16x4 __attribute__((ext_vector_type(4)));
typedef float f32x16 __attribute__((ext_vector_type(16)));
typedef float f32x2 __attribute__((ext_vector_type(2)));
typedef __bf16 bf16x2_t __attribute__((ext_vector_type(2)));
typedef unsigned u32x4 __attribute__((ext_vector_type(4)));
typedef __bf16 bf16x8_t __attribute__((ext_vector_type(8)));
#define MFMA32(a, b, c) __builtin_amdgcn_mfma_f32_32x32x16_bf16((a), (b), (c), 0, 0, 0)

constexpr int NB = 4, SL = 8192, SC = 256, SB = 8448, NP = NB * SB, DM = 1024, NIN = 8976;
constexpr float LN_EPS = 1e-6f;
constexpr float ALPHA = 1.41421356237f;
constexpr float LOG2E = 1.44269504089f;

constexpr size_t SZ512 = (size_t)NP * 512 * 2;
constexpr size_t OFF_A = 0;
constexpr size_t OFF_QD = OFF_A + 2 * SZ512;
constexpr size_t OFF_KD = OFF_QD + SZ512;
constexpr size_t OFF_VDT = OFF_KD + SZ512;
constexpr size_t OFF_S5U = OFF_VDT + SZ512;
constexpr size_t OFF_MQ = OFF_S5U + SZ512;
constexpr size_t OFF_MK = OFF_MQ + SZ512;
constexpr size_t OFF_MVT = OFF_MK + SZ512;
constexpr size_t OFF_MO = OFF_MVT + SZ512;
constexpr size_t OFF_QG = OFF_MO + SZ512;
constexpr size_t OFF_KG = OFF_QG + SZ512;
constexpr size_t OFF_VGT = OFF_KG + SZ512 / 4;
constexpr size_t OFF_MGATE = OFF_VGT + SZ512 / 4;
constexpr size_t OFF_WIN = OFF_MGATE + (size_t)NP * 16 * 4;
constexpr size_t OFF_WBR = OFF_WIN + (size_t)9088 * 1024 * 2;
constexpr size_t OFF_WO = OFF_WBR + (size_t)4 * 1024 * 512 * 2;
constexpr size_t OFF_WGLU = OFF_WO + (size_t)1024 * 1024 * 2;
constexpr size_t OFF_WQ = OFF_WGLU + (size_t)1024 * 512 * 2;
constexpr size_t OFF_SK = OFF_WQ + (size_t)2048 * 1024 * 2;
constexpr size_t OFF_MODP = OFF_SK + 65536;
constexpr size_t OFF_MOD = OFF_MODP + (size_t)2 * 8 * 5 * 6144 * 4;
constexpr size_t OFF_LAMB = OFF_MOD + (size_t)2 * 5 * 6144 * 4;
constexpr size_t OFF_BBAR = OFF_LAMB + 65536;
constexpr size_t OFF_LAMV = OFF_BBAR + 1048576;
constexpr size_t SZCH = (size_t)32 * SB * 4;
constexpr size_t OFF_GI = OFF_LAMV + 256;
constexpr size_t OFF_GF = OFF_GI + SZCH;
constexpr size_t OFF_AA = OFF_GF + SZCH;
constexpr size_t OFF_MXA = OFF_AA + SZCH;
constexpr size_t OFF_MTA = OFF_MXA + SZCH;
constexpr size_t SZHE = (size_t)NB * 2 * 32 * 132 * 64 * 8;
constexpr size_t OFF_HEND = OFF_MTA + SZCH;
constexpr size_t OFF_CARRY = OFF_HEND + SZHE;
constexpr size_t OFF_HC = OFF_CARRY + SZHE;
constexpr size_t OFF_STASH = OFF_HC + (size_t)1024 * 1024 * 4;
constexpr size_t OFF_PU = OFF_STASH;
constexpr size_t OFF_PV = OFF_STASH + (size_t)16384 * 1024;
constexpr size_t OFF_ROPE = OFF_STASH + (size_t)512 * 64 * 256 * 4;
constexpr size_t OFF_TMAX = OFF_ROPE + 32768;
constexpr size_t OFF_BBT = OFF_TMAX + 32768;
constexpr size_t OFF_CMT = OFF_BBT + 524288;
constexpr size_t OFF_NST = OFF_CMT + 524288;
constexpr size_t OFF_NPST = OFF_NST + (size_t)1056 * 128 * 4;
constexpr size_t OFF_ALOC = OFF_NPST + (size_t)1056 * 128 * 4;
constexpr size_t OFF_BKA = OFF_ALOC + 8192;
constexpr size_t OFF_CTR = OFF_BKA + 8192;
constexpr size_t OFF_BAR = OFF_CTR + 256;
constexpr size_t WS_END = OFF_BAR + 16384;
constexpr size_t OFF_GST = OFF_MQ;
constexpr size_t OFF_PST = OFF_MK;
constexpr size_t OFF_Z = OFF_MQ;

constexpr size_t OFF_Q2 = OFF_S5U;
constexpr size_t OFF_IDX = OFF_MO;
constexpr size_t OFF_GATE = OFF_MO + (size_t)NP * 8 * 16 * 4;

struct P {
  const float* in[36];
  float* out;
  char* ws;
};

typedef const float* const __attribute__((address_space(4)))* kargp_t;
DI kargp_t karg() { kargp_t k = (kargp_t)__builtin_amdgcn_kernarg_segment_ptr(); asm volatile("" : "+s"(k)); return k; }
#define IN(i) (karg()[i])
#define OUTP ((float*)karg()[36])
#define WSP ((char*)karg()[37])
DI int otid() { int t = threadIdx.x; asm volatile("" : "+v"(t)); return t; }
template <int M> DI int shx_i(int v) {
  if constexpr (M < 32) return __builtin_amdgcn_ds_swizzle(v, 0x1f | (M << 10));
  else return __builtin_amdgcn_ds_bpermute(((otid() & 63) ^ M) << 2, v);
}
#define SHX(v, M) __int_as_float(shx_i<M>(__float_as_int(v)))
#define SHXI(v, M) shx_i<M>(v)
DI unsigned cvtpk(float lo, float hi) { f32x2 v = {lo, hi}; bf16x2_t b = __builtin_convertvector(v, bf16x2_t); return __builtin_bit_cast(unsigned, b); }
DI u16 f2bf(float x) { return (u16)(cvtpk(x, 0.f) & 0xffffu); }
DI float bf2f(u16 x) { return __uint_as_float(((unsigned)x) << 16); }
DI float bflo(unsigned u) { return __uint_as_float(u << 16); }
DI float bfhi(unsigned u) { return __uint_as_float(u & 0xffff0000u); }
DI float wave_sum(float v) { v += SHX(v, 32); v += SHX(v, 16); v += SHX(v, 8); v += SHX(v, 4); v += SHX(v, 2); v += SHX(v, 1); return v; }
DI float wave_max(float v) { v = fmaxf(v, SHX(v, 32)); v = fmaxf(v, SHX(v, 16)); v = fmaxf(v, SHX(v, 8)); v = fmaxf(v, SHX(v, 4)); v = fmaxf(v, SHX(v, 2)); v = fmaxf(v, SHX(v, 1)); return v; }
DI float block_sum(float v, float* red) {
  v = wave_sum(v);
  __syncthreads();
  if ((otid() & 63) == 0) red[otid() >> 6] = v;
  __syncthreads();
  return red[0] + red[1] + red[2] + red[3];
}
DI float sigmoidf_(float x) { return __builtin_amdgcn_rcpf(1.f + __expf(-x)); }
DI float gelu_erf(float x) {
  const float z = fabsf(x) * 0.70710678118f;
  const float t = __builtin_amdgcn_rcpf(1.f + 0.3275911f * z);
  const float poly = t * (0.254829592f + t * (-0.284496736f + t * (1.421413741f + t * (-1.453152027f + t * 1.061405429f))));
  const float e = 1.f - poly * __expf(-z * z);
  return 0.5f * x * (1.f + copysignf(e, x));
}
DI float silu_(float x) { return x * __builtin_amdgcn_rcpf(1.f + __expf(-x)); }
DI float fexp2(float x) { return __builtin_amdgcn_exp2f(x); }

DI const float* h_in_ptr(const P& p, int L, int pos) {
  int b = pos / SB, s = pos - b * SB;
  if (L == 0) return s < SL ? IN(0) + ((size_t)b * SL + s) * DM : IN(2) + ((size_t)b * SC + (s - SL)) * DM;
  return s < SL ? OUTP + ((size_t)b * SL + s) * DM : (const float*)(WSP + OFF_HC) + ((size_t)b * SC + (s - SL)) * DM;
}
DI float* h_out_ptr(const P& p, int pos) {
  int b = pos / SB, s = pos - b * SB;
  return s < SL ? OUTP + ((size_t)b * SL + s) * DM : (float*)(WSP + OFF_HC) + ((size_t)b * SC + (s - SL)) * DM;
}
DI const float* mod_ptr(const P& p, int L, int pos) {
  int b = pos / SB, s = pos - b * SB;
  int v = s < SL ? b : 4;
  return (const float*)(WSP + OFF_MOD) + ((size_t)L * 5 + v) * 6144;
}

DI void gemm_core(const u16* __restrict__ A, int lda, const u16* __restrict__ B, int ldb, int K, f32x16 (&acc)[2][2], u16* lds) {
  const int tid = otid(), lane = tid & 63, wave = tid >> 6;
  const int wm = wave >> 1, wn = wave & 1, r32 = lane & 31, h = lane >> 5;
  u16* As = lds; u16* Bs = lds + 128 * 72;
  const int lr = tid >> 3, lc = (tid & 7) * 8;
  u32x4 ra[4], rb[4];
  const int nk = K >> 6;
#pragma unroll
  for (int i = 0; i < 4; ++i) {
    ra[i] = *(const u32x4*)(A + (size_t)(lr + 32 * i) * lda + lc);
    rb[i] = *(const u32x4*)(B + (size_t)(lr + 32 * i) * ldb + lc);
  }
#pragma unroll 1
  for (int kt = 0; kt < nk; ++kt) {
    __syncthreads();
#pragma unroll
    for (int i = 0; i < 4; ++i) {
      *(u32x4*)(As + (lr + 32 * i) * 72 + lc) = ra[i];
      *(u32x4*)(Bs + (lr + 32 * i) * 72 + lc) = rb[i];
    }
    __syncthreads();
    if (kt + 1 < nk) {
#pragma unroll
      for (int i = 0; i < 4; ++i) {
        ra[i] = *(const u32x4*)(A + (size_t)(lr + 32 * i) * lda + (kt + 1) * 64 + lc);
        rb[i] = *(const u32x4*)(B + (size_t)(lr + 32 * i) * ldb + (kt + 1) * 64 + lc);
      }
    }
#pragma unroll
    for (int s = 0; s < 4; ++s) {
      bf16x8 af[2], bfr[2];
#pragma unroll
      for (int mi = 0; mi < 2; ++mi) af[mi] = *(const bf16x8*)(As + (wm * 64 + mi * 32 + r32) * 72 + s * 16 + h * 8);
#pragma unroll
      for (int ni = 0; ni < 2; ++ni) bfr[ni] = *(const bf16x8*)(Bs + (wn * 64 + ni * 32 + r32) * 72 + s * 16 + h * 8);
#pragma unroll
      for (int mi = 0; mi < 2; ++mi)
#pragma unroll
        for (int ni = 0; ni < 2; ++ni) acc[mi][ni] = MFMA32(af[mi], bfr[ni], acc[mi][ni]);
    }
  }
}
DI void acc_zero(f32x16 (&acc)[2][2]) {
#pragma unroll
  for (int mi = 0; mi < 2; ++mi)
#pragma unroll
    for (int ni = 0; ni < 2; ++ni)
#pragma unroll
      for (int i = 0; i < 16; ++i) acc[mi][ni][i] = 0.f;
}
#define EPI_LOOP(acc, BODY)                                                                   \
  {                                                                                           \
    const int e_lane = otid() & 63, e_wave = otid() >> 6;                           \
    const int e_wm = e_wave >> 1, e_wn = e_wave & 1, e_r = e_lane & 31, e_h = e_lane >> 5;    \
    _Pragma("unroll") for (int mi = 0; mi < 2; ++mi) _Pragma("unroll") for (int ni = 0; ni < 2; ++ni) \
    _Pragma("unroll") for (int i = 0; i < 16; ++i) {                                         \
      const int row = e_wm * 64 + mi * 32 + (i & 3) + 8 * (i >> 2) + 4 * e_h;                 \
      const int col = e_wn * 64 + ni * 32 + e_r;                                              \
      const float val = acc[mi][ni][i];                                                       \
      BODY                                                                                    \
    }                                                                                         \
  }

template <bool GLUPERM = false>
DI void transpose_tile(const float* __restrict__ src, int K, int N, u16* __restrict__ dst, int tile, float* lds) {
  const int ntn = (N + 63) >> 6;
  const int k0 = (tile / ntn) * 64, n0 = (tile % ntn) * 64;
  const int tid = otid();
  __syncthreads();
  {
    const int r = tid >> 4, c4 = (tid & 15) * 4;
#pragma unroll
    for (int i = 0; i < 4; ++i) {
      const int kk = r + 16 * i;
      float4 v = make_float4(0.f, 0.f, 0.f, 0.f);
      if (n0 + c4 < N) v = *(const float4*)(src + (size_t)(k0 + kk) * N + n0 + c4);
      lds[kk * 65 + c4 + 0] = v.x; lds[kk * 65 + c4 + 1] = v.y; lds[kk * 65 + c4 + 2] = v.z; lds[kk * 65 + c4 + 3] = v.w;
    }
  }
  __syncthreads();
  {
    const int n = tid >> 2, kc = (tid & 3) * 16;
    if (n0 + n < N) {
      unsigned w[8];
#pragma unroll
      for (int j = 0; j < 8; ++j) w[j] = cvtpk(lds[(kc + 2 * j) * 65 + n], lds[(kc + 2 * j + 1) * 65 + n]);
      int nd = n0 + n;
      if (GLUPERM) { const int ca = nd & 511; nd = (ca >> 6) * 128 + ((ca >> 5) & 1) * 64 + (nd >= 512 ? 32 : 0) + (ca & 31); }
      uint4* d = (uint4*)(dst + (size_t)nd * K + k0 + kc);
      d[0] = make_uint4(w[0], w[1], w[2], w[3]);
      d[1] = make_uint4(w[4], w[5], w[6], w[7]);
    }
  }
}
DI void convert_chunk(const float* __restrict__ src, u16* __restrict__ dst, size_t chunk) {
  const size_t o = chunk * 2048 + (size_t)otid() * 8;
  const float4 a = *(const float4*)(src + o), b = *(const float4*)(src + o + 4);
  *(uint4*)(dst + o) = make_uint4(cvtpk(a.x, a.y), cvtpk(a.z, a.w), cvtpk(b.x, b.y), cvtpk(b.z, b.w));
}

DI void convert_chunk_fp8(const float* __restrict__ src, unsigned char* __restrict__ dst, size_t chunk, float scale) {
  const size_t o = chunk * 2048 + (size_t)otid() * 8;
  const float4 a = *(const float4*)(src + o), b = *(const float4*)(src + o + 4);
  int w0 = 0, w1 = 0;
  w0 = __builtin_amdgcn_cvt_pk_fp8_f32(a.x * scale, a.y * scale, w0, false); w0 = __builtin_amdgcn_cvt_pk_fp8_f32(a.z * scale, a.w * scale, w0, true);
  w1 = __builtin_amdgcn_cvt_pk_fp8_f32(b.x * scale, b.y * scale, w1, false); w1 = __builtin_amdgcn_cvt_pk_fp8_f32(b.z * scale, b.w * scale, w1, true);
  *(uint2*)(dst + o) = make_uint2((unsigned)w0, (unsigned)w1);
}

DI void ln_mod_row(const float* __restrict__ hrow, const float* __restrict__ shift, const float* __restrict__ scale, u16* __restrict__ dst, float* red) {
  const int tid = otid();
  const float4 x = *(const float4*)(hrow + tid * 4);
  const float mean = block_sum(x.x + x.y + x.z + x.w, red) * (1.f / DM);
  const float a = x.x - mean, b = x.y - mean, c = x.z - mean, d = x.w - mean;
  const float var = block_sum(a * a + b * b + c * c + d * d, red) * (1.f / DM);
  const float rs = rsqrtf(var + LN_EPS);
  const float4 sh = *(const float4*)(shift + tid * 4), sc = *(const float4*)(scale + tid * 4);
  const float y0 = a * rs * (1.f + sc.x) + sh.x, y1 = b * rs * (1.f + sc.y) + sh.y, y2 = c * rs * (1.f + sc.z) + sh.z, y3 = d * rs * (1.f + sc.w) + sh.w;
  *(uint2*)(dst + tid * 4) = make_uint2(cvtpk(y0, y1), cvtpk(y2, y3));
}

DI void ln_mod_wave(const float* __restrict__ hrow, const float* __restrict__ shift, const float* __restrict__ scale, u16* __restrict__ dst, int lane) {
  float4 x[4];
#pragma unroll
  for (int i = 0; i < 4; ++i) x[i] = *(const float4*)(hrow + lane * 4 + 256 * i);
  float sm = 0.f;
#pragma unroll
  for (int i = 0; i < 4; ++i) sm += x[i].x + x[i].y + x[i].z + x[i].w;
  const float mean = wave_sum(sm) * (1.f / DM);
  float vs = 0.f;
#pragma unroll
  for (int i = 0; i < 4; ++i) { x[i].x -= mean; x[i].y -= mean; x[i].z -= mean; x[i].w -= mean; vs += x[i].x * x[i].x + x[i].y * x[i].y + x[i].z * x[i].z + x[i].w * x[i].w; }
  const float rs = rsqrtf(wave_sum(vs) * (1.f / DM) + LN_EPS);
#pragma unroll
  for (int i = 0; i < 4; ++i) {
    const float4 sh = *(const float4*)(shift + lane * 4 + 256 * i), sc = *(const float4*)(scale + lane * 4 + 256 * i);
    *(uint2*)(dst + lane * 4 + 256 * i) = make_uint2(cvtpk(x[i].x * rs * (1.f + sc.x) + sh.x, x[i].y * rs * (1.f + sc.y) + sh.y), cvtpk(x[i].z * rs * (1.f + sc.z) + sh.z, x[i].w * rs * (1.f + sc.w) + sh.w));
  }
}

template <int VD>
DI void attn_pass(const u16* __restrict__ qrow, const u16* __restrict__ Kb, int ldk, const u16* __restrict__ Vt, int nkeys, f32x16 (&O)[VD / 32], float& lsum, u16* lds) {
  constexpr int NV = VD / 32;
  const int tid = otid(), lane = tid & 63, r32 = lane & 31, h = lane >> 5;
  u16* Ks = lds; u16* Vs = lds + 64 * 72;
  bf16x8 qf[4];
#pragma unroll
  for (int s = 0; s < 4; ++s) qf[s] = *(const bf16x8*)(qrow + s * 16 + h * 8);
#pragma unroll
  for (int vb = 0; vb < NV; ++vb)
#pragma unroll
    for (int i = 0; i < 16; ++i) O[vb][i] = 0.f;
  float m = -INFINITY, l = 0.f;
  const float c = 0.125f * LOG2E;
  const int lr = tid >> 3, lc = (tid & 7) * 8;
  u32x4 rk[2], rv[NV];
#pragma unroll
  for (int i = 0; i < 2; ++i) rk[i] = *(const u32x4*)(Kb + (size_t)(lr + 32 * i) * ldk + lc);
#pragma unroll
  for (int i = 0; i < NV; ++i) rv[i] = *(const u32x4*)(Vt + (size_t)(lr + 32 * i) * NP + lc);
  for (int k0 = 0; k0 < nkeys; k0 += 64) {
    __syncthreads();
#pragma unroll
    for (int i = 0; i < 2; ++i) *(u32x4*)(Ks + (lr + 32 * i) * 72 + lc) = rk[i];
#pragma unroll
    for (int i = 0; i < NV; ++i) *(u32x4*)(Vs + (lr + 32 * i) * 72 + lc) = rv[i];
    __syncthreads();
    if (k0 + 64 < nkeys) {
#pragma unroll
      for (int i = 0; i < 2; ++i) rk[i] = *(const u32x4*)(Kb + (size_t)(k0 + 64 + lr + 32 * i) * ldk + lc);
#pragma unroll
      for (int i = 0; i < NV; ++i) rv[i] = *(const u32x4*)(Vt + (size_t)(lr + 32 * i) * NP + k0 + 64 + lc);
    }
    f32x16 S[2];
#pragma unroll
    for (int kb = 0; kb < 2; ++kb)
#pragma unroll
      for (int i = 0; i < 16; ++i) S[kb][i] = 0.f;
#pragma unroll
    for (int s = 0; s < 4; ++s)
#pragma unroll
      for (int kb = 0; kb < 2; ++kb) {
        const bf16x8 kf = *(const bf16x8*)(Ks + (kb * 32 + r32) * 72 + s * 16 + h * 8);
        S[kb] = MFMA32(kf, qf[s], S[kb]);
      }
    float mx = S[0][0];
#pragma unroll
    for (int kb = 0; kb < 2; ++kb)
#pragma unroll
      for (int i = 0; i < 16; ++i) mx = fmaxf(mx, S[kb][i]);
    mx = fmaxf(mx, SHX(mx, 32));
    if (__ballot(mx > m + 40.f) != 0ull) {
      const float mn = fmaxf(m, mx);
      const float alpha = fexp2((m - mn) * c);
      m = mn;
      l *= alpha;
#pragma unroll
      for (int vb = 0; vb < NV; ++vb)
#pragma unroll
        for (int i = 0; i < 16; ++i) O[vb][i] *= alpha;
    }
    const float mc = m * c;
    float rs = 0.f;
#pragma unroll
    for (int kb = 0; kb < 2; ++kb)
#pragma unroll
      for (int i = 0; i < 16; ++i) { const float pv = fexp2(S[kb][i] * c - mc); S[kb][i] = pv; rs += pv; }
    l += rs;
#pragma unroll
    for (int kb = 0; kb < 2; ++kb)
#pragma unroll
      for (int s2 = 0; s2 < 2; ++s2) {
        uint4 pw;
        pw.x = cvtpk(S[kb][8 * s2 + 0], S[kb][8 * s2 + 1]); pw.y = cvtpk(S[kb][8 * s2 + 2], S[kb][8 * s2 + 3]);
        pw.z = cvtpk(S[kb][8 * s2 + 4], S[kb][8 * s2 + 5]); pw.w = cvtpk(S[kb][8 * s2 + 6], S[kb][8 * s2 + 7]);
        const bf16x8 pf = __builtin_bit_cast(bf16x8, pw);
#pragma unroll
        for (int vb = 0; vb < NV; ++vb) {
          const u16* vp = Vs + (vb * 32 + r32) * 72 + kb * 32 + s2 * 16 + 4 * h;
          const s16x4 lo = *(const s16x4*)vp, hi = *(const s16x4*)(vp + 8);
          const bf16x8 vf = __builtin_shufflevector(lo, hi, 0, 1, 2, 3, 4, 5, 6, 7);
          O[vb] = MFMA32(vf, pf, O[vb]);
        }
      }
  }
  lsum = l + SHX(l, 32);
}

DI void attn_pass_gqa2(const u16* __restrict__ qrow0, const u16* __restrict__ qrow1, const u16* __restrict__ Kb, int ldk, const u16* __restrict__ Vt, int nkeys,
                       f32x16 (&O)[2][2], float (&lsum)[2], u16* lds) {
  const int tid = otid(), lane = tid & 63, r32 = lane & 31, h = lane >> 5;
  u16* Ks = lds; u16* Vs = lds + 64 * 72;
  bf16x8 qf[2][4];
#pragma unroll
  for (int s = 0; s < 4; ++s) { qf[0][s] = *(const bf16x8*)(qrow0 + s * 16 + h * 8); qf[1][s] = *(const bf16x8*)(qrow1 + s * 16 + h * 8); }
#pragma unroll
  for (int hd = 0; hd < 2; ++hd)
#pragma unroll
    for (int vb = 0; vb < 2; ++vb)
#pragma unroll
      for (int i = 0; i < 16; ++i) O[hd][vb][i] = 0.f;
  float m[2] = {-INFINITY, -INFINITY}, l[2] = {0.f, 0.f};
  const float c = 0.125f * LOG2E;
  const int lr = tid >> 3, lc = (tid & 7) * 8;
  u32x4 rk[2], rv[2];
#pragma unroll
  for (int i = 0; i < 2; ++i) rk[i] = *(const u32x4*)(Kb + (size_t)(lr + 32 * i) * ldk + lc);
#pragma unroll
  for (int i = 0; i < 2; ++i) rv[i] = *(const u32x4*)(Vt + (size_t)(lr + 32 * i) * NP + lc);
  for (int k0 = 0; k0 < nkeys; k0 += 64) {
    __syncthreads();
#pragma unroll
    for (int i = 0; i < 2; ++i) *(u32x4*)(Ks + (lr + 32 * i) * 72 + lc) = rk[i];
#pragma unroll
    for (int i = 0; i < 2; ++i) *(u32x4*)(Vs + (lr + 32 * i) * 72 + lc) = rv[i];
    __syncthreads();
    if (k0 + 64 < nkeys) {
#pragma unroll
      for (int i = 0; i < 2; ++i) rk[i] = *(const u32x4*)(Kb + (size_t)(k0 + 64 + lr + 32 * i) * ldk + lc);
#pragma unroll
      for (int i = 0; i < 2; ++i) rv[i] = *(const u32x4*)(Vt + (size_t)(lr + 32 * i) * NP + k0 + 64 + lc);
    }
#pragma unroll
    for (int hd = 0; hd < 2; ++hd) {
      f32x16 S[2];
#pragma unroll
      for (int kb = 0; kb < 2; ++kb)
#pragma unroll
        for (int i = 0; i < 16; ++i) S[kb][i] = 0.f;
#pragma unroll
      for (int s = 0; s < 4; ++s)
#pragma unroll
        for (int kb = 0; kb < 2; ++kb) {
          const bf16x8 kf = *(const bf16x8*)(Ks + (kb * 32 + r32) * 72 + s * 16 + h * 8);
          S[kb] = MFMA32(kf, qf[hd][s], S[kb]);
        }
      float mx = S[0][0];
#pragma unroll
      for (int kb = 0; kb < 2; ++kb)
#pragma unroll
        for (int i = 0; i < 16; ++i) mx = fmaxf(mx, S[kb][i]);
      mx = fmaxf(mx, SHX(mx, 32));
      if (__ballot(mx > m[hd] + 40.f) != 0ull) {
        const float mn = fmaxf(m[hd], mx);
        const float alpha = fexp2((m[hd] - mn) * c);
        m[hd] = mn;
        l[hd] *= alpha;
#pragma unroll
        for (int vb = 0; vb < 2; ++vb)
#pragma unroll
          for (int i = 0; i < 16; ++i) O[hd][vb][i] *= alpha;
      }
      const float mc = m[hd] * c;
      float rs = 0.f;
#pragma unroll
      for (int kb = 0; kb < 2; ++kb)
#pragma unroll
        for (int i = 0; i < 16; ++i) { const float pv = fexp2(S[kb][i] * c - mc); S[kb][i] = pv; rs += pv; }
      l[hd] += rs;
#pragma unroll
      for (int kb = 0; kb < 2; ++kb)
#pragma unroll
        for (int s2 = 0; s2 < 2; ++s2) {
          uint4 pw;
          pw.x = cvtpk(S[kb][8 * s2 + 0], S[kb][8 * s2 + 1]); pw.y = cvtpk(S[kb][8 * s2 + 2], S[kb][8 * s2 + 3]);
          pw.z = cvtpk(S[kb][8 * s2 + 4], S[kb][8 * s2 + 5]); pw.w = cvtpk(S[kb][8 * s2 + 6], S[kb][8 * s2 + 7]);
          const bf16x8 pf = __builtin_bit_cast(bf16x8, pw);
#pragma unroll
          for (int vb = 0; vb < 2; ++vb) {
            const u16* vp = Vs + (vb * 32 + r32) * 72 + kb * 32 + s2 * 16 + 4 * h;
            const s16x4 lo = *(const s16x4*)vp, hi = *(const s16x4*)(vp + 8);
            const bf16x8 vf = __builtin_shufflevector(lo, hi, 0, 1, 2, 3, 4, 5, 6, 7);
            O[hd][vb] = MFMA32(vf, pf, O[hd][vb]);
          }
        }
    }
  }
  lsum[0] = l[0] + SHX(l[0], 32);
  lsum[1] = l[1] + SHX(l[1], 32);
}

DI int chain_idx(int dir, int s) { return dir == 0 ? (s < SL ? s + SC : s - SL) : (SB - 1 - s); }
DI void mlstm_dir(const bf16x8 (&qf)[8], const u16* __restrict__ Kb, const u16* __restrict__ Vt, const float* __restrict__ Aarr, const float* __restrict__ tmax, int dir,
                  int t0a, int t0b, int t1a, int t1b, int cq, float mxq, f32x16 (&num)[4], float& den_out, char* smem) {
  const int tid = otid(), lane = tid & 63, r32 = lane & 31, h = lane >> 5;
  u16* Ks = (u16*)smem; u16* Vs = (u16*)(smem + 17408); float* As = (float*)(smem + 17408 + 18432);
  float den = 0.f;
  const int n0 = t0b - t0a, nall = n0 + (t1b - t1a);
  const int kr = tid >> 4, kc = (tid & 15) * 8, vr = tid >> 3, vc = (tid & 7) * 8;
  u32x4 rk[4], rv[4]; float ra = 0.f;
  int* tlist = (int*)(smem + 17408 + 18432 + 256);
  float* tred = (float*)(smem + 17408 + 18432 + 256 + 544);
  {
    float mn = fminf(mxq, SHX(mxq, 32));
    mn = fminf(mn, SHX(mn, 16)); mn = fminf(mn, SHX(mn, 8)); mn = fminf(mn, SHX(mn, 4)); mn = fminf(mn, SHX(mn, 2)); mn = fminf(mn, SHX(mn, 1));
    __syncthreads();
    if (lane == 0) tred[tid >> 6] = mn;
    __syncthreads();
    if (tid == 0) {
      const float bmin = fminf(fminf(tred[0], tred[1]), fminf(tred[2], tred[3]));
      int cnt = 0;
      for (int u = 0; u < nall; ++u) {
        const int k0 = u < n0 ? SL + 64 * (t0a + u) : 64 * (t1a + u - n0);
        if (tmax[k0 >> 6] * LOG2E - bmin > -64.f) tlist[1 + cnt++] = k0;
      }
      tlist[0] = cnt;
    }
    __syncthreads();
  }
  const int ntile = tlist[0];
  auto tile_k0 = [&](int u) { return tlist[1 + u]; };
  for (int u = 0; u < ntile; ++u) {
    const int k0 = tile_k0(u);
    __syncthreads();
    {
#pragma unroll
      for (int i = 0; i < 4; ++i) rk[i] = *(const u32x4*)(Kb + (size_t)(k0 + kr + 16 * i) * 512 + kc);
#pragma unroll
      for (int i = 0; i < 4; ++i) rv[i] = *(const u32x4*)(Vt + (size_t)(vr + 32 * i) * NP + k0 + vc);
      if (tid < 64) ra = Aarr[k0 + tid] * LOG2E;
#pragma unroll
      for (int i = 0; i < 4; ++i) *(u32x4*)(Ks + (kr + 16 * i) * 136 + kc) = rk[i];
#pragma unroll
      for (int i = 0; i < 4; ++i) *(u32x4*)(Vs + (vr + 32 * i) * 72 + vc) = rv[i];
      if (tid < 64) As[tid] = ra;
    }
    __syncthreads();
    f32x16 S[2];
#pragma unroll
    for (int kb = 0; kb < 2; ++kb)
#pragma unroll
      for (int i = 0; i < 16; ++i) S[kb][i] = 0.f;
#pragma unroll
    for (int s = 0; s < 8; ++s)
#pragma unroll
      for (int kb = 0; kb < 2; ++kb) {
        const bf16x8 kf = *(const bf16x8*)(Ks + (kb * 32 + r32) * 136 + s * 16 + h * 8);
        S[kb] = MFMA32(kf, qf[s], S[kb]);
      }
#pragma unroll
    for (int kb = 0; kb < 2; ++kb)
#pragma unroll
      for (int g = 0; g < 4; ++g) {
        const float4 a4 = *(const float4*)(As + kb * 32 + 8 * g + 4 * h);
        const float av[4] = {a4.x, a4.y, a4.z, a4.w};
#pragma unroll
        for (int e = 0; e < 4; ++e) {
          const int sk = k0 + kb * 32 + 8 * g + 4 * h + e;
          const int ck = chain_idx(dir, sk);
          const float w = (ck <= cq) ? fexp2(fminf(av[e] - mxq, 0.f)) : 0.f;
          const float pv = S[kb][4 * g + e] * w;
          S[kb][4 * g + e] = pv; den += pv;
        }
      }
#pragma unroll
    for (int kb = 0; kb < 2; ++kb)
#pragma unroll
      for (int s2 = 0; s2 < 2; ++s2) {
        uint4 pw;
        pw.x = cvtpk(S[kb][8 * s2 + 0], S[kb][8 * s2 + 1]); pw.y = cvtpk(S[kb][8 * s2 + 2], S[kb][8 * s2 + 3]);
        pw.z = cvtpk(S[kb][8 * s2 + 4], S[kb][8 * s2 + 5]); pw.w = cvtpk(S[kb][8 * s2 + 6], S[kb][8 * s2 + 7]);
        const bf16x8 pf = __builtin_bit_cast(bf16x8, pw);
#pragma unroll
        for (int vb = 0; vb < 4; ++vb) {
          const u16* vp = Vs + (vb * 32 + r32) * 72 + kb * 32 + s2 * 16 + 4 * h;
          const s16x4 lo = *(const s16x4*)vp, hi = *(const s16x4*)(vp + 8);
          const bf16x8 vf = __builtin_shufflevector(lo, hi, 0, 1, 2, 3, 4, 5, 6, 7);
          num[vb] = MFMA32(vf, pf, num[vb]);
        }
      }
  }
  den_out += den + SHX(den, 32);
}

DI void s5_load_u(const u16* __restrict__ S5U, int b, int lo, int g, float* lu, int lane) {
  const u16* src = S5U + ((size_t)b * SB + lo + lane) * 512 + g * 16;
  const uint4 a = *(const uint4*)src, c = *(const uint4*)(src + 8);
  float* d = lu + lane * 16;
  d[0] = bflo(a.x); d[1] = bfhi(a.x); d[2] = bflo(a.y); d[3] = bfhi(a.y); d[4] = bflo(a.z); d[5] = bfhi(a.z); d[6] = bflo(a.w); d[7] = bfhi(a.w);
  d[8] = bflo(c.x); d[9] = bfhi(c.x); d[10] = bflo(c.y); d[11] = bfhi(c.y); d[12] = bflo(c.z); d[13] = bfhi(c.z); d[14] = bflo(c.w); d[15] = bfhi(c.w);
}

DI void s5_bu_half(const u16* __restrict__ urow, const bf16x8 (&bfr)[4], u16* W, int r32, int h) {
  const bf16x8 af = *(const bf16x8*)urow;
#pragma unroll
  for (int j = 0; j < 4; ++j) {
    f32x16 z;
#pragma unroll
    for (int i = 0; i < 16; ++i) z[i] = 0.f;
    const f32x16 acc = MFMA32(af, bfr[j], z);
#pragma unroll
    for (int i = 0; i < 16; ++i) W[((i & 3) + 8 * (i >> 2) + 4 * h) * 136 + 32 * j + r32] = f2bf(acc[i]);
  }
}
template <bool WB>
DI void s5_scan_half(u16* W, int dir, int recol, float2 lam, float& hr, float& hi) {
#pragma unroll 4
  for (int q = 0; q < 32; ++q) {
    const int t = dir ? 31 - q : q;
    const float br = bf2f(W[t * 136 + recol]), bi = bf2f(W[t * 136 + recol + 32]);
    const float nr = lam.x * hr - lam.y * hi + br, ni = lam.x * hi + lam.y * hr + bi;
    hr = nr; hi = ni;
    if (WB) { W[t * 136 + recol] = f2bf(hr); W[t * 136 + recol + 32] = f2bf(hi); }
  }
}

__device__ const unsigned char PEER_PAIRS[64] = {0, 1, 2, 3, 4, 5, 6, 7, 8, 9, 10, 11, 12, 13, 14, 15, 16, 17, 18, 19, 20, 21, 22, 23, 32, 33, 34, 35, 36, 48, 49, 50, 51, 64, 65, 66, 80, 81, 96, 97, 112, 113, 128, 144, 160, 176, 192, 208, 224, 240, 0, 0, 0, 0, 0, 0, 0, 0, 0, 0, 0, 0, 0, 0};

constexpr int NPH_LAYER = 14;
constexpr int NPHASES = 2 + 2 * NPH_LAYER;

__device__ __forceinline__ void run_phase(const P& p, int ph, char* smem) {
  const int tid = otid(), lane = tid & 63, wave = tid >> 6;
  const int G = gridDim.x, bid = blockIdx.x;
  char* ws = WSP;
  float* fsm = (float*)smem;
  u16* usm = (u16*)smem;

  if (ph == 0) {
    const int n_mod = 2 * 8 * 24, n_s5 = 32, n_all = n_mod + n_s5 + 2;
    for (int it = bid; it < n_all; it += G) {
      if (it < n_mod) {
        const int L = it / 192, ic = (it / 24) % 8, jc = it % 24;
        __syncthreads();
        for (int e = tid; e < 5 * 128; e += 256) {
          const int v = e / 128, i = ic * 128 + (e % 128);
          const float cv = v < 4 ? IN(1)[v * DM + i] : IN(3)[i];
          fsm[e] = silu_(cv);
        }
        __syncthreads();
        const int j = jc * 256 + tid;
        const float* w = IN(4) + ((size_t)L * DM + ic * 128) * 6144 + j;
        float a0 = 0, a1 = 0, a2 = 0, a3 = 0, a4 = 0;
#pragma unroll 8
        for (int i = 0; i < 128; ++i) {
          const float wv = w[(size_t)i * 6144];
          a0 += fsm[i] * wv; a1 += fsm[128 + i] * wv; a2 += fsm[256 + i] * wv; a3 += fsm[384 + i] * wv; a4 += fsm[512 + i] * wv;
        }
        float* o = (float*)(ws + OFF_MODP) + ((size_t)(L * 8 + ic) * 5) * 6144 + j;
        o[0] = a0; o[6144] = a1; o[2 * 6144] = a2; o[3 * 6144] = a3; o[4 * 6144] = a4;
      } else if (it < n_mod + n_s5) {
        const int e = (it - n_mod) * 256 + tid;
        const int n = e & 63, g = (e >> 6) & 31, ld = e >> 11;
        const float dt = expf(IN(14)[ld * 32 + g]);
        const float ar = IN(12)[e], ai = IN(13)[e];
        const float mag = expf(ar * dt);
        float sn, cs; sincosf(ai * dt, &sn, &cs);
        const float lr = mag * cs, li = mag * sn;
        const float dn = ar * ar + ai * ai;
        const float cr = ((lr - 1.f) * ar + li * ai) / dn, ci = (li * ar - (lr - 1.f) * ai) / dn;
        ((float2*)(ws + OFF_LAMB))[e] = make_float2(lr, li);
        float2* bb = (float2*)(ws + OFF_BBAR) + (size_t)e * 16;
        const float* br = IN(15) + (size_t)e * 16; const float* bi = IN(16) + (size_t)e * 16;
        const int colre = n < 32 ? n : n + 32, colim = colre + 32;
        u16* bbt = (u16*)(ws + OFF_BBT) + (size_t)(e >> 6) * 2048;
        u16* cmt = (u16*)(ws + OFF_CMT) + (size_t)(e >> 6) * 2048;
        for (int c = 0; c < 16; ++c) {
          const float2 v = make_float2(cr * br[c] - ci * bi[c], cr * bi[c] + ci * br[c]);
          bb[c] = v;
          bbt[colre * 16 + c] = f2bf(v.x); bbt[colim * 16 + c] = f2bf(v.y);
          cmt[c * 128 + colre] = f2bf(IN(17)[((size_t)(e >> 6) * 16 + c) * 64 + n]);
          cmt[c * 128 + colim] = f2bf(-IN(18)[((size_t)(e >> 6) * 16 + c) * 64 + n]);
        }
      } else if (it == n_mod + n_s5 + 1) {
        for (int e = tid; e < 192 * 16; e += 256) {
          const int r = e >> 4, i = e & 15;
          const float inv = exp2f(-(float)i * (13.287712379549449f / 16.f));
          float sn, cs; sincosf((float)(r < 128 ? r : r - 128) * inv, &sn, &cs);
          ((float2*)(ws + OFF_ROPE))[e] = make_float2(cs, sn);
        }
      } else {
        if (tid >= 64 && tid < 72) ((int*)(ws + OFF_CTR))[tid - 64] = 0;
        if (tid < 2) {
          const float* lv = IN(8) + tid * 256;
          float s01 = 0.f, s23 = 0.f;
          for (int i = 0; i < 64; ++i) { s01 += lv[i] * lv[64 + i]; s23 += lv[128 + i] * lv[192 + i]; }
          const float lam_init = 0.8f - 0.6f * expf(-0.3f * (float)tid);
          ((float*)(ws + OFF_LAMV))[tid] = expf(s01) - expf(s23) + lam_init;
        }
      }
    }
    return;
  }
  if (ph == 1) {
    const int n_all = 2 * 5 * 6144 / 256;
    for (int it = bid; it < n_all; it += G) {
      const int e = it * 256 + tid;
      const int L = e / (5 * 6144), v = (e / 6144) % 5, j = e % 6144;
      float a = IN(5)[L * 6144 + j];
      for (int ic = 0; ic < 8; ++ic) a += ((const float*)(ws + OFF_MODP))[((size_t)(L * 8 + ic) * 5 + v) * 6144 + j];
      ((float*)(ws + OFF_MOD))[e] = a;
    }
    return;
  }
  const int L = (ph - 2) / NPH_LAYER, k = (ph - 2) % NPH_LAYER;
  u16* XM = (u16*)(ws + OFF_A);
  u16* WinT = (u16*)(ws + OFF_WIN);

  int* s_next = (int*)(smem + 57336);
#define FETCH_ITEM() ([&]() { __syncthreads(); if (otid() == 0) *s_next = atomicAdd(ctr, 1); __syncthreads(); return *s_next; }())
  if (k == 0) {
    const int n_win = 16 * 141, n_wbr = 4 * 8 * 16, n_wo = 256, n_wg = 128, n_wq = 512, n_sk = 16;
    const int n_w = n_win + n_wbr + n_wo + n_wg + n_wq + n_sk;
    const int n_all = n_w + NP / 4;
    for (int it = bid; it < n_all; it += G) {
      if (it < n_w) {
        int t = it;
        if (t < n_win) { transpose_tile(IN(6) + (size_t)L * DM * NIN, DM, NIN, WinT, t, fsm); continue; }
        t -= n_win;
        if (t < n_wbr) { const int kb = t / 128; transpose_tile(IN(26) + ((size_t)L * 4 + kb) * 512 * DM, 512, DM, (u16*)(ws + OFF_WBR) + (size_t)kb * DM * 512, t % 128, fsm); continue; }
        t -= n_wbr;
        if (t < n_wo) { transpose_tile(IN(27) + (size_t)L * DM * DM, DM, DM, (u16*)(ws + OFF_WO), t, fsm); continue; }
        t -= n_wo;
        if (t < n_wg) { transpose_tile<true>(IN(20) + (size_t)L * 512 * DM, 512, DM, (u16*)(ws + OFF_WGLU), t, fsm); continue; }
        t -= n_wg;
        if (t < n_wq) { transpose_tile(IN(32) + (size_t)L * DM * 2048, DM, 2048, (u16*)(ws + OFF_WQ), t, fsm); continue; }
        t -= n_wq;
        convert_chunk(IN(33) + (size_t)L * 32768, (u16*)(ws + OFF_SK), t);
      } else {
        const int pos = (it - n_w) * 4 + wave;
        const float* md = mod_ptr(p, L, pos);
        ln_mod_wave(h_in_ptr(p, L, pos), md, md + 1024, XM + (size_t)pos * DM, lane);
      }
    }
    return;
  }
  if (k == 1) {
    const int n_all = 264 * 39;
    for (int it = bid; it < n_all; it += G) {
      const int mt = it / 39, j = it % 39;
      f32x16 acc[2][2]; acc_zero(acc);
      if (j < 30) {
        int src; u16* dst; int ldd = 512, dcol;
        if (j < 4) { src = j * 128; dst = (u16*)(ws + OFF_QD); dcol = j * 128; }
        else if (j < 8) { src = 512 + (j - 4) * 128; dst = (u16*)(ws + OFF_KD); dcol = (j - 4) * 128; }
        else if (j < 12) { src = 1536 + (j - 8) * 128; dst = (u16*)(ws + OFF_S5U); dcol = (j - 8) * 128; }
        else if (j < 16) { src = 2048 + (j - 12) * 128; dst = (u16*)(ws + OFF_MQ); dcol = (j - 12) * 128; }
        else if (j < 20) { src = 2560 + (j - 16) * 128; dst = (u16*)(ws + OFF_MK); dcol = (j - 16) * 128; }
        else if (j < 24) { src = 3584 + (j - 20) * 128; dst = (u16*)(ws + OFF_MO); dcol = (j - 20) * 128; }
        else if (j < 28) { src = 4112 + (j - 24) * 128; dst = (u16*)(ws + OFF_QG); dcol = (j - 24) * 128; }
        else if (j == 28) { src = 4624; dst = (u16*)(ws + OFF_KG); dcol = 0; ldd = 128; }
        else { src = 4096; dst = nullptr; dcol = 0; }
        gemm_core(XM + (size_t)mt * 128 * DM, DM, WinT + (size_t)src * DM, DM, DM, acc, usm);
        if (j < 29) {
          EPI_LOOP(acc, { dst[(size_t)(mt * 128 + row) * ldd + dcol + col] = f2bf(val); })
        } else {
          float* mg = (float*)(ws + OFF_MGATE);
          EPI_LOOP(acc, { if (col < 16) mg[(size_t)(mt * 128 + row) * 16 + col] = val; })
        }
      } else {
        const int jj = j - 30;
        int src; u16* dst; int drow;
        if (jj < 4) { src = 1024 + jj * 128; dst = (u16*)(ws + OFF_VDT); drow = jj * 128; }
        else if (jj < 8) { src = 3072 + (jj - 4) * 128; dst = (u16*)(ws + OFF_MVT); drow = (jj - 4) * 128; }
        else { src = 4752; dst = (u16*)(ws + OFF_VGT); drow = 0; }
        gemm_core(WinT + (size_t)src * DM, DM, XM + (size_t)mt * 128 * DM, DM, DM, acc, usm);
        EPI_LOOP(acc, { dst[(size_t)(drow + row) * NP + mt * 128 + col] = f2bf(val); })
      }
    }
    return;
  }
  if (k == 2) {
    const int n_s5 = NB * 2 * 32 * 132 / 4;
    const int n_pp = NP / 4;
    const int n_all = n_pp + n_s5;
    for (int it = bid; it < n_all; it += G) {
      if (it < n_pp) {
        const int pos = it * 4 + wave, b = pos / SB, s = pos - b * SB;
        const bool lat = s < SL;
        const int rrow = s >> 6, rcol = 128 + (s & 63);
        if (lat) {
          const int vec = lane >> 2, half = (lane >> 1) & 1, i0 = (lane & 1) * 8;
          u16* base = (u16*)(ws + (vec < 8 ? OFF_QD : OFF_KD)) + (size_t)pos * 512 + (vec & 7) * 64 + half * 32 + i0;
          const u32x4 a = *(const u32x4*)base, b = *(const u32x4*)(base + 16);
          const float4* tb = (const float4*)((const float2*)(ws + OFF_ROPE) + (half ? rcol : rrow) * 16 + i0);
          const float4 t0 = tb[0], t1 = tb[1], t2 = tb[2], t3 = tb[3];
          const float x1[8] = {bflo(a.x), bfhi(a.x), bflo(a.y), bfhi(a.y), bflo(a.z), bfhi(a.z), bflo(a.w), bfhi(a.w)};
          const float x2[8] = {bflo(b.x), bfhi(b.x), bflo(b.y), bfhi(b.y), bflo(b.z), bfhi(b.z), bflo(b.w), bfhi(b.w)};
          const float cs[8] = {t0.x, t0.z, t1.x, t1.z, t2.x, t2.z, t3.x, t3.z};
          const float sn[8] = {t0.y, t0.w, t1.y, t1.w, t2.y, t2.w, t3.y, t3.w};
          float o1[8], o2[8];
#pragma unroll
          for (int e = 0; e < 8; ++e) { o1[e] = x1[e] * cs[e] - x2[e] * sn[e]; o2[e] = x2[e] * cs[e] + x1[e] * sn[e]; }
          u32x4 w1, w2;
          w1.x = cvtpk(o1[0], o1[1]); w1.y = cvtpk(o1[2], o1[3]); w1.z = cvtpk(o1[4], o1[5]); w1.w = cvtpk(o1[6], o1[7]);
          w2.x = cvtpk(o2[0], o2[1]); w2.y = cvtpk(o2[2], o2[3]); w2.z = cvtpk(o2[4], o2[5]); w2.w = cvtpk(o2[6], o2[7]);
          *(u32x4*)base = w1; *(u32x4*)(base + 16) = w2;
        }
        {
          const int c = lane & 7, hh = c >> 2, ie = (c & 1) * 8;
          const float4* tb = (const float4*)((const float2*)(ws + OFF_ROPE) + (hh ? rcol : rrow) * 16 + ie);
          const float4 t0 = tb[0], t1 = tb[1], t2 = tb[2], t3 = tb[3];
          const float cs[8] = {t0.x, t0.z, t1.x, t1.z, t2.x, t2.z, t3.x, t3.z};
          const float sn[8] = {t0.y, t0.w, t1.y, t1.w, t2.y, t2.w, t3.y, t3.w};
#pragma unroll
          for (int rnd = 0; rnd < 2; ++rnd) {
            const bool act = rnd == 0 || lane < 16;
            const int vec = lane >> 3;
            u16* ptr = rnd == 0 ? (u16*)(ws + OFF_QG) + (size_t)pos * 512 + vec * 64 + c * 8 : (u16*)(ws + OFF_KG) + (size_t)pos * 128 + (vec & 1) * 64 + c * 8;
            const float* gp = (rnd == 0 ? IN(10) : IN(11)) + L * 64 + c * 8;
            const u32x4 a = *(const u32x4*)ptr;
            const float4 g0 = *(const float4*)gp, g1 = *(const float4*)(gp + 4);
            float x[8] = {bflo(a.x), bfhi(a.x), bflo(a.y), bfhi(a.y), bflo(a.z), bfhi(a.z), bflo(a.w), bfhi(a.w)};
            float ss = 0.f;
#pragma unroll
            for (int e = 0; e < 8; ++e) ss += x[e] * x[e];
            ss += SHX(ss, 1); ss += SHX(ss, 2); ss += SHX(ss, 4);
            const float rs = rsqrtf(ss * (1.f / 64.f) + LN_EPS);
            const float gg[8] = {g0.x, g0.y, g0.z, g0.w, g1.x, g1.y, g1.z, g1.w};
            float y[8];
#pragma unroll
            for (int e = 0; e < 8; ++e) y[e] = x[e] * rs * gg[e];
            if (lat) {
#pragma unroll
              for (int e = 0; e < 8; ++e) {
                const float yp = SHX(y[e], 2);
                x[e] = (c & 2) ? (y[e] * cs[e] + yp * sn[e]) : (y[e] * cs[e] - yp * sn[e]);
              }
#pragma unroll
              for (int e = 0; e < 8; ++e) y[e] = x[e];
            }
            if (act) { u32x4 w; w.x = cvtpk(y[0], y[1]); w.y = cvtpk(y[2], y[3]); w.z = cvtpk(y[4], y[5]); w.w = cvtpk(y[6], y[7]); *(u32x4*)ptr = w; }
          }
        }
        {
          const int seg_lo = lat ? 0 : SL, seg_hi = lat ? SL - 1 : SB - 1;
#pragma unroll
          for (int q = 0; q < 4; ++q) {
            const int ch = (lane + 64 * q) * 4;
            const u16* raw = (const u16*)(ws + (ch < 512 ? OFF_MQ : OFF_MK)) + (ch & 511);
            const uint2 xc = *(const uint2*)(raw + (size_t)pos * 512);
            uint2 xm = make_uint2(0, 0), xp = make_uint2(0, 0);
            if (s > seg_lo) xm = *(const uint2*)(raw + (size_t)(pos - 1) * 512);
            if (s < seg_hi) xp = *(const uint2*)(raw + (size_t)(pos + 1) * 512);
            const float* cw = IN(22) + (size_t)L * 3 * 1024 + ch; const float* cb = IN(23) + (size_t)L * 1024 + ch;
            const float4 w0 = *(const float4*)cw, w1 = *(const float4*)(cw + 1024), w2 = *(const float4*)(cw + 2048), bb = *(const float4*)cb;
            float o0 = bb.x + w0.x * bflo(xm.x) + w1.x * bflo(xc.x) + w2.x * bflo(xp.x);
            float o1 = bb.y + w0.y * bfhi(xm.x) + w1.y * bfhi(xc.x) + w2.y * bfhi(xp.x);
            float o2 = bb.z + w0.z * bflo(xm.y) + w1.z * bflo(xc.y) + w2.z * bflo(xp.y);
            float o3 = bb.w + w0.w * bfhi(xm.y) + w1.w * bfhi(xc.y) + w2.w * bfhi(xp.y);
            const float ksc = ch < 512 ? 1.f : 0.08838834764831845f;
            o0 = silu_(o0) * ksc; o1 = silu_(o1) * ksc; o2 = silu_(o2) * ksc; o3 = silu_(o3) * ksc;
            u16* dstc = (u16*)(ws + OFF_A) + (ch < 512 ? (size_t)0 : (size_t)NP * 512) + (size_t)pos * 512 + (ch & 511);
            *(uint2*)dstc = make_uint2(cvtpk(o0, o1), cvtpk(o2, o3));
          }
        }
        if (lane < 16) {
          const float g = ((const float*)(ws + OFF_MGATE))[(size_t)pos * 16 + lane] + IN(24)[L * 16 + lane];
          const int type = lane >> 2, head = lane & 3, dir = type >> 1;
          const int chain = dir * 16 + b * 4 + head;
          if (type & 1) ((float*)(ws + OFF_GF))[(size_t)chain * SB + s] = fminf(g, 0.f) - log1pf(expf(-fabsf(g)));
          else ((float*)(ws + OFF_GI))[(size_t)chain * SB + s] = g;
        }
      } else {
        const int item = (it - n_pp) * 4 + wave;
        const int kk = item % 132, g = (item / 132) & 31, dir = (item / (132 * 32)) & 1, b = item / (132 * 64);
        const int lo = dir == 0 ? (kk < 4 ? SL + 64 * kk : 64 * (kk - 4)) : (kk < 4 ? SL + 192 - 64 * kk : 8128 - 64 * (kk - 4));
        const int r32 = lane & 31, h = lane >> 5;
        const int ldg = (L * 2 + dir) * 32 + g;
        u16* W = usm + wave * 4352;
        __syncthreads();
        const float2 lam = ((const float2*)(ws + OFF_LAMB))[ldg * 64 + lane];
        bf16x8 bfr[4];
#pragma unroll
        for (int j = 0; j < 4; ++j) bfr[j] = *(const bf16x8*)((const u16*)(ws + OFF_BBT) + ((size_t)ldg * 128 + 32 * j + r32) * 16 + 8 * h);
        const int recol = lane < 32 ? lane : lane + 32;
        float hr = 0.f, hi = 0.f;
#pragma unroll 1
        for (int hq = 0; hq < 2; ++hq) {
          const int hh = dir ? 1 - hq : hq;
          s5_bu_half((const u16*)(ws + OFF_S5U) + ((size_t)b * SB + lo + 32 * hh + r32) * 512 + g * 16 + 8 * h, bfr, W, r32, h);
          s5_scan_half<false>(W, dir, recol, lam, hr, hi);
        }
        ((float2*)(ws + OFF_HEND))[(size_t)item * 64 + lane] = make_float2(hr, hi);
      }
    }
    return;
  }
  if (k == 3) {
    const int n_all = 32 + 64 + 1056;
    for (int it = bid; it < n_all; it += G) {
      if (it >= 96) {
        const int i2 = it - 96, chain = i2 / 33, j = i2 % 33, dir = chain >> 4, b = (chain >> 2) & 3, head = chain & 3;
        const int p0 = j == 0 ? SL : (dir == 0 ? 256 * (j - 1) : SL - 256 * j);
        const int r32 = lane & 31, h = lane >> 5;
        u16* Ks = usm;
        float* wS = fsm + 4352;
        float* red = fsm + 4352 + 256;
        __syncthreads();
        {
          const int so = dir == 0 ? tid : 255 - tid;
          const float lf = ((const float*)(ws + OFF_GF))[(size_t)chain * SB + p0 + so];
          const float ig = ((const float*)(ws + OFF_GI))[(size_t)chain * SB + p0 + so];
          float x = lf;
#pragma unroll
          for (int d = 1; d < 64; d <<= 1) { const float y = __int_as_float(__builtin_amdgcn_ds_bpermute(((lane - d) & 63) << 2, __float_as_int(x))); if (lane >= d) x += y; }
          if (lane == 63) red[wave] = x;
          __syncthreads();
          float off = 0.f;
          for (int w = 0; w < wave; ++w) off += red[w];
          const float aloc = ig - (x + off);
          const float mx = wave_max(aloc);
          if (lane == 0) red[4 + wave] = mx;
          __syncthreads();
          const float am = fmaxf(fmaxf(red[4], red[5]), fmaxf(red[6], red[7]));
          wS[so] = __expf(aloc - am);
          if (tid == 0) ((float*)(ws + OFF_ALOC))[i2] = am;
        }
        f32x16 acc[4];
#pragma unroll
        for (int vb = 0; vb < 4; ++vb)
#pragma unroll
          for (int i = 0; i < 16; ++i) acc[vb][i] = 0.f;
        float nacc = 0.f;
        const u16* Kg = (const u16*)(ws + OFF_A) + (size_t)NP * 512 + ((size_t)b * SB + p0) * 512 + head * 128;
        const u16* Vg = (const u16*)(ws + OFF_MVT) + (size_t)(head * 128) * NP + (size_t)b * SB + p0;
#pragma unroll 1
        for (int sub = 0; sub < 4; ++sub) {
          __syncthreads();
          {
            const int kr = tid >> 4, kc = (tid & 15) * 8;
#pragma unroll
            for (int i = 0; i < 4; ++i) *(u32x4*)(Ks + (kr + 16 * i) * 136 + kc) = *(const u32x4*)(Kg + (size_t)(sub * 64 + kr + 16 * i) * 512 + kc);
          }
          __syncthreads();
#pragma unroll
          for (int s16 = 0; s16 < 4; ++s16) {
            float kv[8];
#pragma unroll
            for (int jj = 0; jj < 8; ++jj) {
              const int sl = 16 * s16 + 8 * h + jj;
              kv[jj] = bf2f(Ks[sl * 136 + 32 * wave + r32]) * wS[sub * 64 + sl];
              nacc += kv[jj];
            }
            u32x4 aw; aw.x = cvtpk(kv[0], kv[1]); aw.y = cvtpk(kv[2], kv[3]); aw.z = cvtpk(kv[4], kv[5]); aw.w = cvtpk(kv[6], kv[7]);
            const bf16x8 af = __builtin_bit_cast(bf16x8, aw);
#pragma unroll
            for (int vb = 0; vb < 4; ++vb) {
              const bf16x8 vf = *(const bf16x8*)(Vg + (size_t)(32 * vb + r32) * NP + sub * 64 + 16 * s16 + 8 * h);
              acc[vb] = MFMA32(af, vf, acc[vb]);
            }
          }
        }
        u16* Gd = (u16*)(ws + OFF_GST) + (size_t)i2 * 16384;
#pragma unroll
        for (int vb = 0; vb < 4; ++vb)
#pragma unroll
          for (int g = 0; g < 4; ++g)
            *(uint2*)(Gd + (size_t)(32 * vb + r32) * 128 + 32 * wave + 8 * g + 4 * h) = make_uint2(cvtpk(acc[vb][4 * g], acc[vb][4 * g + 1]), cvtpk(acc[vb][4 * g + 2], acc[vb][4 * g + 3]));
        nacc += SHX(nacc, 32);
        if (h == 0) ((float*)(ws + OFF_NST))[(size_t)i2 * 128 + 32 * wave + r32] = nacc;
      } else if (it < 32) {
        const int chain = it, dir = chain >> 4;
        const float* gi = (const float*)(ws + OFF_GI) + (size_t)chain * SB;
        const float* gf = (const float*)(ws + OFF_GF) + (size_t)chain * SB;
        auto spos = [&](int c) { return dir == 0 ? (c < SC ? SL + c : c - SC) : (SB - 1 - c); };
        float tot = 0.f;
        for (int j = 0; j < 33; ++j) tot += gf[spos(tid * 33 + j)];
        __syncthreads();
        fsm[tid] = tot;
        __syncthreads();
        float pre = 0.f;
        for (int i = 0; i < tid; ++i) pre += fsm[i];
        float F = pre, lm = -INFINITY;
        for (int j = 0; j < 33; ++j) { const int sp = spos(tid * 33 + j); F += gf[sp]; lm = fmaxf(lm, gi[sp] - F); }
        __syncthreads();
        fsm[256 + tid] = lm;
        __syncthreads();
        float pm = 0.f;
        for (int i = 0; i < tid; ++i) pm = fmaxf(pm, fsm[256 + i]);
        F = pre;
        for (int j = 0; j < 33; ++j) {
          const int sp = spos(tid * 33 + j);
          F += gf[sp];
          const float a = gi[sp] - F;
          pm = fmaxf(pm, a);
          ((float*)(ws + OFF_AA))[(size_t)chain * SB + sp] = a;
          ((float*)(ws + OFF_MXA))[(size_t)chain * SB + sp] = pm;
          ((float*)(ws + OFF_MTA))[(size_t)chain * SB + sp] = F + pm;
        }
        __threadfence_block();
        __syncthreads();
        if (tid < 132) {
          const float* aa = (const float*)(ws + OFF_AA) + (size_t)chain * SB + tid * 64;
          float mxv = aa[0];
          for (int j = 1; j < 64; ++j) mxv = fmaxf(mxv, aa[j]);
          ((float*)(ws + OFF_TMAX))[chain * 132 + tid] = mxv;
        }
      } else {
        const int item = (it - 32) * 4 + wave;
        const int g = item & 31, dir = (item >> 5) & 1;
        float2 lam = ((const float2*)(ws + OFF_LAMB))[((L * 2 + dir) * 32 + g) * 64 + lane];
#pragma unroll
        for (int q = 0; q < 6; ++q) lam = make_float2(lam.x * lam.x - lam.y * lam.y, 2.f * lam.x * lam.y);
        float cr = 0.f, ci = 0.f;
        const float2* he = (const float2*)(ws + OFF_HEND) + (size_t)item * 132 * 64 + lane;
        float2* ca = (float2*)(ws + OFF_CARRY) + (size_t)item * 132 * 64 + lane;
#pragma unroll 1
        for (int kk0 = 0; kk0 < 132; kk0 += 12) {
          float2 e[12];
#pragma unroll
          for (int j = 0; j < 12; ++j) e[j] = he[(kk0 + j) * 64];
#pragma unroll
          for (int j = 0; j < 12; ++j) {
            ca[(kk0 + j) * 64] = make_float2(cr, ci);
            const float nr = lam.x * cr - lam.y * ci + e[j].x, ni = lam.x * ci + lam.y * cr + e[j].y;
            cr = nr; ci = ni;
          }
        }
      }
    }
    return;
  }
  if (k == 13) {
    const int n_all = 32 * 9;
    for (int it = bid; it < n_all; it += G) {
      const int chain = it / 9, e = it % 9, dir = chain >> 4;
      const float* gi = (const float*)(ws + OFF_GI) + (size_t)chain * SB;
      const float* aa = (const float*)(ws + OFF_AA) + (size_t)chain * SB;
      float st[8];
#pragma unroll
      for (int i = 0; i < 8; ++i) st[i] = 0.f;
      float B = -INFINITY;
      const bool isn = e == 8;
      if (isn && tid >= 16) continue;
      const size_t eo = isn ? (size_t)tid * 8 : (size_t)e * 2048 + tid * 8;
#pragma unroll 1
      for (int kk0 = 0; kk0 < 33; kk0 += 11) {
        uint4 gm[11]; float4 gn0[11], gn1[11]; float Av[11];
#pragma unroll
        for (int j = 0; j < 11; ++j) {
          const int kk = kk0 + j, ci = chain * 33 + kk;
          if (isn) { const float* g = (const float*)(ws + OFF_NST) + (size_t)ci * 128 + eo; gn0[j] = *(const float4*)g; gn1[j] = *(const float4*)(g + 4); }
          else gm[j] = *(const uint4*)((const u16*)(ws + OFF_GST) + (size_t)ci * 16384 + eo);
          float fst = 0.f;
          if (kk > 0) { const int c = 256 * kk - 1; const int sp = dir == 0 ? (c < SC ? SL + c : c - SC) : (SB - 1 - c); fst = gi[sp] - aa[sp]; }
          Av[j] = ((const float*)(ws + OFF_ALOC))[ci] - fst;
        }
#pragma unroll
        for (int j = 0; j < 11; ++j) {
          const int ci = chain * 33 + kk0 + j;
          if (isn) {
            *(uint4*)((u16*)(ws + OFF_NPST) + (size_t)ci * 128 + eo) = make_uint4(cvtpk(st[0], st[1]), cvtpk(st[2], st[3]), cvtpk(st[4], st[5]), cvtpk(st[6], st[7]));
            if (tid == 0) ((float*)(ws + OFF_BKA))[ci] = B;
          } else {
            *(uint4*)((u16*)(ws + OFF_PST) + (size_t)ci * 16384 + eo) = make_uint4(cvtpk(st[0], st[1]), cvtpk(st[2], st[3]), cvtpk(st[4], st[5]), cvtpk(st[6], st[7]));
          }
          const float A = Av[j];
          const float Bn = fmaxf(B, A);
          const float f1 = __expf(B - Bn), f2 = __expf(A - Bn);
          B = Bn;
          if (isn) {
            const float4 g0 = gn0[j], g1 = gn1[j];
            st[0] = f1 * st[0] + f2 * g0.x; st[1] = f1 * st[1] + f2 * g0.y; st[2] = f1 * st[2] + f2 * g0.z; st[3] = f1 * st[3] + f2 * g0.w;
            st[4] = f1 * st[4] + f2 * g1.x; st[5] = f1 * st[5] + f2 * g1.y; st[6] = f1 * st[6] + f2 * g1.z; st[7] = f1 * st[7] + f2 * g1.w;
          } else {
            const uint4 g = gm[j];
            st[0] = f1 * st[0] + f2 * bflo(g.x); st[1] = f1 * st[1] + f2 * bfhi(g.x); st[2] = f1 * st[2] + f2 * bflo(g.y); st[3] = f1 * st[3] + f2 * bfhi(g.y);
            st[4] = f1 * st[4] + f2 * bflo(g.z); st[5] = f1 * st[5] + f2 * bfhi(g.z); st[6] = f1 * st[6] + f2 * bflo(g.w); st[7] = f1 * st[7] + f2 * bfhi(g.w);
          }
        }
      }
    }
    return;
  }
  if (k == 4) {
    const int n_diff = NB * 4 * 66, n_ml = NB * 4 * 66, n_gqa = NB * 4 * 66, n_s5 = NB * 32 * 132 / 4;
    const int n_all = n_diff + n_ml + n_gqa + n_s5;
    const int r32 = lane & 31, h = lane >> 5;
    int* ctr = (int*)(ws + OFF_CTR) + L;
    int it = FETCH_ITEM();
    for (; it < n_diff; it = FETCH_ITEM()) {
      {
        const int qt = it % 66, head = (it / 66) & 3, b = it / (66 * 4);
        const int s = qt * 128 + wave * 32 + r32, pos = b * SB + s;
        const int kbeg = qt < 64 ? 0 : SL, nkeys = qt < 64 ? SB : SC;
        u16* qd = (u16*)(ws + OFF_QD) + (size_t)pos * 512 + head * 128;
        const float lam = ((const float*)(ws + OFF_LAMV))[L];
        const float lam_init = 0.8f - 0.6f * expf(-0.3f * (float)L);
        f32x16 R[4], O[4]; float lsum;
        attn_pass<128>(qd, (const u16*)(ws + OFF_KD) + ((size_t)b * SB + kbeg) * 512 + head * 128, 512,
                       (const u16*)(ws + OFF_VDT) + (size_t)(head * 128) * NP + (size_t)b * SB + kbeg, nkeys, R, lsum, usm);
        float* stash = (float*)(ws + OFF_STASH) + ((size_t)bid * 256 + otid()) * 64;
        {
          const float il = 1.f / lsum;
#pragma unroll
          for (int vb = 0; vb < 4; ++vb)
#pragma unroll
            for (int i = 0; i < 16; ++i) stash[vb * 16 + i] = R[vb][i] * il;
        }
        attn_pass<128>(qd + 64, (const u16*)(ws + OFF_KD) + ((size_t)b * SB + kbeg) * 512 + head * 128 + 64, 512,
                       (const u16*)(ws + OFF_VDT) + (size_t)(head * 128) * NP + (size_t)b * SB + kbeg, nkeys, O, lsum, usm);
        float ss = 0.f;
        {
          const float il = lam / lsum;
#pragma unroll
          for (int vb = 0; vb < 4; ++vb)
#pragma unroll
            for (int i = 0; i < 16; ++i) { R[vb][i] = stash[vb * 16 + i] - O[vb][i] * il; ss += R[vb][i] * R[vb][i]; }
        }
        ss += SHX(ss, 32);
        const float rn = rsqrtf(ss * (1.f / 128.f) + LN_EPS) * (1.f - lam_init);
        const float* ng = IN(9) + L * 128;
#pragma unroll
        for (int vb = 0; vb < 4; ++vb)
#pragma unroll
          for (int g = 0; g < 4; ++g) {
            const int v0 = vb * 32 + 8 * g + 4 * h;
            const float4 gg = *(const float4*)(ng + v0);
            *(uint2*)(qd + v0) = make_uint2(cvtpk(R[vb][4 * g] * rn * gg.x, R[vb][4 * g + 1] * rn * gg.y), cvtpk(R[vb][4 * g + 2] * rn * gg.z, R[vb][4 * g + 3] * rn * gg.w));
          }
      }
    }
    for (; it < n_diff + n_ml; it = FETCH_ITEM()) {
      {
        const int i2 = it - n_diff;
        const int qt = i2 % 66, head = (i2 / 66) & 3, b = i2 / (66 * 4);
        const int tidm = otid(), lane = tidm & 63, wave = tidm >> 6, r32 = lane & 31, h = lane >> 5;
        const int s = qt * 128 + wave * 32 + r32, pos = b * SB + s;
        bf16x8 qf[8];
        {
          const u16* qrow = (const u16*)(ws + OFF_A) + (size_t)pos * 512 + head * 128;
#pragma unroll
          for (int q = 0; q < 8; ++q) qf[q] = *(const bf16x8*)(qrow + q * 16 + h * 8);
        }
        const u16* Kb = (const u16*)(ws + OFF_A) + (size_t)NP * 512 + (size_t)b * SB * 512 + head * 128;
        const u16* Vt = (const u16*)(ws + OFF_MVT) + (size_t)(head * 128) * NP + (size_t)b * SB;
        f32x16 num[4];
        float* stash = (float*)(ws + OFF_STASH) + ((size_t)bid * 256 + otid()) * 64;
#pragma unroll 1
        for (int dir = 0; dir < 2; ++dir) {
          const int chain = dir * 16 + b * 4 + head;
          const float* Aarr = (const float*)(ws + OFF_AA) + (size_t)chain * SB;
          const float mxq = ((const float*)(ws + OFF_MXA))[(size_t)chain * SB + s] * LOG2E;
          const float mt = ((const float*)(ws + OFF_MTA))[(size_t)chain * SB + s];
          const int cq = chain_idx(dir, s);
          int t0a, t0b, t1a, t1b, kch = 0;
          if (qt < 64) { const int kq = qt >> 1; t0a = 0; t0b = 0; if (dir == 0) { t1a = 4 * kq; t1b = 2 * qt + 2; kch = 1 + kq; } else { t1a = 2 * qt; t1b = 4 * kq + 4; kch = 32 - kq; } }
          else { const int cqt = qt - 64; t1a = 0; t1b = 0; if (dir == 0) { t0a = 0; t0b = 2 * cqt + 2; } else { t0a = 2 * cqt; t0b = 4; } }
          float den = 0.f;
          if (kch > 0) {
            const int ci = chain * 33 + kch;
            const float et = fexp2(fminf(((const float*)(ws + OFF_BKA))[ci] * LOG2E - mxq, 0.f));
            const u16* Pp = (const u16*)(ws + OFF_PST) + (size_t)ci * 16384;
#pragma unroll
            for (int vb = 0; vb < 4; ++vb) {
#pragma unroll
              for (int i = 0; i < 16; ++i) num[vb][i] = 0.f;
#pragma unroll
              for (int q = 0; q < 8; ++q) {
                const bf16x8 pf = *(const bf16x8*)(Pp + (size_t)(32 * vb + r32) * 128 + 16 * q + 8 * h);
                num[vb] = MFMA32(pf, qf[q], num[vb]);
              }
#pragma unroll
              for (int i = 0; i < 16; ++i) num[vb][i] *= et;
              __builtin_amdgcn_sched_barrier(0);
            }
            const u16* np = (const u16*)(ws + OFF_NPST) + (size_t)ci * 128;
            float dp = 0.f;
#pragma unroll
            for (int q = 0; q < 8; ++q) {
              const bf16x8_t qv = __builtin_bit_cast(bf16x8_t, qf[q]);
              const bf16x8_t nv = *(const bf16x8_t*)(np + 16 * q + 8 * h);
              dp = __builtin_amdgcn_fdot2_f32_bf16(__builtin_shufflevector(qv, qv, 0, 1), __builtin_shufflevector(nv, nv, 0, 1), dp, false);
              dp = __builtin_amdgcn_fdot2_f32_bf16(__builtin_shufflevector(qv, qv, 2, 3), __builtin_shufflevector(nv, nv, 2, 3), dp, false);
              dp = __builtin_amdgcn_fdot2_f32_bf16(__builtin_shufflevector(qv, qv, 4, 5), __builtin_shufflevector(nv, nv, 4, 5), dp, false);
              dp = __builtin_amdgcn_fdot2_f32_bf16(__builtin_shufflevector(qv, qv, 6, 7), __builtin_shufflevector(nv, nv, 6, 7), dp, false);
            }
            dp += SHX(dp, 32);
            den = et * dp;
          } else {
#pragma unroll
            for (int vb = 0; vb < 4; ++vb)
#pragma unroll
              for (int i = 0; i < 16; ++i) num[vb][i] = 0.f;
          }
          mlstm_dir(qf, Kb, Vt, Aarr, (const float*)(ws + OFF_TMAX) + chain * 132, dir, t0a, t0b, t1a, t1b, cq, mxq, num, den, smem);
          const float dd = 1.f / fmaxf(fabsf(den), expf(-mt));
          if (dir == 0) {
#pragma unroll
            for (int vb = 0; vb < 4; ++vb)
#pragma unroll
              for (int i = 0; i < 16; ++i) stash[vb * 16 + i] = num[vb][i] * dd;
          } else {
            float ss = 0.f;
#pragma unroll
            for (int vb = 0; vb < 4; ++vb)
#pragma unroll
              for (int i = 0; i < 16; ++i) { num[vb][i] = stash[vb * 16 + i] + num[vb][i] * dd; ss += num[vb][i] * num[vb][i]; }
            ss += SHX(ss, 32);
            const float rn = rsqrtf(ss * (1.f / 128.f) + LN_EPS);
            const float* ng = IN(25) + L * 512 + head * 128;
            u16* mo = (u16*)(ws + OFF_MO) + (size_t)pos * 512 + head * 128;
#pragma unroll
            for (int vb = 0; vb < 4; ++vb)
#pragma unroll
              for (int g = 0; g < 4; ++g) {
                const int v0 = vb * 32 + 8 * g + 4 * h;
                const float4 gg = *(const float4*)(ng + v0);
                const uint2 ov = *(const uint2*)(mo + v0);
                const float y0 = num[vb][4 * g] * rn * gg.x * sigmoidf_(bflo(ov.x)), y1 = num[vb][4 * g + 1] * rn * gg.y * sigmoidf_(bfhi(ov.x));
                const float y2 = num[vb][4 * g + 2] * rn * gg.z * sigmoidf_(bflo(ov.y)), y3 = num[vb][4 * g + 3] * rn * gg.w * sigmoidf_(bfhi(ov.y));
                *(uint2*)(mo + v0) = make_uint2(cvtpk(y0, y1), cvtpk(y2, y3));
              }
          }
        }
      }
    }
    for (; it < n_diff + n_ml + n_gqa; it = FETCH_ITEM()) {
      {
        const int i2 = it - n_diff - n_ml;
        const int qt = i2 % 66, hp = (i2 / 66) & 3, b = i2 / (66 * 4);
        const int kv = hp >> 1;
        const int s = qt * 128 + wave * 32 + r32, pos = b * SB + s;
        const int kbeg = qt < 64 ? 0 : SL, nkeys = qt < 64 ? SB : SC;
        u16* qg = (u16*)(ws + OFF_QG) + (size_t)pos * 512 + hp * 128;
        f32x16 O[2][2]; float lsum[2];
        attn_pass_gqa2(qg, qg + 64, (const u16*)(ws + OFF_KG) + ((size_t)b * SB + kbeg) * 128 + kv * 64, 128,
                       (const u16*)(ws + OFF_VGT) + (size_t)(kv * 64) * NP + (size_t)b * SB + kbeg, nkeys, O, lsum, usm);
#pragma unroll
        for (int hd = 0; hd < 2; ++hd) {
          const float il = 1.f / lsum[hd];
#pragma unroll
          for (int vb = 0; vb < 2; ++vb)
#pragma unroll
            for (int g = 0; g < 4; ++g) {
              const int v0 = vb * 32 + 8 * g + 4 * h;
              *(uint2*)(qg + hd * 64 + v0) = make_uint2(cvtpk(O[hd][vb][4 * g] * il, O[hd][vb][4 * g + 1] * il), cvtpk(O[hd][vb][4 * g + 2] * il, O[hd][vb][4 * g + 3] * il));
            }
        }
      }
    }
    for (; it < n_all; it = FETCH_ITEM()) {
      {
        const int item = (it - n_diff - n_ml - n_gqa) * 4 + wave;
        const int T = item % 132, g = (item / 132) & 31, b = item / (132 * 32);
        u16* W = usm + wave * 4352;
        const int recol = lane < 32 ? lane : lane + 32;
        const size_t pos0 = (size_t)b * SB + 64 * T;
        __syncthreads();
        f32x16 ycc[2];
#pragma unroll
        for (int hh = 0; hh < 2; ++hh)
#pragma unroll
          for (int i = 0; i < 16; ++i) ycc[hh][i] = 0.f;
#pragma unroll 1
        for (int dir = 0; dir < 2; ++dir) {
          const int kk = dir == 0 ? (T < 128 ? T + 4 : T - 128) : (T < 128 ? 4 + 127 - T : 3 - (T - 128));
          const int ldg = (L * 2 + dir) * 32 + g;
          const float2 lam = ((const float2*)(ws + OFF_LAMB))[ldg * 64 + lane];
          bf16x8 bfr[4];
#pragma unroll
          for (int j = 0; j < 4; ++j) bfr[j] = *(const bf16x8*)((const u16*)(ws + OFF_BBT) + ((size_t)ldg * 128 + 32 * j + r32) * 16 + 8 * h);
          const float2 cy = ((const float2*)(ws + OFF_CARRY))[((size_t)((b * 2 + dir) * 32 + g) * 132 + kk) * 64 + lane];
          float hr = cy.x, hi = cy.y;
          const u16* cm = (const u16*)(ws + OFF_CMT) + ((size_t)ldg * 16 + (r32 & 15)) * 128 + 8 * h;
#pragma unroll 1
          for (int hq = 0; hq < 2; ++hq) {
            const int hh = dir ? 1 - hq : hq;
            s5_bu_half((const u16*)(ws + OFF_S5U) + (pos0 + 32 * hh + r32) * 512 + g * 16 + 8 * h, bfr, W, r32, h);
            s5_scan_half<true>(W, dir, recol, lam, hr, hi);
            f32x16 yy;
#pragma unroll
            for (int i = 0; i < 16; ++i) yy[i] = 0.f;
#pragma unroll
            for (int sk = 0; sk < 8; ++sk) {
              const bf16x8 af = *(const bf16x8*)(W + r32 * 136 + 16 * sk + 8 * h);
              const bf16x8 cf = *(const bf16x8*)(cm + 16 * sk);
              yy = MFMA32(af, cf, yy);
            }
            if (hh == 0) { ycc[0] += yy; } else { ycc[1] += yy; }
          }
        }
        if (r32 < 16) {
          const float dsk = IN(19)[L * 512 + g * 16 + r32];
#pragma unroll
          for (int hh = 0; hh < 2; ++hh)
#pragma unroll
            for (int i = 0; i < 16; ++i) {
              const int t = 32 * hh + (i & 3) + 8 * (i >> 2) + 4 * h;
              u16* up = (u16*)(ws + OFF_S5U) + (pos0 + t) * 512 + g * 16 + r32;
              *up = f2bf(gelu_erf(ycc[hh][i] + bf2f(*up) * dsk));
            }
        }
      }
    }
    return;
  }
  if (k == 5) {
    const int n_g = 264 * 8;
    const int n_all = n_g + NP / 4;
    for (int it = bid; it < n_all; it += G) {
      if (it < n_g) {
        const int mt = it / 8, nt = it % 8;
        f32x16 acc[2][2]; acc_zero(acc);
        gemm_core((const u16*)(ws + OFF_S5U) + (size_t)mt * 128 * 512, 512, (const u16*)(ws + OFF_WGLU) + (size_t)nt * 128 * 512, 512, 512, acc, usm);
        {
          u16* YS = (u16*)(ws + OFF_MVT);
          const int e_r = lane & 31, e_h = lane >> 5, e_wm = wave >> 1, e_wn = wave & 1;
          const int ca = nt * 64 + e_wn * 32 + e_r;
          const float ba = IN(21)[L * 1024 + ca], bgt = IN(21)[L * 1024 + 512 + ca];
#pragma unroll
          for (int mi = 0; mi < 2; ++mi)
#pragma unroll
            for (int i = 0; i < 16; ++i) {
              const int row = e_wm * 64 + mi * 32 + (i & 3) + 8 * (i >> 2) + 4 * e_h;
              YS[(size_t)(mt * 128 + row) * 512 + ca] = f2bf((acc[mi][0][i] + ba) * sigmoidf_(acc[mi][1][i] + bgt));
            }
        }
      } else {
        const int pos = (it - n_g) * 4 + wave;
        const float* md = mod_ptr(p, L, pos);
        ln_mod_wave(h_in_ptr(p, L, pos), md, md + 1024, XM + (size_t)pos * DM, lane);
      }
    }
    return;
  }
  if (k == 6) {
    const int n_all = NP * 512 / 2048;
    for (int it = bid; it < n_all; it += G) {
      const size_t e = (size_t)it * 2048 + tid * 8;
      const size_t pos = e >> 9; const int c = (int)(e & 511);
      const u16* z = (const u16*)(ws + OFF_Z) + pos * 1024 + c;
      const uint4 a = *(const uint4*)z, g = *(const uint4*)(z + 512);
      uint4 o;
      o.x = cvtpk(bflo(a.x) * sigmoidf_(bflo(g.x)), bfhi(a.x) * sigmoidf_(bfhi(g.x)));
      o.y = cvtpk(bflo(a.y) * sigmoidf_(bflo(g.y)), bfhi(a.y) * sigmoidf_(bfhi(g.y)));
      o.z = cvtpk(bflo(a.z) * sigmoidf_(bflo(g.z)), bfhi(a.z) * sigmoidf_(bfhi(g.z)));
      o.w = cvtpk(bflo(a.w) * sigmoidf_(bflo(g.w)), bfhi(a.w) * sigmoidf_(bfhi(g.w)));
      *(uint4*)((u16*)(ws + OFF_S5U) + pos * 512 + c) = o;
    }
    return;
  }
  if (k == 7) {
    const int n_g = 264 * 8, n_all = n_g + 1024;
    int* ctr = (int*)(ws + OFF_CTR) + 2 + L * 2;
    for (int it = FETCH_ITEM(); it < n_all; it = FETCH_ITEM()) {
      if (it >= n_g) {
        for (int c = 0; c < 8; ++c) convert_chunk_fp8(IN(34) + (size_t)L * 16384 * 1024, (unsigned char*)(ws + OFF_PU), (size_t)(it - n_g) * 8 + c, 64.f);
        continue;
      }
      const int mt = it / 8, nt = it % 8;
      f32x16 mg[2][2]; acc_zero(mg);
#pragma unroll 1
      for (int kb = 0; kb < 4; ++kb) {
        f32x16 a1[2][2]; acc_zero(a1);
        gemm_core(XM + (size_t)mt * 128 * DM, DM, WinT + (size_t)(4880 + kb * 1024 + nt * 128) * DM, DM, DM, a1, usm);
        const float* bg = IN(7) + L * 4096 + kb * 1024 + nt * 128;
        unsigned gp[2][2][8];
        {
          const int r32 = lane & 31, wn = wave & 1;
#pragma unroll
          for (int ni = 0; ni < 2; ++ni) {
            const float bv = bg[wn * 64 + ni * 32 + r32];
#pragma unroll
            for (int mi = 0; mi < 2; ++mi)
#pragma unroll
              for (int i = 0; i < 8; ++i) gp[mi][ni][i] = cvtpk(sigmoidf_(a1[mi][ni][2 * i] + bv), sigmoidf_(a1[mi][ni][2 * i + 1] + bv));
          }
        }
        f32x16 a2[2][2]; acc_zero(a2);
        const size_t yo = kb == 0 ? OFF_QD : (kb == 1 ? OFF_MVT : (kb == 2 ? OFF_MO : OFF_QG));
        gemm_core((const u16*)(ws + yo) + (size_t)mt * 128 * 512, 512, (const u16*)(ws + OFF_WBR) + ((size_t)kb * DM + nt * 128) * 512, 512, 512, a2, usm);
#pragma unroll
        for (int mi = 0; mi < 2; ++mi)
#pragma unroll
          for (int ni = 0; ni < 2; ++ni)
#pragma unroll
            for (int i = 0; i < 8; ++i) { mg[mi][ni][2 * i] += bflo(gp[mi][ni][i]) * a2[mi][ni][2 * i]; mg[mi][ni][2 * i + 1] += bfhi(gp[mi][ni][i]) * a2[mi][ni][2 * i + 1]; }
      }
      u16* MG = (u16*)(ws + OFF_Z);
      EPI_LOOP(mg, { MG[(size_t)(mt * 128 + row) * 1024 + nt * 128 + col] = f2bf(val); })
    }
    return;
  }
  if (k == 8) {
    const int n_g = 264 * 8, n_cv = 1024;
    const int n_all = n_g + n_cv;
    int* ctr = (int*)(ws + OFF_CTR) + 3 + L * 2;
    for (int it = FETCH_ITEM(); it < n_all; it = FETCH_ITEM()) {
      if (it < n_g) {
        const int mt = it / 8, nt = it % 8;
        f32x16 acc[2][2]; acc_zero(acc);
        gemm_core((const u16*)(ws + OFF_Z) + (size_t)mt * 128 * DM, DM, (const u16*)(ws + OFF_WO) + (size_t)nt * 128 * DM, DM, DM, acc, usm);
        const float* g1 = mod_ptr(p, L, mt * 128) + 2048 + nt * 128;
        const float* hin0 = h_in_ptr(p, L, mt * 128) + nt * 128;
        float* hout0 = h_out_ptr(p, mt * 128) + nt * 128;
        EPI_LOOP(acc, { hout0[(size_t)row * DM + col] = ALPHA * hin0[(size_t)row * DM + col] + g1[col] * val; })
      } else {
        for (int c = 0; c < 8; ++c) convert_chunk_fp8(IN(35) + (size_t)L * 16384 * 1024, (unsigned char*)(ws + OFF_PV), (size_t)(it - n_g) * 8 + c, 8.f);
      }
    }
    return;
  }
  if (k == 9) {
    for (int it = bid; it < NP / 4; it += G) {
      const int pos = it * 4 + wave;
      float* hrow = h_out_ptr(p, pos);
      float4 x[4];
#pragma unroll
      for (int i = 0; i < 4; ++i) x[i] = *(const float4*)(hrow + lane * 4 + 256 * i);
      float sm = 0.f;
#pragma unroll
      for (int i = 0; i < 4; ++i) sm += x[i].x + x[i].y + x[i].z + x[i].w;
      const float mean = wave_sum(sm) * (1.f / DM);
      float vs = 0.f;
#pragma unroll
      for (int i = 0; i < 4; ++i) { x[i].x -= mean; x[i].y -= mean; x[i].z -= mean; x[i].w -= mean; vs += x[i].x * x[i].x + x[i].y * x[i].y + x[i].z * x[i].z + x[i].w * x[i].w; }
      const float rs = rsqrtf(wave_sum(vs) * (1.f / DM) + LN_EPS);
      float sm2 = 0.f;
#pragma unroll
      for (int i = 0; i < 4; ++i) {
        const float4 g = *(const float4*)(IN(28) + L * DM + lane * 4 + 256 * i), be = *(const float4*)(IN(29) + L * DM + lane * 4 + 256 * i);
        x[i] = make_float4(x[i].x * rs * g.x + be.x, x[i].y * rs * g.y + be.y, x[i].z * rs * g.z + be.z, x[i].w * rs * g.w + be.w);
        *(float4*)(hrow + lane * 4 + 256 * i) = x[i];
        sm2 += x[i].x + x[i].y + x[i].z + x[i].w;
      }
      const float mean2 = wave_sum(sm2) * (1.f / DM);
      float vs2 = 0.f;
#pragma unroll
      for (int i = 0; i < 4; ++i) { x[i].x -= mean2; x[i].y -= mean2; x[i].z -= mean2; x[i].w -= mean2; vs2 += x[i].x * x[i].x + x[i].y * x[i].y + x[i].z * x[i].z + x[i].w * x[i].w; }
      const float rs2 = rsqrtf(wave_sum(vs2) * (1.f / DM) + LN_EPS);
      const float* md = mod_ptr(p, L, pos);
#pragma unroll
      for (int i = 0; i < 4; ++i) {
        const float4 sh = *(const float4*)(md + 3072 + lane * 4 + 256 * i), sc = *(const float4*)(md + 4096 + lane * 4 + 256 * i);
        *(uint2*)(XM + (size_t)pos * DM + lane * 4 + 256 * i) = make_uint2(cvtpk(x[i].x * rs2 * (1.f + sc.x) + sh.x, x[i].y * rs2 * (1.f + sc.y) + sh.y), cvtpk(x[i].z * rs2 * (1.f + sc.z) + sh.z, x[i].w * rs2 * (1.f + sc.w) + sh.w));
      }
    }
    return;
  }
  if (k == 10) {
    const int n_all = 264 * 16;
    for (int it = bid; it < n_all; it += G) {
      const int mt = it / 16, nt = it % 16;
      f32x16 acc[2][2]; acc_zero(acc);
      gemm_core(XM + (size_t)mt * 128 * DM, DM, (const u16*)(ws + OFF_WQ) + (size_t)nt * 128 * DM, DM, DM, acc, usm);
      u16* Q2 = (u16*)(ws + OFF_Q2);
      EPI_LOOP(acc, { Q2[(size_t)(mt * 128 + row) * 2048 + nt * 128 + col] = f2bf(val); })
    }
    return;
  }
  if (k == 11) {
    const int n_all = NP / 8;
    float* sc = fsm;
    float* T1v = fsm + 64 * 132;
    float* T2v = T1v + 1024;
    int* T1i = (int*)(T2v + 1024);
    int* T2i = T1i + 1024;
    float* Sv = (float*)(T2i + 1024) + wave * 64;
    int* Si = (int*)((float*)(T2i + 1024) + 256) + wave * 64;
    const int r32 = lane & 31, h = lane >> 5;
    for (int it = bid; it < n_all; it += G) {
      const size_t row0 = (size_t)it * 64;
#pragma unroll 1
      for (int half = 0; half < 2; ++half) {
        f32x16 a[2];
#pragma unroll
        for (int ni = 0; ni < 2; ++ni)
#pragma unroll
          for (int i = 0; i < 16; ++i) a[ni][i] = 0.f;
        const u16* qa = (const u16*)(ws + OFF_Q2) + (row0 + (wave >> 1) * 32 + r32) * 256 + half * 128;
        const u16* kbp = (const u16*)(ws + OFF_SK) + (size_t)half * 16384 + (size_t)((wave & 1) * 64 + r32) * 128;
#pragma unroll
        for (int s = 0; s < 8; ++s) {
          const bf16x8 af = *(const bf16x8*)(qa + s * 16 + h * 8);
#pragma unroll
          for (int ni = 0; ni < 2; ++ni) {
            const bf16x8 bf = *(const bf16x8*)(kbp + (size_t)ni * 32 * 128 + s * 16 + h * 8);
            a[ni] = MFMA32(af, bf, a[ni]);
          }
        }
        __syncthreads();
#pragma unroll
        for (int ni = 0; ni < 2; ++ni)
#pragma unroll
          for (int i = 0; i < 16; ++i) sc[((wave >> 1) * 32 + (i & 3) + 8 * (i >> 2) + 4 * h) * 132 + (wave & 1) * 64 + ni * 32 + r32] = a[ni][i];
        __syncthreads();
        float* Tv = half ? T2v : T1v; int* Ti = half ? T2i : T1i;
#pragma unroll 1
        for (int g = 0; g < 4; ++g) {
          float v0[4], v1[4]; unsigned k0[4], k1[4], T[4];
#pragma unroll
          for (int r = 0; r < 4; ++r) {
            const int row = wave * 16 + g * 4 + r;
            v0[r] = sc[row * 132 + lane]; v1[r] = sc[row * 132 + 64 + lane];
            unsigned u0 = __float_as_uint(v0[r]), u1 = __float_as_uint(v1[r]);
            u0 = (u0 >> 31) ? ~u0 : (u0 | 0x80000000u); u1 = (u1 >> 31) ? ~u1 : (u1 | 0x80000000u);
            k0[r] = (u0 & 0xFFFFFF80u) | (unsigned)(127 - lane); k1[r] = (u1 & 0xFFFFFF80u) | (unsigned)(63 - lane);
            T[r] = 0u;
          }
          bool dn0 = false, dn1 = false, dn2 = false, dn3 = false;
#pragma unroll 1
          for (int bit = 31; bit >= 0; --bit) {
#pragma unroll
            for (int r = 0; r < 4; ++r) {
              bool& dn = r == 0 ? dn0 : (r == 1 ? dn1 : (r == 2 ? dn2 : dn3));
              const unsigned cand = T[r] | (1u << bit);
              const int cnt = __popcll(__ballot(k0[r] >= cand)) + __popcll(__ballot(k1[r] >= cand));
              T[r] = cnt >= 16 ? cand : T[r];
              dn = dn | (cnt == 16);
            }
            if (dn0 && dn1 && dn2 && dn3) break;
          }
#pragma unroll
          for (int r = 0; r < 4; ++r) {
            const int row = wave * 16 + g * 4 + r;
            const bool s0 = k0[r] >= T[r], s1 = k1[r] >= T[r];
            const unsigned long long m0 = __ballot(s0), m1 = __ballot(s1);
            const int p0 = __builtin_amdgcn_mbcnt_hi((unsigned)(m0 >> 32), __builtin_amdgcn_mbcnt_lo((unsigned)m0, 0u));
            const int p1 = __popcll(m0) + __builtin_amdgcn_mbcnt_hi((unsigned)(m1 >> 32), __builtin_amdgcn_mbcnt_lo((unsigned)m1, 0u));
            if (s0) { Tv[row * 16 + p0] = v0[r]; Ti[row * 16 + p0] = lane; }
            if (s1) { Tv[row * 16 + p1] = v1[r]; Ti[row * 16 + p1] = lane + 64; }
          }
        }
      }
#pragma unroll 1
      for (int g = 0; g < 4; ++g) {
        {
          const int rowl = wave * 16 + g * 4 + (lane >> 4), j = lane & 15;
#pragma unroll
          for (int half = 0; half < 2; ++half) {
            float* Tv = half ? T2v : T1v; int* Ti = half ? T2i : T1i;
            const float v = Tv[rowl * 16 + j]; const int vi = Ti[rowl * 16 + j];
            int rank = 0;
#pragma unroll
            for (int i = 0; i < 16; ++i) { const float o = Tv[rowl * 16 + i]; rank += (o > v || (o == v && i < j)) ? 1 : 0; }
            Tv[rowl * 16 + rank] = v; Ti[rowl * 16 + rank] = vi;
          }
        }
        unsigned kk[4], T[4]; float cv[4];
        const int pr = PEER_PAIRS[lane], ia = pr >> 4, ib = pr & 15;
#pragma unroll
        for (int r = 0; r < 4; ++r) {
          const int row = wave * 16 + g * 4 + r;
          cv[r] = T1v[row * 16 + ia] + T2v[row * 16 + ib];
          unsigned u = __float_as_uint(cv[r]); u = (u >> 31) ? ~u : (u | 0x80000000u);
          kk[r] = lane < 50 ? ((u & 0xFFFFFFC0u) | (unsigned)(63 - lane)) : 0u;
          T[r] = 0u;
        }
        bool dn0 = false, dn1 = false, dn2 = false, dn3 = false;
#pragma unroll 1
        for (int bit = 31; bit >= 0; --bit) {
#pragma unroll
          for (int r = 0; r < 4; ++r) {
            bool& dn = r == 0 ? dn0 : (r == 1 ? dn1 : (r == 2 ? dn2 : dn3));
            const unsigned cand = T[r] | (1u << bit);
            const int cnt = __popcll(__ballot(kk[r] >= cand));
            T[r] = cnt >= 16 ? cand : T[r];
            dn = dn | (cnt == 16);
          }
          if (dn0 && dn1 && dn2 && dn3) break;
        }
#pragma unroll
        for (int r = 0; r < 4; ++r) {
          const int row = wave * 16 + g * 4 + r;
          const bool se = kk[r] >= T[r] && T[r] != 0u;
          const unsigned long long me = __ballot(se);
          const int pe = __builtin_amdgcn_mbcnt_hi((unsigned)(me >> 32), __builtin_amdgcn_mbcnt_lo((unsigned)me, 0u));
          if (se) {
            Sv[r * 16 + pe] = cv[r];
            Si[r * 16 + pe] = T1i[row * 16 + ia] * 128 + T2i[row * 16 + ib];
          }
        }
        {
          const float val = Sv[lane]; const int idx = Si[lane];
          float mx = val;
          mx = fmaxf(mx, SHX(mx, 8)); mx = fmaxf(mx, SHX(mx, 4)); mx = fmaxf(mx, SHX(mx, 2)); mx = fmaxf(mx, SHX(mx, 1));
          const float ev = __expf(val - mx);
          float sm = ev;
          sm += SHX(sm, 8); sm += SHX(sm, 4); sm += SHX(sm, 2); sm += SHX(sm, 1);
          const size_t o = (row0 + wave * 16 + g * 4) * 16 + lane;
          ((int*)(ws + OFF_IDX))[o] = idx;
          ((float*)(ws + OFF_GATE))[o] = ev / sm;
        }
      }
      __syncthreads();
    }
    return;
  }
  if (k == 12) {
    const unsigned char* PU = (const unsigned char*)(ws + OFF_PU); const unsigned char* PV = (const unsigned char*)(ws + OFF_PV);
    float* wl = fsm + 8 + wave * 32;
    float* fs = fsm + 8 + 128;
    int myidx = 0; float myg = 0.f;
    u32x4 A[8], B[8], C[8], D[8];
#define LOADROWS(X, TAB, E0)                                                             \
      _Pragma("unroll") for (int j = 0; j < 8; ++j) {                                    \
        const int idx = __builtin_amdgcn_readlane(myidx, (E0) + j);                      \
        X[j] = *(const u32x4*)((TAB) + (size_t)idx * DM + lane * 16);                    \
      }
#define LOADROWS_N(X, TAB, E0)                                                           \
      _Pragma("unroll") for (int j = 0; j < 8; ++j) {                                    \
        const int idx = __builtin_amdgcn_readlane(nidx, (E0) + j);                       \
        X[j] = *(const u32x4*)((TAB) + (size_t)idx * DM + lane * 16);                    \
      }
    if (bid < NP) {
      const size_t r0 = (size_t)bid * 8 + wave * 2;
      myidx = lane < 32 ? ((const int*)(ws + OFF_IDX))[r0 * 16 + lane] : 0;
      myg = lane < 32 ? ((const float*)(ws + OFF_GATE))[r0 * 16 + lane] : 0.f;
      LOADROWS(A, PU, 0)
      LOADROWS(B, PU, 8)
      LOADROWS(C, PU, 16)
      LOADROWS(D, PU, 24)
    }
    for (int it = bid; it < NP; it += G) {
      const int pos = it;
      const bool has_next = it + G < NP;
      int nidx = 0; float ng = 0.f;
      if (has_next) {
        const size_t r1 = (size_t)(it + G) * 8 + wave * 2;
        nidx = lane < 32 ? ((const int*)(ws + OFF_IDX))[r1 * 16 + lane] : 0;
        ng = lane < 32 ? ((const float*)(ws + OFF_GATE))[r1 * 16 + lane] : 0.f;
      }
      float tf[16];
      {
        const u16* xr = XM + (size_t)pos * DM + lane * 16;
        const u32x4 a = *(const u32x4*)xr, b = *(const u32x4*)(xr + 8);
        tf[0] = bflo(a.x); tf[1] = bfhi(a.x); tf[2] = bflo(a.y); tf[3] = bfhi(a.y); tf[4] = bflo(a.z); tf[5] = bfhi(a.z); tf[6] = bflo(a.w); tf[7] = bfhi(a.w);
        tf[8] = bflo(b.x); tf[9] = bfhi(b.x); tf[10] = bflo(b.y); tf[11] = bfhi(b.y); tf[12] = bflo(b.z); tf[13] = bfhi(b.z); tf[14] = bflo(b.w); tf[15] = bfhi(b.w);
      }
      const bool b5 = lane & 32, b4 = lane & 16, b3 = lane & 8;
#define UNPK(X, j, q) const f32x2 q##0 = __builtin_amdgcn_cvt_pk_f32_fp8((int)X[j].x, false), q##1 = __builtin_amdgcn_cvt_pk_f32_fp8((int)X[j].x, true), \
                                  q##2 = __builtin_amdgcn_cvt_pk_f32_fp8((int)X[j].y, false), q##3 = __builtin_amdgcn_cvt_pk_f32_fp8((int)X[j].y, true), \
                                  q##4 = __builtin_amdgcn_cvt_pk_f32_fp8((int)X[j].z, false), q##5 = __builtin_amdgcn_cvt_pk_f32_fp8((int)X[j].z, true), \
                                  q##6 = __builtin_amdgcn_cvt_pk_f32_fp8((int)X[j].w, false), q##7 = __builtin_amdgcn_cvt_pk_f32_fp8((int)X[j].w, true);
#define DOTS(X, E0)                                                                  \
      {                                                                                  \
        float d[8];                                                                      \
        _Pragma("unroll") for (int j = 0; j < 8; ++j) {                                  \
          UNPK(X, j, q)                                                                  \
          d[j] = tf[0] * q0.x + tf[1] * q0.y + tf[2] * q1.x + tf[3] * q1.y + tf[4] * q2.x + tf[5] * q2.y + tf[6] * q3.x + tf[7] * q3.y \
               + tf[8] * q4.x + tf[9] * q4.y + tf[10] * q5.x + tf[11] * q5.y + tf[12] * q6.x + tf[13] * q6.y + tf[14] * q7.x + tf[15] * q7.y; \
          asm volatile("" : "+v"(d[j]));                                                 \
        }                                                                                \
        float d4[4], d2[2], d1;                                                          \
        _Pragma("unroll") for (int i = 0; i < 4; ++i) { const float keep = b5 ? d[i + 4] : d[i], send = b5 ? d[i] : d[i + 4]; d4[i] = keep + SHX(send, 32); } \
        _Pragma("unroll") for (int i = 0; i < 2; ++i) { const float keep = b4 ? d4[i + 2] : d4[i], send = b4 ? d4[i] : d4[i + 2]; d2[i] = keep + SHX(send, 16); } \
        { const float keep = b3 ? d2[1] : d2[0], send = b3 ? d2[0] : d2[1]; d1 = keep + SHX(send, 8); } \
        d1 += SHX(d1, 4); d1 += SHX(d1, 2); d1 += SHX(d1, 1);                            \
        const float gt = __int_as_float(__builtin_amdgcn_ds_bpermute(((E0) + (lane >> 3)) << 2, __float_as_int(myg))); \
        if ((lane & 7) == 0) wl[(E0) + (lane >> 3)] = gt * gelu_erf(d1 * (1.f / 64.f)) * 0.125f; \
        __builtin_amdgcn_sched_barrier(0);                                               \
      }
#define ACCV(X, E0)                                                                      \
      _Pragma("unroll") for (int j = 0; j < 8; ++j) {                                    \
        const float w = wl[(E0) + j];                                                    \
        UNPK(X, j, q)                                                                    \
        ov[0] += w * q0.x; ov[1] += w * q0.y; ov[2] += w * q1.x; ov[3] += w * q1.y; ov[4] += w * q2.x; ov[5] += w * q2.y; ov[6] += w * q3.x; ov[7] += w * q3.y; \
        ov[8] += w * q4.x; ov[9] += w * q4.y; ov[10] += w * q5.x; ov[11] += w * q5.y; ov[12] += w * q6.x; ov[13] += w * q6.y; ov[14] += w * q7.x; ov[15] += w * q7.y; \
        _Pragma("unroll") for (int i = 0; i < 16; ++i) asm volatile("" : "+v"(ov[i]));   \
      }
      __syncthreads();
      DOTS(A, 0)
      LOADROWS(A, PV, 0)
      DOTS(B, 8)
      LOADROWS(B, PV, 8)
      DOTS(C, 16)
      LOADROWS(C, PV, 16)
      DOTS(D, 24)
      LOADROWS(D, PV, 24)
      float ov[16];
#pragma unroll
      for (int i = 0; i < 16; ++i) ov[i] = 0.f;
      ACCV(A, 0)
      __builtin_amdgcn_sched_barrier(0);
      if (has_next) { LOADROWS_N(A, PU, 0) }
      ACCV(B, 8)
      __builtin_amdgcn_sched_barrier(0);
      if (has_next) { LOADROWS_N(B, PU, 8) }
      ACCV(C, 16)
      __builtin_amdgcn_sched_barrier(0);
      if (has_next) { LOADROWS_N(C, PU, 16) }
      ACCV(D, 24)
      __builtin_amdgcn_sched_barrier(0);
      if (has_next) { LOADROWS_N(D, PU, 24) }
#undef UNPK
#undef DOTS
#undef ACCV
#pragma unroll
      for (int i = 0; i < 16; ++i) fs[wave * 1024 + lane * 16 + i] = ov[i];
      __syncthreads();
      const int tid2 = otid();
      float f[4];
#pragma unroll
      for (int i = 0; i < 4; ++i) f[i] = fs[tid2 * 4 + i] + fs[1024 + tid2 * 4 + i] + fs[2048 + tid2 * 4 + i] + fs[3072 + tid2 * 4 + i];
      float* hrow = h_out_ptr(p, pos);
      const float4 hm = *(const float4*)(hrow + tid2 * 4);
      const float4 g2 = *(const float4*)(mod_ptr(p, L, pos) + 5120 + tid2 * 4);
      const float x0 = ALPHA * hm.x + g2.x * f[0], x1 = ALPHA * hm.y + g2.y * f[1], x2 = ALPHA * hm.z + g2.z * f[2], x3 = ALPHA * hm.w + g2.w * f[3];
      const float mean = block_sum(x0 + x1 + x2 + x3, fsm) * (1.f / DM);
      const float a = x0 - mean, b = x1 - mean, c = x2 - mean, d = x3 - mean;
      const float var = block_sum(a * a + b * b + c * c + d * d, fsm) * (1.f / DM);
      const float rs = rsqrtf(var + LN_EPS);
      const float4 g = *(const float4*)(IN(30) + L * DM + tid2 * 4), be = *(const float4*)(IN(31) + L * DM + tid2 * 4);
      *(float4*)(hrow + tid2 * 4) = make_float4(a * rs * g.x + be.x, b * rs * g.y + be.y, c * rs * g.z + be.z, d * rs * g.w + be.w);
      myidx = nidx; myg = ng;
    }
#undef LOADROWS
#undef LOADROWS_N
    return;
  }
}

#if MULTI_LAUNCH
__global__ void __launch_bounds__(256, 2) k_phase(P p, int ph) {
  __shared__ __attribute__((aligned(16))) char smem[57344];
  run_phase(p, ph, smem);
}
#endif

#if !MULTI_LAUNCH
#define XB_TMO      128
#define XB_XCNT(j)  (256  + 64 * (j))
#define XB_XSUB(j)  (1280 + 64 * (j))
#define XB_XGEN(j)  (2304 + 64 * (j))
#define XB_TOP      3328
#define XB_TOPGEN   3392
#define XCD_BAR_WORDS 3456
#define XB_SPIN_CAP (1u << 18)
#define LAS __attribute__((address_space(3)))

__device__ __forceinline__ unsigned xb_ld(unsigned* p)              { return __hip_atomic_load(p, __ATOMIC_RELAXED, __HIP_MEMORY_SCOPE_AGENT); }
__device__ __forceinline__ unsigned xb_add(unsigned* p, unsigned v) { return __hip_atomic_fetch_add(p, v, __ATOMIC_RELAXED, __HIP_MEMORY_SCOPE_AGENT); }
__device__ __forceinline__ unsigned xb_xcc_id() { return (unsigned)__builtin_amdgcn_s_getreg((3 << 11) | 20) & 0xFu; }
#define XB_SPIN(cond, bar) do { unsigned _sp = 0; while (cond) { __builtin_amdgcn_s_sleep(1); \
    if ((++_sp & 255u) == 0u) { if (xb_ld(&(bar)[XB_TMO])) break; if (_sp > XB_SPIN_CAP) { atomicAdd(&(bar)[XB_TMO], 1u); break; } } } } while (0)

struct XcdBarrier {
    unsigned* bar; unsigned x;
    volatile LAS unsigned* st;
};

__device__ __forceinline__ XcdBarrier xcd_barrier_post(unsigned* bar, volatile LAS unsigned* st) {
    XcdBarrier b; b.bar = bar; b.x = xb_xcc_id(); b.st = st;
    if (threadIdx.x == 0) (void)xb_add(&bar[XB_XCNT(b.x)], 1u);
    return b;
}
__device__ __forceinline__ void xcd_barrier_complete(unsigned* bar, unsigned x, unsigned& nloc, unsigned& nx) {
    const unsigned G = gridDim.x * gridDim.y * gridDim.z;
    unsigned sum, cnt, mine, sp = 0u;
    for (;;) {
        sum = 0u; cnt = 0u; mine = 0u;
#pragma unroll
        for (unsigned j = 0; j < 16; ++j) { const unsigned c = xb_ld(&bar[XB_XCNT(j)]); sum += c; cnt += (c > 0u) ? 1u : 0u; mine = (j == x) ? c : mine; }
        if (sum == G) break;
        __builtin_amdgcn_s_sleep(1);
        if ((++sp & 255u) == 0u) { if (xb_ld(&bar[XB_TMO])) break; if (sp > XB_SPIN_CAP) { atomicAdd(&bar[XB_TMO], 1u); break; } }
    }
    nloc = mine > 0u ? mine : 1u; nx = cnt > 0u ? cnt : 1u;
}

__device__ __forceinline__ void xcd_barrier(const XcdBarrier& b) {
    asm volatile("s_waitcnt vmcnt(0)" ::: "memory");
    __syncthreads();
    if (threadIdx.x == 0) {
        unsigned* bar = b.bar;
        __builtin_amdgcn_s_waitcnt(0);
        unsigned nloc = b.st[0], nx = b.st[1];
        if (nloc == 0u) { xcd_barrier_complete(bar, b.x, nloc, nx); b.st[0] = nloc; b.st[1] = nx; }
        const unsigned old = xb_add(&bar[XB_XSUB(b.x)], 1u);
        const unsigned gen = old / nloc;
        if (old + 1u == (gen + 1u) * nloc) {
            __builtin_amdgcn_fence(__ATOMIC_RELEASE, "agent");
            asm volatile("s_waitcnt vmcnt(0)" ::: "memory");
            const unsigned og = xb_add(&bar[XB_TOP], 1u);
            const unsigned tg = og / nx;
            if (og + 1u == (tg + 1u) * nx) xb_add(&bar[XB_TOPGEN], 1u);
            else XB_SPIN(xb_ld(&bar[XB_TOPGEN]) == tg, bar);
            __builtin_amdgcn_fence(__ATOMIC_ACQUIRE, "agent");
            xb_add(&bar[XB_XGEN(b.x)], 1u);
            asm volatile("s_waitcnt vmcnt(0)" ::: "memory");
        } else {
            XB_SPIN(xb_ld(&bar[XB_XGEN(b.x)]) == gen, bar);
            __builtin_amdgcn_fence(__ATOMIC_ACQUIRE, "agent");
            asm volatile("s_waitcnt vmcnt(0)" ::: "memory");
        }
    }
    __syncthreads();
}


__global__ void __launch_bounds__(256, 2) k_mega(P p) {
  __shared__ __attribute__((aligned(16))) char smem[57344];
  cg::grid_group grid = cg::this_grid();
  __shared__ uint4 xb_words;
  if (threadIdx.x == 0) xb_words = make_uint4(0u, 0u, 0u, 0u);
  __syncthreads();
  (void)xcd_barrier_post((unsigned*)(WSP + OFF_BAR), (volatile LAS unsigned*)&xb_words);
#define XBAR() { XcdBarrier xb_; xb_.bar = (unsigned*)(WSP + OFF_BAR); xb_.x = xb_xcc_id(); xb_.st = (volatile LAS unsigned*)&xb_words; xcd_barrier(xb_); }
  run_phase(p, 0, smem); grid.sync();
  run_phase(p, 1, smem); XBAR()
  run_phase(p, 2, smem); XBAR()
  run_phase(p, 3, smem); XBAR()
  run_phase(p, 4, smem); XBAR()
  run_phase(p, 5, smem); XBAR()
  run_phase(p, 15, smem); XBAR()
  run_phase(p, 6, smem); XBAR()
  run_phase(p, 7, smem); XBAR()
  run_phase(p, 9, smem); XBAR()
  run_phase(p, 10, smem); XBAR()
  run_phase(p, 11, smem); XBAR()
  run_phase(p, 12, smem); XBAR()
  run_phase(p, 13, smem); XBAR()
  run_phase(p, 14, smem); XBAR()
  run_phase(p, 16, smem); XBAR()
  run_phase(p, 17, smem); XBAR()
  run_phase(p, 18, smem); XBAR()
  run_phase(p, 19, smem); XBAR()
  run_phase(p, 29, smem); XBAR()
  run_phase(p, 20, smem); XBAR()
  run_phase(p, 21, smem); XBAR()
  run_phase(p, 23, smem); XBAR()
  run_phase(p, 24, smem); XBAR()
  run_phase(p, 25, smem); XBAR()
  run_phase(p, 26, smem); XBAR()
  run_phase(p, 27, smem); XBAR()
  run_phase(p, 28, smem);
#undef XBAR
}
#endif

extern "C" void kernel_launch(void* const* d_in, const int* in_sizes, int n_in, void* d_out, int out_size, void* d_ws, size_t ws_size, hipStream_t stream) {
  if (n_in != 36 || ws_size < WS_END) { fprintf(stderr, "kernel_launch: need 36 inputs and %zu bytes of workspace (got %d, %zu)\n", (size_t)WS_END, n_in, ws_size); return; }
  P p{};
  for (int i = 0; i < 36; ++i) p.in[i] = (const float*)d_in[i];
  p.out = (float*)d_out; p.ws = (char*)d_ws;
#if MULTI_LAUNCH
  for (int ph = 0; ph < NPHASES; ++ph) hipLaunchKernelGGL(k_phase, dim3(512), dim3(256), 0, stream, p, ph);
#else
  static int grid_blocks = 0;
  if (!grid_blocks) {
    int dev = 0, cus = 0, per_cu = 0;
    hipGetDevice(&dev);
    hipDeviceGetAttribute(&cus, hipDeviceAttributeMultiprocessorCount, dev);
    hipOccupancyMaxActiveBlocksPerMultiprocessor(&per_cu, k_mega, 256, 0);
    if (per_cu < 1) per_cu = 1;
    grid_blocks = cus * per_cu;
    if (grid_blocks > 512) grid_blocks = 512;
  }
  hipMemsetAsync((char*)d_ws + OFF_BAR, 0, 16384, stream);
  void* args[] = {&p};
  hipError_t e = hipLaunchCooperativeKernel((void*)k_mega, dim3(grid_blocks), dim3(256), args, 0, stream);
  if (e != hipSuccess) fprintf(stderr, "cooperative launch failed: %s (grid %d)\n", hipGetErrorString(e), grid_blocks);
#endif
}
```
